# Optimizing an MI355X kernel written in HIP

```python
import math
import jax, jax.numpy as jnp
from jax import lax
import numpy as np

D_MODEL = 2048
BATCH = 2
SEQ = 16384
DEPTH = 2

CHUNK = 64
RMS_EPS = 1e-6
D_FF = 5632
RWKV_HEADS = 12
RWKV_HEAD_DIM = 64
RWKV_DIM = RWKV_HEADS * RWKV_HEAD_DIM
DECAY_LORA = 64
ICLR_LORA = 64
GATE_LORA = 128
RWKV_GN_EPS = 64e-5
GDN_HEADS = 6
GDN_HEAD_DIM = 128
GDN_DIM = GDN_HEADS * GDN_HEAD_DIM
GDN_CONV = 4
LRU_BLOCKS = 8
LRU_BLOCK_DIM = 64
LRU_DIM = LRU_BLOCKS * LRU_BLOCK_DIM
LRU_CONV = 4
LRU_C = 8.0
MIX_DIM = RWKV_DIM + GDN_DIM + LRU_DIM
RWKV_IN = 3 * RWKV_DIM + DECAY_LORA + ICLR_LORA + GATE_LORA
GDN_IN = 4 * GDN_DIM + 2 * GDN_HEADS
LRU_IN = 2 * LRU_DIM
PROJ_DIM = RWKV_IN + GDN_IN + LRU_IN

kernel_name = "hybrid_rwkv7_gdn_rglru_macaron"


def rmsnorm(x, g):
    xf = x.astype(jnp.float32)
    y = xf * lax.rsqrt(jnp.mean(xf * xf, axis=-1, keepdims=True) + RMS_EPS)
    return (y * g.astype(jnp.float32)).astype(x.dtype)


def l2norm(x):
    xf = x.astype(jnp.float32)
    return xf * lax.rsqrt(jnp.sum(xf * xf, axis=-1, keepdims=True) + 1e-12)


def swiglu(h, wg, wu, wd):
    return (jax.nn.silu(h @ wg) * (h @ wu)) @ wd


def causal_dwconv(x, w):
    K, C = w.shape
    return lax.conv_general_dilated(x, w[:, None, :].astype(x.dtype), window_strides=(1,),
                                    padding=[(K - 1, 0)],
                                    dimension_numbers=('NWC', 'WIO', 'NWC'),
                                    feature_group_count=C)


def rwkv7_recurrence(r, w, k, v, kk, a):
    B, T, H, N = r.shape

    def step(S, inp):
        r_t, w_t, k_t, v_t, kk_t, a_t = inp
        sa = jnp.einsum('bhvk,bhk->bhv', S, kk_t)
        S = (S * w_t[:, :, None, :]
             - sa[..., None] * (kk_t * a_t)[:, :, None, :]
             + v_t[..., None] * k_t[:, :, None, :])
        return S, jnp.einsum('bhvk,bhk->bhv', S, r_t)

    xs = tuple(jnp.swapaxes(t, 0, 1) for t in (r, w, k, v, kk, a))
    _, y = lax.scan(step, jnp.zeros((B, H, N, N), jnp.float32), xs)
    return jnp.swapaxes(y, 0, 1)


def rwkv7_mixer(z, mu, w0, w2, a0, a2, g2, k_k, k_a, r_k, ln_g, ln_b):
    B, T, _ = z.shape
    zf = z.astype(jnp.float32)
    z_prev = jnp.pad(zf[:, :-1], ((0, 0), (1, 0), (0, 0)))
    zf = zf + mu * (z_prev - zf)
    o1 = RWKV_DIM
    o2 = 2 * RWKV_DIM
    o3 = 3 * RWKV_DIM
    o4 = o3 + DECAY_LORA
    o5 = o4 + ICLR_LORA
    r, k, v, zw, za, zg = jnp.split(zf, [o1, o2, o3, o4, o5], axis=-1)
    w_log = -jax.nn.softplus(-(w0 + jnp.tanh(zw) @ w2)) - 0.5
    decay = jnp.exp(-jnp.exp(w_log))
    a = jax.nn.sigmoid(a0 + za @ a2)
    g = jax.nn.sigmoid(zg) @ g2
    heads = lambda t: t.reshape(B, T, RWKV_HEADS, RWKV_HEAD_DIM)
    kk = l2norm(heads(k * k_k))
    k = k * (1.0 + (a - 1.0) * k_a)
    r, k, v, decay, a = map(heads, (r, k, v, decay, a))
    y = rwkv7_recurrence(r, decay, k, v, kk, a)
    mean = jnp.mean(y, axis=-1, keepdims=True)
    var = jnp.mean(jnp.square(y - mean), axis=-1, keepdims=True)
    y = ((y - mean) * lax.rsqrt(var + RWKV_GN_EPS)).reshape(B, T, RWKV_DIM) * ln_g + ln_b
    bonus = jnp.sum(r * k * r_k, axis=-1, keepdims=True) * v
    y = (y + bonus.reshape(B, T, RWKV_DIM)) * g
    return y.astype(z.dtype)


def gated_delta_chunked(q, k, v, g, beta):
    B, T, H, DK = q.shape
    DV = v.shape[-1]
    n = T // CHUNK

    def blocks(t):
        t = t.reshape((B, n, CHUNK, H) + t.shape[3:])
        return jnp.moveaxis(t, 3, 1)

    q, k, v, g, beta = map(blocks, (q, k, v, g, beta))
    gc = jnp.cumsum(g, axis=-1)
    idx = jnp.arange(CHUNK)
    causal = idx[:, None] >= idx[None, :]
    strict = idx[:, None] > idx[None, :]
    diff = gc[..., :, None] - gc[..., None, :]
    decay = jnp.where(causal, jnp.exp(jnp.where(causal, diff, 0.0)), 0.0)
    kb = k * beta[..., None]
    m = jnp.where(strict, jnp.einsum('bhnid,bhnjd->bhnij', kb, k) * decay, 0.0)
    lower = m + jnp.eye(CHUNK, dtype=m.dtype)
    rhs = jnp.concatenate([v * beta[..., None], kb * jnp.exp(gc)[..., None]], axis=-1)
    sol = lax.linalg.triangular_solve(lower, rhs, left_side=True, lower=True,
                                      unit_diagonal=True)
    u, wk = sol[..., :DV], sol[..., DV:]
    qk = jnp.where(causal, jnp.einsum('bhnid,bhnjd->bhnij', q, k) * decay, 0.0)

    def step(S, inp):
        q_i, k_i, u_i, w_i, qk_i, gc_i = inp
        v_new = u_i - jnp.einsum('bhcd,bhde->bhce', w_i, S)
        o = (jnp.einsum('bhcd,bhde->bhce', q_i * jnp.exp(gc_i)[..., None], S)
             + jnp.einsum('bhij,bhje->bhie', qk_i, v_new))
        g_last = gc_i[..., -1:]
        S = (S * jnp.exp(g_last)[..., None]
             + jnp.einsum('bhcd,bhce->bhde', k_i * jnp.exp(g_last - gc_i)[..., None], v_new))
        return S, o

    xs = tuple(jnp.moveaxis(t, 2, 0) for t in (q, k, u, wk, qk, gc))
    _, o = lax.scan(step, jnp.zeros((B, H, DK, DV), jnp.float32), xs)
    o = jnp.transpose(o, (1, 0, 3, 2, 4))
    return o.reshape(B, T, H, DV)


def gdn_mixer(z, conv_w, a_log, dt_bias, norm_g):
    B, T, _ = z.shape
    qkv, gate, zb, za = jnp.split(z, [3 * GDN_DIM, 4 * GDN_DIM, 4 * GDN_DIM + GDN_HEADS], axis=-1)
    qkv = jax.nn.silu(causal_dwconv(qkv, conv_w)).astype(jnp.float32)
    q, k, v = jnp.split(qkv.reshape(B, T, 3 * GDN_HEADS, GDN_HEAD_DIM), 3, axis=2)
    q = l2norm(q) * (GDN_HEAD_DIM ** -0.5)
    k = l2norm(k)
    beta = jax.nn.sigmoid(zb.astype(jnp.float32))
    g = -jnp.exp(a_log.astype(jnp.float32)) * jax.nn.softplus(za.astype(jnp.float32) + dt_bias)
    o = gated_delta_chunked(q, k, v, g, beta)
    o = rmsnorm(o, norm_g) * jax.nn.silu(gate.astype(jnp.float32).reshape(B, T, GDN_HEADS, GDN_HEAD_DIM))
    return o.reshape(B, T, GDN_DIM).astype(z.dtype)


def rglru_mixer(z, conv_w, conv_b, w_a, b_a, w_x, b_x, lam):
    B, T, _ = z.shape
    xl, yl = jnp.split(z, 2, axis=-1)
    xc = (causal_dwconv(xl, conv_w) + conv_b).astype(jnp.float32)
    xb = xc.reshape(B, T, LRU_BLOCKS, LRU_BLOCK_DIM)
    r = jax.nn.sigmoid(jnp.einsum('btnc,ncd->btnd', xb, w_a).reshape(B, T, LRU_DIM) + b_a)
    i = jax.nn.sigmoid(jnp.einsum('btnc,ncd->btnd', xb, w_x).reshape(B, T, LRU_DIM) + b_x)
    log_a = -LRU_C * r * jax.nn.softplus(-lam.astype(jnp.float32))
    a = jnp.exp(log_a)
    u = jnp.sqrt(-jnp.expm1(2.0 * log_a)) * (i * xc)

    def combine(e, l):
        return (e[0] * l[0], l[0] * e[1] + l[1])

    _, h = lax.associative_scan(combine, (a, u), axis=1)
    return (h * jax.nn.gelu(yl.astype(jnp.float32))).astype(z.dtype)


def setup_inputs(seed: int = 0) -> dict:
    key = jax.random.key(seed)
    ks = iter(jax.random.split(key, 48))
    f32 = jnp.float32
    L = DEPTH

    def nrm(shape, scale):
        return jax.random.normal(next(ks), shape, f32) * scale

    def gain(shape):
        return 1.0 + nrm(shape, 0.02)

    def unif(shape, lo, hi):
        return jax.random.uniform(next(ks), shape, f32, lo, hi)

    x = nrm((BATCH, SEQ, D_MODEL), 1.0)
    norm1_g = gain((L, D_MODEL))
    ffn1_wg = nrm((L, D_MODEL, D_FF), D_MODEL ** -0.5)
    ffn1_wu = nrm((L, D_MODEL, D_FF), D_MODEL ** -0.5)
    ffn1_wd = nrm((L, D_FF, D_MODEL), D_FF ** -0.5)
    norm_mix_g = gain((L, D_MODEL))
    w_in = nrm((L, D_MODEL, PROJ_DIM), D_MODEL ** -0.5)
    rw_mu = unif((L, RWKV_IN), 0.0, 1.0)
    rw_w0 = unif((L, RWKV_DIM), -6.5, -1.5)
    rw_w2 = nrm((L, DECAY_LORA, RWKV_DIM), 0.5 * DECAY_LORA ** -0.5)
    rw_a0 = nrm((L, RWKV_DIM), 0.1)
    rw_a2 = nrm((L, ICLR_LORA, RWKV_DIM), 0.5 * ICLR_LORA ** -0.5)
    rw_g2 = nrm((L, GATE_LORA, RWKV_DIM), GATE_LORA ** -0.5)
    rw_kk = 0.85 + nrm((L, RWKV_DIM), 0.02)
    rw_ka = gain((L, RWKV_DIM))
    rw_rk = nrm((L, RWKV_HEADS, RWKV_HEAD_DIM), 0.1)
    rw_ln_g = gain((L, RWKV_DIM))
    rw_ln_b = nrm((L, RWKV_DIM), 0.02)
    gd_conv_w = nrm((L, GDN_CONV, 3 * GDN_DIM), GDN_CONV ** -0.5)
    gd_a_log = jnp.log(unif((L, GDN_HEADS), 1.0, 16.0))
    dt = jnp.exp(unif((L, GDN_HEADS), math.log(1e-3), math.log(1e-1)))
    gd_dt_bias = dt + jnp.log(-jnp.expm1(-dt))
    gd_norm_g = gain((L, GDN_HEAD_DIM))
    lr_conv_w = nrm((L, LRU_CONV, LRU_DIM), LRU_CONV ** -0.5)
    lr_conv_b = nrm((L, LRU_DIM), 0.02)
    lr_wa = nrm((L, LRU_BLOCKS, LRU_BLOCK_DIM, LRU_BLOCK_DIM), LRU_BLOCK_DIM ** -0.5)
    lr_ba = nrm((L, LRU_DIM), 0.02)
    lr_wx = nrm((L, LRU_BLOCKS, LRU_BLOCK_DIM, LRU_BLOCK_DIM), LRU_BLOCK_DIM ** -0.5)
    lr_bx = nrm((L, LRU_DIM), 0.02)
    s = unif((L, LRU_DIM), 0.9, 0.999) ** (1.0 / LRU_C)
    lr_lam = jnp.log(s) - jnp.log1p(-s)
    w_out = nrm((L, MIX_DIM, D_MODEL), MIX_DIM ** -0.5)
    norm2_g = gain((L, D_MODEL))
    ffn2_wg = nrm((L, D_MODEL, D_FF), D_MODEL ** -0.5)
    ffn2_wu = nrm((L, D_MODEL, D_FF), D_MODEL ** -0.5)
    ffn2_wd = nrm((L, D_FF, D_MODEL), D_FF ** -0.5)
    final_g = gain((D_MODEL,))
    return {"x": x, "norm1_g": norm1_g, "ffn1_wg": ffn1_wg, "ffn1_wu": ffn1_wu,
            "ffn1_wd": ffn1_wd, "norm_mix_g": norm_mix_g, "w_in": w_in,
            "rw_mu": rw_mu, "rw_w0": rw_w0, "rw_w2": rw_w2, "rw_a0": rw_a0,
            "rw_a2": rw_a2, "rw_g2": rw_g2, "rw_kk": rw_kk, "rw_ka": rw_ka,
            "rw_rk": rw_rk, "rw_ln_g": rw_ln_g, "rw_ln_b": rw_ln_b,
            "gd_conv_w": gd_conv_w, "gd_a_log": gd_a_log, "gd_dt_bias": gd_dt_bias,
            "gd_norm_g": gd_norm_g, "lr_conv_w": lr_conv_w, "lr_conv_b": lr_conv_b,
            "lr_wa": lr_wa, "lr_ba": lr_ba, "lr_wx": lr_wx, "lr_bx": lr_bx,
            "lr_lam": lr_lam, "w_out": w_out, "norm2_g": norm2_g,
            "ffn2_wg": ffn2_wg, "ffn2_wu": ffn2_wu, "ffn2_wd": ffn2_wd,
            "final_g": final_g}


def reference(x, norm1_g, ffn1_wg, ffn1_wu, ffn1_wd, norm_mix_g, w_in,
              rw_mu, rw_w0, rw_w2, rw_a0, rw_a2, rw_g2, rw_kk, rw_ka, rw_rk,
              rw_ln_g, rw_ln_b, gd_conv_w, gd_a_log, gd_dt_bias, gd_norm_g,
              lr_conv_w, lr_conv_b, lr_wa, lr_ba, lr_wx, lr_bx, lr_lam, w_out,
              norm2_g, ffn2_wg, ffn2_wu, ffn2_wd, final_g):
    for l in range(DEPTH):
        x = x + 0.5 * swiglu(rmsnorm(x, norm1_g[l]), ffn1_wg[l], ffn1_wu[l], ffn1_wd[l])
        h = rmsnorm(x, norm_mix_g[l])
        z = h @ w_in[l]
        z_rw, z_gd, z_lr = jnp.split(z, [RWKV_IN, RWKV_IN + GDN_IN], axis=-1)
        y_rw = rwkv7_mixer(z_rw, rw_mu[l], rw_w0[l], rw_w2[l], rw_a0[l], rw_a2[l], rw_g2[l],
                           rw_kk[l], rw_ka[l], rw_rk[l], rw_ln_g[l], rw_ln_b[l])
        y_gd = gdn_mixer(z_gd, gd_conv_w[l], gd_a_log[l], gd_dt_bias[l], gd_norm_g[l])
        y_lr = rglru_mixer(z_lr, lr_conv_w[l], lr_conv_b[l], lr_wa[l], lr_ba[l],
                           lr_wx[l], lr_bx[l], lr_lam[l])
        mix = jnp.concatenate([y_rw, y_gd, y_lr], axis=-1)
        x = x + mix @ w_out[l]
        x = x + 0.5 * swiglu(rmsnorm(x, norm2_g[l]), ffn2_wg[l], ffn2_wu[l], ffn2_wd[l])
    return rmsnorm(x, final_g)
```

```cpp
#include <hip/hip_runtime.h>
#include <hip/hip_cooperative_groups.h>
#include <cstdio>
namespace cg = cooperative_groups;
#include <hip/hip_runtime.h>
namespace pg8 {
#define PG8_LAS __attribute__((address_space(3)))
typedef unsigned short bf16_t;
typedef short bf16x8 __attribute__((ext_vector_type(8)));
typedef float f32x4 __attribute__((ext_vector_type(4)));
typedef unsigned u32x4 __attribute__((ext_vector_type(4)));
constexpr int BM = 256, BK = 64, HALF = 128, HTB = HALF * BK * 2  , STAGE_BYTES = 8 * HTB, NXCD = 8, WGM = 8;

__host__ __device__ __forceinline__ int lds_byte(int r, int c) { const int st = (r >> 4) * 2 + (c >> 5), rr = r & 15, cc = c & 31, ob = rr * 64 + cc * 2; return st * 1024 + (ob ^ (((ob >> 9) & 1) << 5)); }
__host__ __device__ __forceinline__ void stage_rc(int b, int& R, int& C) { const int st = b / 1024, sb = b % 1024, swz = sb ^ (((sb >> 9) & 1) << 5); R = (st >> 1) * 16 + swz / 64; C = (st & 1) * 32 + (swz % 64) / 2; }
__host__ __device__ __forceinline__ int perm32(int rho) { const int n = rho >> 4, i = rho & 15; return 8 * (i >> 2) + 4 * n + (i & 3); }

struct Unit { int pm, pn; };
struct Gemm { const bf16_t* A; const bf16_t* Bt; int M, N, K; };

struct StaticOrder {
    int nM, nN, nwg, G, c;
    __host__ __device__ void init(int M, int N, int G_, int c_) { nM = M / BM; nN = N / BM; nwg = nM * nN; G = G_; c = c_; }
    __host__ __device__ bool next(int i, Unit& u) const {
        const long L = (long)i * G + c; if (L >= nwg) return false;
        int wgid = (int)L; { const int q = nwg / NXCD, r = nwg % NXCD, xcd = wgid % NXCD, off = wgid / NXCD; wgid = (xcd < r ? xcd * (q + 1) : r * (q + 1) + (xcd - r) * q) + off; }
        const int nig = WGM * nN, gid = wgid / nig, fm = gid * WGM, gsz = (nM - fm) < WGM ? (nM - fm) : WGM;
        u.pm = fm + ((wgid % nig) % gsz); u.pn = (wgid % nig) / gsz; return true;
    }
    __device__ __forceinline__ void a_ready(const Unit&) const {}
    __device__ __forceinline__ void done(const Unit&) const {}
};
__device__ __forceinline__ unsigned cvt_pk_bf16(float lo, float hi) { unsigned r; asm volatile("v_cvt_pk_bf16_f32 %0, %1, %2" : "=v"(r) : "v"(lo), "v"(hi)); return r; }
typedef float f32x2 __attribute__((ext_vector_type(2)));
typedef unsigned u32x2 __attribute__((ext_vector_type(2)));
__device__ __forceinline__ float fast_silu(float g) { return g * __builtin_amdgcn_rcpf(1.0f + __expf(-g)); }
struct EpiGU {
    static constexpr bool PERM = true, AFTER_DRAIN = false;
    bf16_t* O; int ldc;
    __device__ __forceinline__ void operator()(const f32x4 (&acc)[2][2][4][2], const Unit& u, int wr, int wc, int fr, int fq) const {
        const int row0 = u.pm * BM + wr * 64 + fr, col0 = u.pn * HALF + wc * 32 + 8 * fq;
#pragma unroll
        for (int ai = 0; ai < 2; ++ai)
#pragma unroll
            for (int m = 0; m < 4; ++m) { bf16_t* rowp = O + (size_t)(row0 + ai * HALF + m * 16) * ldc + col0;
                const f32x4 g0 = acc[ai][0][m][0], g1 = acc[ai][0][m][1], u0 = acc[ai][1][m][0], u1 = acc[ai][1][m][1];
                f32x4 h0, h1;
#pragma unroll
                for (int j = 0; j < 4; ++j) { h0[j] = fast_silu(g0[j]) * u0[j]; h1[j] = fast_silu(g1[j]) * u1[j]; }
                u32x4 w; w.x = cvt_pk_bf16(h0[0], h0[1]); w.y = cvt_pk_bf16(h0[2], h0[3]); w.z = cvt_pk_bf16(h1[0], h1[1]); w.w = cvt_pk_bf16(h1[2], h1[3]);
                *(u32x4*)rowp = w; }
    }
};
struct EpiZ {
    static constexpr bool PERM = true, AFTER_DRAIN = false;
    bf16_t* O; int ldc;
    __device__ __forceinline__ void operator()(const f32x4 (&acc)[2][2][4][2], const Unit& u, int wr, int wc, int fr, int fq) const {
        const int row0 = u.pm * BM + wr * 64 + fr, col0 = u.pn * BM + wc * 32 + 8 * fq;
#pragma unroll
        for (int ai = 0; ai < 2; ++ai)
#pragma unroll
            for (int m = 0; m < 4; ++m) { bf16_t* rowp = O + (size_t)(row0 + ai * HALF + m * 16) * ldc + col0;
#pragma unroll
                for (int bj = 0; bj < 2; ++bj) { const f32x4 v0 = acc[ai][bj][m][0], v1 = acc[ai][bj][m][1];
                    u32x4 w; w.x = cvt_pk_bf16(v0[0], v0[1]); w.y = cvt_pk_bf16(v0[2], v0[3]); w.z = cvt_pk_bf16(v1[0], v1[1]); w.w = cvt_pk_bf16(v1[2], v1[3]);
                    *(u32x4*)(rowp + bj * HALF) = w; } }
    }
};
struct EpiResid {
    static constexpr bool PERM = false, AFTER_DRAIN = false;
    float* X; int ldc; float scale;
    __device__ __forceinline__ void operator()(const f32x4 (&acc)[2][2][4][2], const Unit& u, int wr, int wc, int fr, int fq) const {
        const int row0 = u.pm * BM + wr * 64 + fr, col0 = u.pn * BM + wc * 32 + 4 * fq;
#pragma unroll
        for (int ai = 0; ai < 2; ++ai)
#pragma unroll
            for (int m = 0; m < 4; ++m) { float* rowp = X + (size_t)(row0 + ai * HALF + m * 16) * ldc + col0;
#pragma unroll
                for (int bj = 0; bj < 2; ++bj)
#pragma unroll
                    for (int n = 0; n < 2; ++n) { f32x4* q = (f32x4*)(rowp + bj * HALF + n * 16); *q = *q + acc[ai][bj][m][n] * scale; } }
    }
};
template <class Epi, class Sched>
__device__ __forceinline__ void gemm_phase(PG8_LAS unsigned char* lds, const Gemm g, const Sched& S, const Epi& E) {
    int tid_o = threadIdx.x; asm volatile("" : "+v"(tid_o));
    const int tid = tid_o, wid = __builtin_amdgcn_readfirstlane(tid >> 6), lane = tid & 63, wr = wid >> 2, wc = wid & 3, fr = lane & 15, fq = lane >> 4;
    const int K = g.K, nt = K / BK;
    unsigned voffA[2], voffB[2];
#pragma unroll
    for (int i = 0; i < 2; ++i) { int R, C; stage_rc(tid * 16 + i * 8192, R, C); const int Rb = Epi::PERM ? ((R & ~31) + perm32(R & 31)) : R;
        voffA[i] = (unsigned)(R * K + C) * 2u; voffB[i] = (unsigned)(Rb * K + C) * 2u; }
    const size_t kstep = (size_t)(BK * 2);
    const size_t hstep = (size_t)HALF * K * 2;
    const size_t tstep = 2 * hstep;
    const unsigned ldsw = (unsigned)wid * 1024u;
    const int aoff = lds_byte(wr * 64 + fr, fq * 8), boff = lds_byte(wc * 32 + fr, fq * 8);
#define PG8_SA(b, h) (((b) * 2 + (h)) * HTB)
#define PG8_SB(b, h) ((4 + (b) * 2 + (h)) * HTB)
#define PG8_STAGE(bufoff, gbase, voff) do { _Pragma("unroll") for (int _i = 0; _i < 2; ++_i) \
        __builtin_amdgcn_global_load_lds((const unsigned*)((const char*)(gbase) + (voff)[_i]), (PG8_LAS unsigned*)(lds + (bufoff) + ldsw + _i * 8192), 16, 0, 0); } while (0)
#define PG8_LDA(dst, b, h) do { _Pragma("unroll") for (int m = 0; m < 4; ++m) _Pragma("unroll") for (int k = 0; k < 2; ++k) dst[m][k] = *(const PG8_LAS bf16x8*)(lds + PG8_SA(b, h) + aoff + m * 2048 + k * 1024); } while (0)
#define PG8_LDB(dst, b, h) do { _Pragma("unroll") for (int n = 0; n < 2; ++n) _Pragma("unroll") for (int k = 0; k < 2; ++k) dst[n][k] = *(const PG8_LAS bf16x8*)(lds + PG8_SB(b, h) + boff + n * 2048 + k * 1024); } while (0)
#define PG8_MMA(ai, bj, At, Bt) do { __builtin_amdgcn_s_setprio(1); _Pragma("unroll") for (int m = 0; m < 4; ++m) _Pragma("unroll") for (int n = 0; n < 2; ++n) _Pragma("unroll") for (int k = 0; k < 2; ++k) \
        acc[ai][bj][m][n] = __builtin_amdgcn_mfma_f32_16x16x32_bf16(Bt[n][k], At[m][k], acc[ai][bj][m][n], 0, 0, 0); __builtin_amdgcn_s_setprio(0); } while (0)
#define PG8_WAIT_V(n) asm volatile("s_waitcnt vmcnt(" #n ")" ::: "memory")
#define PG8_WAIT_L(n) asm volatile("s_waitcnt lgkmcnt(" #n ")" ::: "memory")
#define PG8_BAR __builtin_amdgcn_s_barrier()
#define PG8_SCHED __builtin_amdgcn_sched_barrier(0)
    Unit cur, nxt; int ui = 0;
    if (!S.next(0, cur)) return;
    f32x4 acc[2][2][4][2];
#pragma unroll
    for (int a = 0; a < 2; ++a)
#pragma unroll
        for (int b = 0; b < 2; ++b)
#pragma unroll
            for (int m = 0; m < 4; ++m)
#pragma unroll
                for (int n = 0; n < 2; ++n) acc[a][b][m][n] = (f32x4){0.f, 0.f, 0.f, 0.f};
    bf16x8 At[4][2], B0[2][2], B1[2][2];
    const char* cA = (const char*)g.A + (size_t)cur.pm * tstep; const char* cB = (const char*)g.Bt + (size_t)cur.pn * tstep;
    S.a_ready(cur);
    PG8_STAGE(PG8_SB(0, 0), cB, voffB); PG8_STAGE(PG8_SA(0, 0), cA, voffA); PG8_STAGE(PG8_SB(0, 1), cB + hstep, voffB); PG8_STAGE(PG8_SA(0, 1), cA + hstep, voffA);
    if (wr == 1) PG8_BAR;
    PG8_WAIT_V(4); PG8_BAR;
    PG8_STAGE(PG8_SB(1, 0), cB + kstep, voffB); PG8_STAGE(PG8_SA(1, 0), cA + kstep, voffA); PG8_STAGE(PG8_SB(1, 1), cB + hstep + kstep, voffB);
    PG8_WAIT_V(6); PG8_BAR;
    for (;;) {
        const bool has_next = S.next(ui + 1, nxt);
        const char* nA = has_next ? (const char*)g.A + (size_t)nxt.pm * tstep : cA; const char* nB = has_next ? (const char*)g.Bt + (size_t)nxt.pn * tstep : cB;
        for (int t = 0; t < nt; t += 2) {
            const bool last = (t == nt - 2);
            const char* a1 = cA + (size_t)(t + 1) * kstep;
            const char* a2 = last ? nA : cA + (size_t)(t + 2) * kstep; const char* b2 = last ? nB : cB + (size_t)(t + 2) * kstep;
            const char* a3 = a2 + kstep; const char* b3 = b2 + kstep;
            if (last && has_next) S.a_ready(nxt);
            PG8_LDB(B0, 0, 0); PG8_SCHED; PG8_LDA(At, 0, 0); PG8_STAGE(PG8_SA(1, 1), a1 + hstep, voffA);
            PG8_WAIT_L(8); PG8_BAR; PG8_WAIT_L(0); PG8_MMA(0, 0, At, B0); PG8_BAR; PG8_SCHED;
            PG8_LDB(B1, 0, 1); PG8_STAGE(PG8_SB(0, 0), b2, voffB);
            PG8_BAR; PG8_WAIT_L(0); PG8_MMA(0, 1, At, B1); PG8_BAR;
            PG8_LDA(At, 0, 1); PG8_STAGE(PG8_SA(0, 0), a2, voffA);
            PG8_BAR; PG8_WAIT_L(0); PG8_MMA(1, 0, At, B0); PG8_BAR; PG8_SCHED;
            PG8_STAGE(PG8_SB(0, 1), b2 + hstep, voffB);
            PG8_WAIT_V(6); PG8_BAR; PG8_MMA(1, 1, At, B1); PG8_BAR;
            PG8_LDB(B0, 1, 0); PG8_SCHED; PG8_LDA(At, 1, 0); PG8_STAGE(PG8_SA(0, 1), a2 + hstep, voffA);
            PG8_WAIT_L(8); PG8_BAR; PG8_WAIT_L(0); PG8_MMA(0, 0, At, B0); PG8_BAR; PG8_SCHED;
            PG8_LDB(B1, 1, 1); PG8_STAGE(PG8_SB(1, 0), b3, voffB);
            PG8_BAR; PG8_WAIT_L(0); PG8_MMA(0, 1, At, B1); PG8_BAR;
            PG8_LDA(At, 1, 1); PG8_STAGE(PG8_SA(1, 0), a3, voffA);
            PG8_BAR; PG8_WAIT_L(0); PG8_MMA(1, 0, At, B0); PG8_BAR; PG8_SCHED;
            PG8_STAGE(PG8_SB(1, 1), b3 + hstep, voffB);
            PG8_WAIT_V(6); PG8_BAR; PG8_MMA(1, 1, At, B1); PG8_BAR;
        }
        if constexpr (!Epi::AFTER_DRAIN) { E(acc, cur, wr, wc, fr, fq); S.done(cur); }
        if (!has_next) break;
#pragma unroll
        for (int a = 0; a < 2; ++a)
#pragma unroll
            for (int b = 0; b < 2; ++b)
#pragma unroll
                for (int m = 0; m < 4; ++m)
#pragma unroll
                    for (int n = 0; n < 2; ++n) acc[a][b][m][n] = (f32x4){0.f, 0.f, 0.f, 0.f};
        cur = nxt; cA = nA; cB = nB; ++ui;
    }
    PG8_WAIT_V(0);
    if (wr == 0) PG8_BAR;
    PG8_BAR;
    if constexpr (Epi::AFTER_DRAIN) { E.fused(acc, cur, wr, wc, fr, fq, lds, wid, lane); S.done(cur); }
#undef PG8_SA
#undef PG8_SB
#undef PG8_STAGE
#undef PG8_LDA
#undef PG8_LDB
#undef PG8_MMA
#undef PG8_WAIT_V
#undef PG8_WAIT_L
#undef PG8_BAR
#undef PG8_SCHED
}
}
#ifndef PH
#define PH 0xFFFF
#endif
typedef unsigned short u16;
typedef float f32x4 __attribute__((ext_vector_type(4)));
typedef float f32x2 __attribute__((ext_vector_type(2)));
typedef unsigned u32x4 __attribute__((ext_vector_type(4)));
typedef unsigned u32x2 __attribute__((ext_vector_type(2)));
typedef _Float16 h16;
typedef _Float16 h16x4 __attribute__((ext_vector_type(4)));
typedef _Float16 h16x8 __attribute__((ext_vector_type(8)));
typedef _Float16 h16x2 __attribute__((ext_vector_type(2)));
#define LAS __attribute__((address_space(3)))

constexpr int MT = 32768, TS = 16384, DM = 2048, DFF = 5632;
constexpr int LDS_BYTES = 144 * 1024;
constexpr size_t WS_HBUF = 0;
constexpr size_t WS_WBUF = 134217728;
constexpr size_t WS_WGU = WS_WBUF, WS_WD = WS_WBUF + 46137344;
constexpr size_t WS_WIN = WS_WBUF, WS_WOUT = WS_WBUF + 28311552;
constexpr size_t WS_ACT = WS_WBUF + 69206016;
constexpr size_t WS_Z = WS_WBUF + 36700160;
constexpr size_t WS_RWP = WS_Z + 285212672;
constexpr size_t WS_RWS = WS_RWP + 301989888;
constexpr size_t WS_ZG = WS_RWS + 6291456;
constexpr size_t WS_GDP = WS_ZG + 8388608;
constexpr size_t WS_GDS = WS_GDP + 150994944;
constexpr size_t WS_LRA = WS_GDS + 3145728;
constexpr size_t WS_LRU = WS_LRA + 67108864;
constexpr size_t WS_END = WS_LRU + 67108864;
static_assert(WS_END <= 1073741824ull, "workspace");
constexpr int Z1_LD = 2560, Z2_LD = 4352;
constexpr int Z2_GATE = 2304, Z2_XL = 3072, Z2_YL = 3584, Z2_ZB = 4096, Z2_ZA = 4102;

struct Params { const float* in[35]; float* out; unsigned char* ws; };

__device__ __forceinline__ int otid() { int t = threadIdx.x; asm volatile("" : "+v"(t)); return t; }
__device__ __forceinline__ int obid() { int t = blockIdx.x; asm volatile("" : "+s"(t)); return t; }
__device__ __forceinline__ int ogrid() { int t = gridDim.x; asm volatile("" : "+s"(t)); return t; }
__device__ __forceinline__ float bf2f(u16 h) { return __uint_as_float((unsigned)h << 16); }
__device__ __forceinline__ float bflo(unsigned w) { return __uint_as_float(w << 16); }
__device__ __forceinline__ float bfhi(unsigned w) { return __uint_as_float(w & 0xffff0000u); }
__device__ __forceinline__ u16 f2bf(float f) { unsigned u = __float_as_uint(f); u += 0x7FFFu + ((u >> 16) & 1u); return (u16)(u >> 16); }
__device__ __forceinline__ unsigned pk_bf(float lo, float hi) { return pg8::cvt_pk_bf16(lo, hi); }
template <int C> __device__ __forceinline__ float dppf(float v) { return __int_as_float(__builtin_amdgcn_update_dpp(0, __float_as_int(v), C, 0xF, 0xF, true)); }
__device__ __forceinline__ float red16(float v) { v += dppf<0xB1>(v); v += dppf<0x4E>(v); v += dppf<0x141>(v); v += dppf<0x140>(v); return v; }
__device__ __forceinline__ float rlane(float v, int l) { return __int_as_float(__builtin_amdgcn_readlane(__float_as_int(v), l)); }
__device__ __forceinline__ float wave_sum(float v) { v = red16(v); return (rlane(v, 0) + rlane(v, 16)) + (rlane(v, 32) + rlane(v, 48)); }
__device__ __forceinline__ float sigm(float x) { return 1.0f / (1.0f + __expf(-x)); }
__device__ __forceinline__ float softplus_(float x) { return fmaxf(x, 0.0f) + log1pf(__expf(-fabsf(x))); }
__device__ __forceinline__ float tanh_(float x) { const float e = __expf(-2.0f * fabsf(x)); const float t = (1.0f - e) / (1.0f + e); return x < 0.f ? -t : t; }
__device__ __forceinline__ float gelu_tanh(float x) { return 0.5f * x * (1.0f + tanh_(0.7978845608028654f * (x + 0.044715f * x * x * x))); }

template <int MAP> __device__ __forceinline__ int rowmap(int n) {
    if (MAP == 0) return n;
    if (MAP == 1) return (n >> 7) * 256 + (n & 127);
    if (MAP == 2) return (n >> 7) * 256 + 128 + (n & 127);
    if (n < 2560 + 3072) return n;
    const int q = n - 2560;
    if (q < 3084) return 2560 + Z2_ZB + (q - 3072);
    return 2560 + Z2_XL + (q - 3084);
}
template <int MAP> __device__ __forceinline__ void conv_w(const float* __restrict__ src, u16* __restrict__ dst, int K, int N, LAS float* tile) {
    const int tid = otid(), NT = (N + 63) >> 6, KT = K >> 6; const int bidx = obid(), gdim = ogrid();
    for (int t = bidx; t < NT * KT; t += gdim) {
        const int nt = t % NT, kt = t / NT;
        const int c = tid & 63, r0 = tid >> 6, n = nt * 64 + c;
#pragma unroll
        for (int i = 0; i < 8; ++i) { const int r = r0 + 8 * i; tile[r * 65 + c] = (n < N) ? src[(size_t)(kt * 64 + r) * N + n] : 0.f; }
        __syncthreads();
        const int nl = tid >> 3, kq = tid & 7, n2 = nt * 64 + nl;
        if (n2 < N) {
            float v[8];
#pragma unroll
            for (int j = 0; j < 8; ++j) v[j] = tile[(kq * 8 + j) * 65 + nl];
            u32x4 w; w.x = pk_bf(v[0], v[1]); w.y = pk_bf(v[2], v[3]); w.z = pk_bf(v[4], v[5]); w.w = pk_bf(v[6], v[7]);
            *(u32x4*)(dst + (size_t)rowmap<MAP>(n2) * K + kt * 64 + kq * 8) = w;
        }
        __syncthreads();
    }
}

template <bool FINAL> __device__ __forceinline__ void norm_rows(const float* src, const float* __restrict__ gamma, u16* dst, float* copy) {
    const int tid_ = otid(); const int lane = tid_ & 63, wid = tid_ >> 6; const int bidx = obid(), gdim = ogrid();
    f32x4 g[8];
#pragma unroll
    for (int i = 0; i < 8; ++i) g[i] = *(const f32x4*)(gamma + i * 256 + lane * 4);
    for (int row = bidx * 8 + wid; row < MT; row += gdim * 8) {
        const float* p = src + (size_t)row * DM; f32x4 v[8]; float ss = 0.f;
#pragma unroll
        for (int i = 0; i < 8; ++i) { v[i] = *(const f32x4*)(p + i * 256 + lane * 4); ss += v[i][0] * v[i][0] + v[i][1] * v[i][1] + v[i][2] * v[i][2] + v[i][3] * v[i][3]; }
        ss = wave_sum(ss);
        const float rs = rsqrtf(ss * (1.0f / 2048.0f) + 1e-6f);
#pragma unroll
        for (int i = 0; i < 8; ++i) {
            const f32x4 o = v[i] * rs * g[i];
            if (FINAL) { *(f32x4*)(copy + (size_t)row * DM + i * 256 + lane * 4) = o; }
            else { u32x2 w; w.x = pk_bf(o[0], o[1]); w.y = pk_bf(o[2], o[3]); *(u32x2*)(dst + (size_t)row * DM + i * 256 + lane * 4) = w;
                   if (copy) *(f32x4*)(copy + (size_t)row * DM + i * 256 + lane * 4) = v[i]; }
        }
    }
}

struct RwP { const float *mu, *w0, *w2, *a0, *a2, *kk, *ka, *rk; };
__device__ __forceinline__ void prep_rw(const u16* __restrict__ Z1, const RwP P, h16* __restrict__ RWP, float* __restrict__ RWS, u16* __restrict__ ZG, LAS float* L) {
    const int tid = otid(), lane = tid & 63; const int bidx = obid(), gdim = ogrid();
    for (int tile = bidx; tile < MT / 16; tile += gdim) {
        const int m0 = tile * 16;
#pragma unroll
        for (int i = 0; i < 8; ++i) {
            const int idx = tid + 512 * i, tok = idx >> 8, cc = idx & 255, m = m0 + tok, c = 2304 + cc;
            const float zc = bf2f(Z1[(size_t)m * Z1_LD + c]);
            const float zp = ((m & (TS - 1)) == 0) ? 0.f : bf2f(Z1[(size_t)(m - 1) * Z1_LD + c]);
            const float zf = zc + P.mu[c] * (zp - zc);
            if (cc < 64) L[cc * 16 + tok] = tanh_(zf);
            else if (cc < 128) L[cc * 16 + tok] = zf;
            else ZG[(size_t)m * 128 + (cc - 128)] = f2bf(sigm(zf));
        }
        __syncthreads();
        const int jj = tid & 255, th = tid >> 8;
        for (int cgi = 0; cgi < 3; ++cgi) {
            const int j = jj + 256 * cgi;
            float aw[8], aa[8];
            { const float w0v = P.w0[j], a0v = P.a0[j];
#pragma unroll
              for (int k = 0; k < 8; ++k) { aw[k] = w0v; aa[k] = a0v; } }
#pragma unroll 4
            for (int i = 0; i < 64; ++i) {
                const float w2v = P.w2[i * 768 + j], a2v = P.a2[i * 768 + j];
                const f32x4 t0 = *(const LAS f32x4*)(L + i * 16 + th * 8), t1 = *(const LAS f32x4*)(L + i * 16 + th * 8 + 4);
                const f32x4 y0 = *(const LAS f32x4*)(L + (64 + i) * 16 + th * 8), y1 = *(const LAS f32x4*)(L + (64 + i) * 16 + th * 8 + 4);
#pragma unroll
                for (int k = 0; k < 4; ++k) { aw[k] += t0[k] * w2v; aw[4 + k] += t1[k] * w2v; aa[k] += y0[k] * a2v; aa[4 + k] += y1[k] * a2v; }
            }
            const float mur = P.mu[j], muk = P.mu[768 + j], muv = P.mu[1536 + j];
            const float kkc = P.kk[j], kac = P.ka[j], rkc = P.rk[j];
            const int hh = j >> 6;
            const int mA = m0 + th * 8;
            float pr = 0.f, pk = 0.f, pv = 0.f;
            if ((mA & (TS - 1)) != 0) { const u16* zp = Z1 + (size_t)(mA - 1) * Z1_LD; pr = bf2f(zp[j]); pk = bf2f(zp[768 + j]); pv = bf2f(zp[1536 + j]); }
#pragma unroll
            for (int tk = 0; tk < 8; ++tk) {
                const int m = mA + tk, b = m >> 14, t = m & (TS - 1);
                const u16* zc = Z1 + (size_t)m * Z1_LD;
                const float cr = bf2f(zc[j]), ck = bf2f(zc[768 + j]), cv = bf2f(zc[1536 + j]);
                const float r = cr + mur * (pr - cr), k = ck + muk * (pk - ck), v = cv + muv * (pv - cv);
                pr = cr; pk = ck; pv = cv;
                const float wlog = -softplus_(-aw[tk]) - 0.5f;
                const float e = __expf(wlog);
                const float dl = -expm1f(-e);
                const float w = 1.0f - dl;
                const float a = sigm(aa[tk]);
                const float kq = k * kkc;
                const float ss = wave_sum(kq * kq);
                const float kkn = kq * rsqrtf(ss + 1e-12f);
                const float kp = k * (1.0f + (a - 1.0f) * kac);
                const float bb = kkn * a;
                const float br = wave_sum(bb * r), kr = wave_sum(kp * r), bonus = wave_sum(r * kp * rkc);
                const size_t rec = (size_t)(b * 12 + hh) * TS + t;
                h16* o = RWP + rec * 384 + lane;
                o[0] = (h16)kkn; o[64] = (h16)bb; o[128] = (h16)kp; o[192] = (h16)(w * r); o[256] = (h16)dl; o[320] = (h16)v;
                if (lane == 0) { f32x4 s; s[0] = br; s[1] = kr; s[2] = bonus; s[3] = 0.f; *(f32x4*)(RWS + rec * 4) = s; }
            }
        }
        __syncthreads();
    }
}

__device__ __forceinline__ void prep_gd(const u16* __restrict__ Z2, const float* __restrict__ cw, const float* __restrict__ alog, const float* __restrict__ dtb,
                                        h16* __restrict__ GDP, float* __restrict__ GDS) {
    const int tid_ = otid(); const int lane = tid_ & 63, wid = tid_ >> 6; const int bidx = obid(), gdim = ogrid();
    for (int task = bidx * 8 + wid; task < 6 * (MT / 64); task += gdim * 8) {
        const int hh = task % 6, chunk = task / 6, m0 = chunk * 64, b = m0 >> 14, t0 = m0 & (TS - 1);
        const int cq = hh * 128 + 2 * lane;
        float w[3][4][2];
#pragma unroll
        for (int a = 0; a < 3; ++a)
#pragma unroll
            for (int i = 0; i < 4; ++i) { const f32x2 q = *(const f32x2*)(cw + i * 2304 + a * 768 + cq); w[a][i][0] = q[0]; w[a][i][1] = q[1]; }
        float x[3][3][2];
#pragma unroll
        for (int a = 0; a < 3; ++a)
#pragma unroll
            for (int d = 0; d < 3; ++d) {
                unsigned wv = 0u;
                if (t0 != 0) wv = *(const unsigned*)(Z2 + (size_t)(m0 - 3 + d) * Z2_LD + a * 768 + cq);
                x[a][d][0] = bflo(wv); x[a][d][1] = bfhi(wv);
            }
        const float An = -__expf(alog[hh]), dtbv = dtb[hh];
        for (int s = 0; s < 64; ++s) {
            const int m = m0 + s;
            const u16* zr = Z2 + (size_t)m * Z2_LD;
            float y[3][2];
#pragma unroll
            for (int a = 0; a < 3; ++a) {
                const unsigned wv = *(const unsigned*)(zr + a * 768 + cq);
                const float c0 = bflo(wv), c1 = bfhi(wv);
                const float s0 = x[a][0][0] * w[a][0][0] + x[a][1][0] * w[a][1][0] + x[a][2][0] * w[a][2][0] + c0 * w[a][3][0];
                const float s1 = x[a][0][1] * w[a][0][1] + x[a][1][1] * w[a][1][1] + x[a][2][1] * w[a][2][1] + c1 * w[a][3][1];
                x[a][0][0] = x[a][1][0]; x[a][1][0] = x[a][2][0]; x[a][2][0] = c0;
                x[a][0][1] = x[a][1][1]; x[a][1][1] = x[a][2][1]; x[a][2][1] = c1;
                y[a][0] = s0 * sigm(s0); y[a][1] = s1 * sigm(s1);
            }
            const float sq = wave_sum(y[0][0] * y[0][0] + y[0][1] * y[0][1]);
            const float sk = wave_sum(y[1][0] * y[1][0] + y[1][1] * y[1][1]);
            const float rq = rsqrtf(sq + 1e-12f) * 0.08838834764831845f, rk = rsqrtf(sk + 1e-12f);
            const float q0 = y[0][0] * rq, q1 = y[0][1] * rq, k0 = y[1][0] * rk, k1 = y[1][1] * rk;
            const float qk = wave_sum(q0 * k0 + q1 * k1);
            const size_t rec = (size_t)(b * 6 + hh) * TS + (t0 + s);
            h16* o = GDP + rec * 384 + 2 * lane;
            h16x2 kv; kv[0] = (h16)k0; kv[1] = (h16)k1; *(h16x2*)(o) = kv;
            h16x2 qv; qv[0] = (h16)q0; qv[1] = (h16)q1; *(h16x2*)(o + 128) = qv;
            h16x2 vv; vv[0] = (h16)y[2][0]; vv[1] = (h16)y[2][1]; *(h16x2*)(o + 256) = vv;
            if (lane == 0) {
                const float beta = sigm(bf2f(zr[Z2_ZB + hh]));
                const float g = An * softplus_(bf2f(zr[Z2_ZA + hh]) + dtbv);
                f32x4 sc; sc[0] = __expf(g); sc[1] = beta; sc[2] = qk; sc[3] = 0.f; *(f32x4*)(GDS + rec * 4) = sc;
            }
        }
    }
}

struct LrP { const float *cw, *cb, *wa, *ba, *wx, *bx, *lam; };
__device__ __forceinline__ void prep_lr(const u16* __restrict__ Z2, const LrP P, float* __restrict__ LRA, float* __restrict__ LRUb) {
    const int tid_ = otid(); const int lane = tid_ & 63, wid = tid_ >> 6; const int bidx = obid(), gdim = ogrid();
    for (int task = bidx * 8 + wid; task < 8 * (MT / 64); task += gdim * 8) {
        const int n = task & 7, chunk = task >> 3, m0 = chunk * 64, t0 = m0 & (TS - 1);
        const int ch = n * 64 + lane;
        float wa[64], wx[64];
#pragma unroll
        for (int c = 0; c < 64; ++c) { wa[c] = P.wa[(size_t)(n * 64 + c) * 64 + lane]; wx[c] = P.wx[(size_t)(n * 64 + c) * 64 + lane]; }
        const float c0 = P.cw[ch], c1 = P.cw[512 + ch], c2 = P.cw[1024 + ch], c3 = P.cw[1536 + ch], cb = P.cb[ch];
        const float ba = P.ba[ch], bx = P.bx[ch];
        const float spl = -8.0f * softplus_(-P.lam[ch]);
        float x0 = 0.f, x1 = 0.f, x2 = 0.f;
        if (t0 != 0) { x0 = bf2f(Z2[(size_t)(m0 - 3) * Z2_LD + Z2_XL + ch]); x1 = bf2f(Z2[(size_t)(m0 - 2) * Z2_LD + Z2_XL + ch]); x2 = bf2f(Z2[(size_t)(m0 - 1) * Z2_LD + Z2_XL + ch]); }
        for (int s = 0; s < 64; ++s) {
            const int m = m0 + s;
            const float xc_in = bf2f(Z2[(size_t)m * Z2_LD + Z2_XL + ch]);
            const float xc = x0 * c0 + x1 * c1 + x2 * c2 + xc_in * c3 + cb;
            x0 = x1; x1 = x2; x2 = xc_in;
            float ra = ba, rx = bx;
#pragma unroll
            for (int c = 0; c < 64; ++c) { const float xv = rlane(xc, c); ra += xv * wa[c]; rx += xv * wx[c]; }
            const float r = sigm(ra), ig = sigm(rx);
            const float la = spl * r;
            const float a = __expf(la);
            const float u = sqrtf(-expm1f(2.0f * la)) * (ig * xc);
            LRA[(size_t)m * 512 + ch] = a; LRUb[(size_t)m * 512 + ch] = u;
        }
    }
}

constexpr int RC = 64;
constexpr int RBUF = RC * 768 + RC * 16;
template <int KIND> __device__ __forceinline__ void rec_block(const unsigned char* __restrict__ gp, const unsigned char* __restrict__ gs, u16* __restrict__ outp  ,
                                                             int rowl0  , LAS unsigned char* lds) {
    const int tid = otid(), lane = tid & 63, wid = tid >> 6, g = lane >> 4, j = lane & 15;
    const int rowl = rowl0 + wid * 4 + g;
    u32x4 st[6], ss;
#pragma unroll
    for (int i = 0; i < 6; ++i) st[i] = *(const u32x4*)(gp + (size_t)(tid + 512 * i) * 16);
    if (tid < RC) ss = *(const u32x4*)(gs + tid * 16);
#pragma unroll
    for (int i = 0; i < 6; ++i) *(LAS u32x4*)(lds + (tid + 512 * i) * 16) = st[i];
    if (tid < RC) *(LAS u32x4*)(lds + RC * 768 + tid * 16) = ss;
    __syncthreads();
    float S[8];
#pragma unroll
    for (int i = 0; i < 8; ++i) S[i] = 0.f;
    for (int c = 0; c < TS / RC; ++c) {
        const bool more = (c + 1 < TS / RC);
        if (more) {
            const unsigned char* np = gp + (size_t)(c + 1) * RC * 768; const unsigned char* ns = gs + (size_t)(c + 1) * RC * 16;
#pragma unroll
            for (int i = 0; i < 6; ++i) st[i] = *(const u32x4*)(np + (size_t)(tid + 512 * i) * 16);
            if (tid < RC) ss = *(const u32x4*)(ns + tid * 16);
        }
        if (wid < 4) {
            const LAS unsigned char* B = lds + (c & 1) * RBUF;
            u16* op = outp + (size_t)c * RC * DM + (wid * 4 + g);
#pragma unroll 4
            for (int s = 0; s < RC; ++s) {
                const LAS unsigned char* Pp = B + s * 768;
                if (KIND == 0) {
                    const h16x4 kk = *(const LAS h16x4*)(Pp + j * 8), bb = *(const LAS h16x4*)(Pp + 128 + j * 8), kp = *(const LAS h16x4*)(Pp + 256 + j * 8),
                                wr = *(const LAS h16x4*)(Pp + 384 + j * 8), dl = *(const LAS h16x4*)(Pp + 512 + j * 8);
                    const float v = (float)*(const LAS h16*)(Pp + 640 + rowl * 2);
                    const f32x2 sc = *(const LAS f32x2*)(B + RC * 768 + s * 16);
                    float p1 = 0.f, p2 = 0.f;
#pragma unroll
                    for (int i = 0; i < 4; ++i) { p1 += S[i] * (float)kk[i]; p2 += S[i] * (float)wr[i]; }
                    p1 = red16(p1); p2 = red16(p2);
                    const float y = p2 - p1 * sc[0] + v * sc[1];
                    if (j == 0) op[(size_t)s * DM] = f2bf(y);
#pragma unroll
                    for (int i = 0; i < 4; ++i) { const float u = v * (float)kp[i] - p1 * (float)bb[i]; S[i] = S[i] * (1.0f - (float)dl[i]) + u; }
                } else {
                    const h16x8 kv = *(const LAS h16x8*)(Pp + j * 16), qv = *(const LAS h16x8*)(Pp + 256 + j * 16);
                    const float v = (float)*(const LAS h16*)(Pp + 512 + rowl * 2);
                    const f32x4 sc = *(const LAS f32x4*)(B + RC * 768 + s * 16);
                    float p1 = 0.f, p2 = 0.f;
#pragma unroll
                    for (int i = 0; i < 8; ++i) { p1 += S[i] * (float)kv[i]; p2 += S[i] * (float)qv[i]; }
                    p1 = red16(p1); p2 = red16(p2);
                    const float vn = sc[1] * (v - sc[0] * p1);
                    const float o = sc[0] * p2 + sc[2] * vn;
                    if (j == 0) op[(size_t)s * DM] = f2bf(o);
#pragma unroll
                    for (int i = 0; i < 8; ++i) S[i] = S[i] * sc[0] + (float)kv[i] * vn;
                }
            }
        }
        if (more) {
            LAS unsigned char* Bn = lds + ((c + 1) & 1) * RBUF;
#pragma unroll
            for (int i = 0; i < 6; ++i) *(LAS u32x4*)(Bn + (tid + 512 * i) * 16) = st[i];
            if (tid < RC) *(LAS u32x4*)(Bn + RC * 768 + tid * 16) = ss;
        }
        __syncthreads();
    }
}
__device__ __forceinline__ void lru_scan(int grp  , const float* __restrict__ LRA, const float* __restrict__ LRUb, const u16* __restrict__ Z2, u16* __restrict__ MIX) {
    const int lane = otid() & 63;
    const int b = grp >> 3, ch = (grp & 7) * 64 + lane;
    float h = 0.f;
    for (int t = 0; t < TS; t += 8) {
        float a[8], u[8], y[8];
#pragma unroll
        for (int k = 0; k < 8; ++k) { const size_t m = (size_t)b * TS + t + k; a[k] = LRA[m * 512 + ch]; u[k] = LRUb[m * 512 + ch]; y[k] = bf2f(Z2[m * Z2_LD + Z2_YL + ch]); }
#pragma unroll
        for (int k = 0; k < 8; ++k) { const size_t m = (size_t)b * TS + t + k; h = a[k] * h + u[k]; MIX[m * DM + 1536 + ch] = f2bf(h * gelu_tanh(y[k])); }
    }
}

__device__ __forceinline__ void post_rw(u16* __restrict__ MIX, const h16* __restrict__ RWP, const float* __restrict__ RWS, const u16* __restrict__ ZG,
                                        const float* __restrict__ g2, const float* __restrict__ lng, const float* __restrict__ lnb) {
    const int tid_ = otid(); const int lane = tid_ & 63, wid = tid_ >> 6; const int bidx = obid(), gdim = ogrid();
    for (int task = bidx * 8 + wid; task < 12 * (MT / 64); task += gdim * 8) {
        const int hh = task % 12, chunk = task / 12, m0 = chunk * 64, b = m0 >> 14, t0 = m0 & (TS - 1);
        const int col = hh * 64 + lane;
        float gc[128];
#pragma unroll
        for (int i = 0; i < 128; ++i) gc[i] = g2[i * 768 + col];
        const float lg = lng[col], lb = lnb[col];
        for (int s = 0; s < 64; ++s) {
            const int m = m0 + s;
            const size_t rec = (size_t)(b * 12 + hh) * TS + (t0 + s);
            const float y = bf2f(MIX[(size_t)m * DM + col]);
            const float mean = wave_sum(y) * (1.0f / 64.0f);
            const float d = y - mean;
            const float var = wave_sum(d * d) * (1.0f / 64.0f);
            const float yn = d * rsqrtf(var + 64e-5f) * lg + lb;
            const float v = (float)RWP[rec * 384 + 320 + lane];
            const float bonus = RWS[rec * 4 + 2];
            const unsigned sw = *(const unsigned*)(ZG + (size_t)m * 128 + 2 * lane);
            const float s0 = bflo(sw), s1 = bfhi(sw);
            float ga = 0.f, gb = 0.f;
#pragma unroll
            for (int i = 0; i < 64; ++i) { ga += rlane(s0, i) * gc[2 * i]; gb += rlane(s1, i) * gc[2 * i + 1]; }
            MIX[(size_t)m * DM + col] = f2bf((yn + bonus * v) * (ga + gb));
        }
    }
}
__device__ __forceinline__ void post_gd(u16* __restrict__ MIX, const u16* __restrict__ Z2, const float* __restrict__ ng) {
    const int tid_ = otid(); const int lane = tid_ & 63, wid = tid_ >> 6; const int bidx = obid(), gdim = ogrid();
    for (int task = bidx * 8 + wid; task < 6 * (MT / 64); task += gdim * 8) {
        const int hh = task % 6, chunk = task / 6, m0 = chunk * 64;
        const float n0 = ng[2 * lane], n1 = ng[2 * lane + 1];
        for (int s = 0; s < 64; ++s) {
            const int m = m0 + s;
            unsigned* op = (unsigned*)(MIX + (size_t)m * DM + 768 + hh * 128 + 2 * lane);
            const unsigned ow = *op;
            const float o0 = bflo(ow), o1 = bfhi(ow);
            const float ss = wave_sum(o0 * o0 + o1 * o1);
            const float rs = rsqrtf(ss * (1.0f / 128.0f) + 1e-6f);
            const unsigned gw = *(const unsigned*)(Z2 + (size_t)m * Z2_LD + Z2_GATE + hh * 128 + 2 * lane);
            const float g0 = bflo(gw), g1 = bfhi(gw);
            *op = pk_bf(o0 * rs * n0 * (g0 * sigm(g0)), o1 * rs * n1 * (g1 * sigm(g1)));
        }
    }
}

__device__ __forceinline__ const float* getp(const LAS unsigned* TAB, int k) {
    const unsigned lo = __builtin_amdgcn_readfirstlane(TAB[2 * k]), hi = __builtin_amdgcn_readfirstlane(TAB[2 * k + 1]);
    return (const float*)(((unsigned long long)hi << 32) | lo);
}
__global__ void __launch_bounds__(512, 2) fwd_mega(Params p) {
    extern __shared__ __attribute__((aligned(16))) unsigned char lds_raw[];
    LAS unsigned char* lds = (LAS unsigned char*)lds_raw;
    cg::grid_group grid = cg::this_grid();
    unsigned char* ws = p.ws;
    u16* HBUF = (u16*)(ws + WS_HBUF); u16* WGU = (u16*)(ws + WS_WGU); u16* WD = (u16*)(ws + WS_WD); u16* WIN = (u16*)(ws + WS_WIN); u16* WOUT = (u16*)(ws + WS_WOUT);
    u16* ACT = (u16*)(ws + WS_ACT); u16* Z = (u16*)(ws + WS_Z); h16* RWPp = (h16*)(ws + WS_RWP); float* RWSp = (float*)(ws + WS_RWS); u16* ZG = (u16*)(ws + WS_ZG);
    h16* GDPp = (h16*)(ws + WS_GDP); float* GDSp = (float*)(ws + WS_GDS); float* LRA = (float*)(ws + WS_LRA); float* LRUb = (float*)(ws + WS_LRU);
    float* X = p.out;
    const int G = gridDim.x, bid = blockIdx.x;
    LAS unsigned* TAB = (LAS unsigned*)(lds + 131072 + 1024);
    if (threadIdx.x == 0) {
#pragma unroll
        for (int i = 0; i < 35; ++i) { const unsigned long long a = (unsigned long long)p.in[i]; TAB[2 * i] = (unsigned)a; TAB[2 * i + 1] = (unsigned)(a >> 32); }
    }
    __syncthreads();
#define INP(k) getp(TAB, (k))

    for (int l = 0; l < 2; ++l) {
        for (int half = 0; half < 2; ++half) {
            const float* ng = INP(half ? 30 : 1) + (size_t)l * DM;
            const float* wg = INP(half ? 31 : 2) + (size_t)l * DM * DFF;
            const float* wu = INP(half ? 32 : 3) + (size_t)l * DM * DFF;
            const float* wd = INP(half ? 33 : 4) + (size_t)l * DM * DFF;
#if PH & 1
            conv_w<1>(wg, WGU, DM, DFF, (LAS float*)lds);
            conv_w<2>(wu, WGU, DM, DFF, (LAS float*)lds);
            conv_w<0>(wd, WD, DFF, DM, (LAS float*)lds);
#endif
#if PH & 2
            if (l == 0 && half == 0) norm_rows<false>(INP(0), ng, HBUF, X); else norm_rows<false>(X, ng, HBUF, nullptr);
#endif
            grid.sync();
#if PH & 4
            { pg8::Gemm g{HBUF, WGU, MT, 2 * DFF, DM}; pg8::StaticOrder S; S.init(MT, 2 * DFF, G, bid); pg8::EpiGU E{ACT, DFF};
              pg8::gemm_phase<pg8::EpiGU, pg8::StaticOrder>(lds, g, S, E); }
#endif
            grid.sync();
#if PH & 8
            { pg8::Gemm g{ACT, WD, MT, DM, DFF}; pg8::StaticOrder S; S.init(MT, DM, G, bid); pg8::EpiResid E{X, DM, 0.5f};
              pg8::gemm_phase<pg8::EpiResid, pg8::StaticOrder>(lds, g, S, E); }
#endif
            grid.sync();
            if (half == 1) continue;
#if PH & 16
            conv_w<3>(INP(6) + (size_t)l * DM * 6668, WIN, DM, 6668, (LAS float*)lds);
            conv_w<0>(INP(29) + (size_t)l * DM * DM, WOUT, DM, DM, (LAS float*)lds);
            norm_rows<false>(X, INP(5) + (size_t)l * DM, HBUF, nullptr);
#endif
            grid.sync();
#if PH & 32
            { pg8::Gemm g{HBUF, WIN, MT, 2560, DM}; pg8::StaticOrder S; S.init(MT, 2560, G, bid); pg8::EpiZ E{Z, Z1_LD};
              pg8::gemm_phase<pg8::EpiZ, pg8::StaticOrder>(lds, g, S, E); }
#endif
            grid.sync();
#if PH & 64
            { RwP P{INP(7) + l * 2560, INP(8) + l * 768, INP(9) + l * 64 * 768, INP(10) + l * 768, INP(11) + l * 64 * 768, INP(13) + l * 768, INP(14) + l * 768, INP(15) + l * 768};
              prep_rw(Z, P, RWPp, RWSp, ZG, (LAS float*)lds); }
#endif
            grid.sync();
#if PH & 128
            { pg8::Gemm g{HBUF, WIN + (size_t)2560 * DM, MT, 4352, DM}; pg8::StaticOrder S; S.init(MT, 4352, G, bid); pg8::EpiZ E{Z, Z2_LD};
              pg8::gemm_phase<pg8::EpiZ, pg8::StaticOrder>(lds, g, S, E); }
#endif
            grid.sync();
#if PH & 256
            prep_gd(Z, INP(18) + l * 4 * 2304, INP(19) + l * 6, INP(20) + l * 6, GDPp, GDSp);
#endif
#if PH & 512
            { LrP P{INP(22) + l * 4 * 512, INP(23) + l * 512, INP(24) + l * 8 * 64 * 64, INP(25) + l * 512, INP(26) + l * 8 * 64 * 64, INP(27) + l * 512, INP(28) + l * 512};
              prep_lr(Z, P, LRA, LRUb); }
#endif
            grid.sync();
#if PH & 1024
            for (int task = bid; task < 208; task += G) {
                if (task < 96) { const int bh = task >> 2, q4 = task & 3, b = bh / 12, hh = bh % 12;
                    rec_block<0>((const unsigned char*)RWPp + (size_t)bh * TS * 768, (const unsigned char*)RWSp + (size_t)bh * TS * 16,
                                 HBUF + (size_t)b * TS * DM + hh * 64 + q4 * 16, q4 * 16, lds); }
                else if (task < 192) { const int gb = task - 96, bh = gb >> 3, o8 = gb & 7, b = bh / 6, hh = bh % 6;
                    rec_block<1>((const unsigned char*)GDPp + (size_t)bh * TS * 768, (const unsigned char*)GDSp + (size_t)bh * TS * 16,
                                 HBUF + (size_t)b * TS * DM + 768 + hh * 128 + o8 * 16, o8 * 16, lds); }
                else if (threadIdx.x < 64) lru_scan(task - 192, LRA, LRUb, Z, HBUF);
            }
#endif
            grid.sync();
#if PH & 2048
            post_rw(HBUF, RWPp, RWSp, ZG, INP(12) + l * 128 * 768, INP(16) + l * 768, INP(17) + l * 768);
#endif
#if PH & 4096
            post_gd(HBUF, Z, INP(21) + l * 128);
#endif
            grid.sync();
#if PH & 8192
            { pg8::Gemm g{HBUF, WOUT, MT, DM, DM}; pg8::StaticOrder S; S.init(MT, DM, G, bid); pg8::EpiResid E{X, DM, 1.0f};
              pg8::gemm_phase<pg8::EpiResid, pg8::StaticOrder>(lds, g, S, E); }
#endif
            grid.sync();
        }
    }
    norm_rows<true>(X, INP(34), nullptr, X);
}

extern "C" void kernel_launch(void* const* d_in, const int* in_sizes, int n_in, void* d_out, int out_size, void* d_ws, size_t ws_size, hipStream_t stream) {
    static int grid_blocks = 0;
    if (!grid_blocks) {
        int dev = 0, cus = 0, per_cu = 0;
        (void)hipGetDevice(&dev);
        (void)hipDeviceGetAttribute(&cus, hipDeviceAttributeMultiprocessorCount, dev);
        (void)hipFuncSetAttribute((const void*)fwd_mega, hipFuncAttributeMaxDynamicSharedMemorySize, LDS_BYTES);
        (void)hipOccupancyMaxActiveBlocksPerMultiprocessor(&per_cu, (const void*)fwd_mega, 512, LDS_BYTES);
        grid_blocks = cus > 0 ? cus : 256;
        if (ws_size < WS_END) fprintf(stderr, "kernel_launch: workspace too small: %zu < %zu\n", ws_size, (size_t)WS_END);
        fprintf(stderr, "kernel_launch: cus %d occupancy %d ws %zu n_in %d\n", cus, per_cu, ws_size, n_in);
    }
    Params p{};
    for (int i = 0; i < 35; ++i) p.in[i] = (const float*)d_in[i];
    p.out = (float*)d_out; p.ws = (unsigned char*)d_ws;
    void* args[] = {&p};
    hipError_t e = hipLaunchCooperativeKernel((const void*)fwd_mega, dim3(grid_blocks), dim3(512), args, LDS_BYTES, stream);
    if (e != hipSuccess) fprintf(stderr, "cooperative launch failed: %s (grid %d)\n", hipGetErrorString(e), grid_blocks);
}
```

```cpp
#include <hip/hip_runtime.h>
#include <hip/hip_cooperative_groups.h>
#include <cstdio>
namespace cg = cooperative_groups;
#include <hip/hip_runtime.h>
namespace pg8 {
#define PG8_LAS __attribute__((address_space(3)))
typedef unsigned short bf16_t;
typedef short bf16x8 __attribute__((ext_vector_type(8)));
typedef float f32x4 __attribute__((ext_vector_type(4)));
typedef unsigned u32x4 __attribute__((ext_vector_type(4)));
constexpr int BM = 256, BK = 64, HALF = 128, HTB = HALF * BK * 2  , STAGE_BYTES = 8 * HTB, NXCD = 8, WGM = 8;

__host__ __device__ __forceinline__ int lds_byte(int r, int c) { const int st = (r >> 4) * 2 + (c >> 5), rr = r & 15, cc = c & 31, ob = rr * 64 + cc * 2; return st * 1024 + (ob ^ (((ob >> 9) & 1) << 5)); }
__host__ __device__ __forceinline__ void stage_rc(int b, int& R, int& C) { const int st = b / 1024, sb = b % 1024, swz = sb ^ (((sb >> 9) & 1) << 5); R = (st >> 1) * 16 + swz / 64; C = (st & 1) * 32 + (swz % 64) / 2; }
__host__ __device__ __forceinline__ int perm32(int rho) { const int n = rho >> 4, i = rho & 15; return 8 * (i >> 2) + 4 * n + (i & 3); }

struct Unit { int pm, pn; };
struct Gemm { const bf16_t* A; const bf16_t* Bt; int M, N, K; };

struct StaticOrder {
    int nM, nN, nwg, G, c;
    __host__ __device__ void init(int M, int N, int G_, int c_) { nM = M / BM; nN = N / BM; nwg = nM * nN; G = G_; c = c_; }
    __host__ __device__ bool next(int i, Unit& u) const {
        const long L = (long)i * G + c; if (L >= nwg) return false;
        int wgid = (int)L; { const int q = nwg / NXCD, r = nwg % NXCD, xcd = wgid % NXCD, off = wgid / NXCD; wgid = (xcd < r ? xcd * (q + 1) : r * (q + 1) + (xcd - r) * q) + off; }
        const int nig = WGM * nN, gid = wgid / nig, fm = gid * WGM, gsz = (nM - fm) < WGM ? (nM - fm) : WGM;
        u.pm = fm + ((wgid % nig) % gsz); u.pn = (wgid % nig) / gsz; return true;
    }
    __device__ __forceinline__ void a_ready(const Unit&) const {}
    __device__ __forceinline__ void done(const Unit&) const {}
};
__device__ __forceinline__ unsigned cvt_pk_bf16(float lo, float hi) { unsigned r; asm volatile("v_cvt_pk_bf16_f32 %0, %1, %2" : "=v"(r) : "v"(lo), "v"(hi)); return r; }
typedef float f32x2 __attribute__((ext_vector_type(2)));
typedef unsigned u32x2 __attribute__((ext_vector_type(2)));
__device__ __forceinline__ float fast_silu(float g) { return g * __builtin_amdgcn_rcpf(1.0f + __expf(-g)); }
struct EpiGU {
    static constexpr bool PERM = true, AFTER_DRAIN = false;
    bf16_t* O; int ldc;
    __device__ __forceinline__ void operator()(const f32x4 (&acc)[2][2][4][2], const Unit& u, int wr, int wc, int fr, int fq) const {
        const int rl0 = wr * 64 + fr, col0 = u.pn * HALF + wc * 32 + 8 * fq;
        bf16_t* const blk = O + ((size_t)u.pm * (ldc >> 6) + (col0 >> 6)) * (BM * 64) + (col0 & 63);
#pragma unroll
        for (int ai = 0; ai < 2; ++ai)
#pragma unroll
            for (int m = 0; m < 4; ++m) { bf16_t* rowp = blk + (size_t)(rl0 + ai * HALF + m * 16) * 64;
                const f32x4 g0 = acc[ai][0][m][0], g1 = acc[ai][0][m][1], u0 = acc[ai][1][m][0], u1 = acc[ai][1][m][1];
                const f32x4 t0 = g0 * (-1.4426950408889634f), t1 = g1 * (-1.4426950408889634f);
                f32x4 d0, d1;
#pragma unroll
                for (int j = 0; j < 4; ++j) { d0[j] = __builtin_amdgcn_exp2f(t0[j]); d1[j] = __builtin_amdgcn_exp2f(t1[j]); }
                d0 = d0 + 1.0f; d1 = d1 + 1.0f;
                f32x4 r0, r1;
#pragma unroll
                for (int j = 0; j < 4; ++j) { r0[j] = __builtin_amdgcn_rcpf(d0[j]); r1[j] = __builtin_amdgcn_rcpf(d1[j]); }
                const f32x4 h0 = (g0 * u0) * r0, h1 = (g1 * u1) * r1;
                u32x4 w; w.x = cvt_pk_bf16(h0[0], h0[1]); w.y = cvt_pk_bf16(h0[2], h0[3]); w.z = cvt_pk_bf16(h1[0], h1[1]); w.w = cvt_pk_bf16(h1[2], h1[3]);
                *(u32x4*)rowp = w; }
    }
};
struct EpiZ {
    static constexpr bool PERM = true, AFTER_DRAIN = false;
    bf16_t* O; int ldc;
    __device__ __forceinline__ void operator()(const f32x4 (&acc)[2][2][4][2], const Unit& u, int wr, int wc, int fr, int fq) const {
        const int row0 = u.pm * BM + wr * 64 + fr, col0 = u.pn * BM + wc * 32 + 8 * fq;
#pragma unroll
        for (int ai = 0; ai < 2; ++ai)
#pragma unroll
            for (int m = 0; m < 4; ++m) { bf16_t* rowp = O + (size_t)(row0 + ai * HALF + m * 16) * ldc + col0;
#pragma unroll
                for (int bj = 0; bj < 2; ++bj) { const f32x4 v0 = acc[ai][bj][m][0], v1 = acc[ai][bj][m][1];
                    u32x4 w; w.x = cvt_pk_bf16(v0[0], v0[1]); w.y = cvt_pk_bf16(v0[2], v0[3]); w.z = cvt_pk_bf16(v1[0], v1[1]); w.w = cvt_pk_bf16(v1[2], v1[3]);
                    *(u32x4*)(rowp + bj * HALF) = w; } }
    }
};
struct EpiResid {
    static constexpr bool PERM = true, AFTER_DRAIN = false;
    const float* Xs; float* X; int ldc; float scale;
    __device__ __forceinline__ void operator()(const f32x4 (&acc)[2][2][4][2], const Unit& u, int wr, int wc, int fr, int fq) const {
        const int row0 = u.pm * BM + wr * 64 + fr, col0 = u.pn * BM + wc * 32 + 8 * fq;
#pragma unroll
        for (int ai = 0; ai < 2; ++ai)
#pragma unroll
            for (int m = 0; m < 4; ++m) { const size_t off = (size_t)(row0 + ai * HALF + m * 16) * ldc + col0;
#pragma unroll
                for (int bj = 0; bj < 2; ++bj) { const size_t o2 = off + bj * HALF;
                    const f32x4 x0 = *(const f32x4*)(Xs + o2) + acc[ai][bj][m][0] * scale, x1 = *(const f32x4*)(Xs + o2 + 4) + acc[ai][bj][m][1] * scale;
                    *(f32x4*)(X + o2) = x0; *(f32x4*)(X + o2 + 4) = x1; } }
    }
};
template <class Epi, class Sched, bool ABLK = false>
__device__ __forceinline__ void gemm_phase(PG8_LAS unsigned char* lds, const Gemm g, const Sched& S, const Epi& E) {
    int tid_o = threadIdx.x; asm volatile("" : "+v"(tid_o));
    const int tid = tid_o, wid = __builtin_amdgcn_readfirstlane(tid >> 6), lane = tid & 63, wr = wid >> 2, wc = wid & 3, fr = lane & 15, fq = lane >> 4;
    const int K = g.K, nt = K / BK;
    unsigned voffA[2], voffB[2];
#pragma unroll
    for (int i = 0; i < 2; ++i) { int R, C; stage_rc(tid * 16 + i * 8192, R, C); const int Rb = Epi::PERM ? ((R & ~31) + perm32(R & 31)) : R;
        voffA[i] = ABLK ? (unsigned)(R * BK + C) * 2u : (unsigned)(R * K + C) * 2u; voffB[i] = (unsigned)(Rb * K + C) * 2u; }
    const size_t kstep = (size_t)(BK * 2);
    const size_t hstep = (size_t)HALF * K * 2;
    const size_t tstep = 2 * hstep;
    const size_t kstepA = ABLK ? (size_t)(BM * BK * 2) : kstep, hstepA = ABLK ? (size_t)(HALF * BK * 2) : hstep, tstepA = tstep;
    const unsigned ldsw = (unsigned)wid * 1024u;
    const int aoff = lds_byte(wr * 64 + fr, fq * 8), boff = lds_byte(wc * 32 + fr, fq * 8);
#define PG8_SA(b, h) (((b) * 2 + (h)) * HTB)
#define PG8_SB(b, h) ((4 + (b) * 2 + (h)) * HTB)
#define PG8_STAGE(bufoff, gbase, voff) do { _Pragma("unroll") for (int _i = 0; _i < 2; ++_i) \
        __builtin_amdgcn_global_load_lds((const unsigned*)((const char*)(gbase) + (voff)[_i]), (PG8_LAS unsigned*)(lds + (bufoff) + ldsw + _i * 8192), 16, 0, 0); } while (0)
#define PG8_LDA(dst, b, h) do { _Pragma("unroll") for (int m = 0; m < 4; ++m) _Pragma("unroll") for (int k = 0; k < 2; ++k) dst[m][k] = *(const PG8_LAS bf16x8*)(lds + PG8_SA(b, h) + aoff + m * 2048 + k * 1024); } while (0)
#define PG8_LDB(dst, b, h) do { _Pragma("unroll") for (int n = 0; n < 2; ++n) _Pragma("unroll") for (int k = 0; k < 2; ++k) dst[n][k] = *(const PG8_LAS bf16x8*)(lds + PG8_SB(b, h) + boff + n * 2048 + k * 1024); } while (0)
#define PG8_MMA(ai, bj, At, Bt) do { __builtin_amdgcn_s_setprio(1); _Pragma("unroll") for (int m = 0; m < 4; ++m) _Pragma("unroll") for (int n = 0; n < 2; ++n) _Pragma("unroll") for (int k = 0; k < 2; ++k) \
        acc[ai][bj][m][n] = __builtin_amdgcn_mfma_f32_16x16x32_bf16(Bt[n][k], At[m][k], acc[ai][bj][m][n], 0, 0, 0); __builtin_amdgcn_s_setprio(0); } while (0)
#define PG8_WAIT_V(n) asm volatile("s_waitcnt vmcnt(" #n ")" ::: "memory")
#define PG8_WAIT_L(n) asm volatile("s_waitcnt lgkmcnt(" #n ")" ::: "memory")
#define PG8_BAR __builtin_amdgcn_s_barrier()
#define PG8_SCHED __builtin_amdgcn_sched_barrier(0)
    Unit cur, nxt; int ui = 0;
    if (!S.next(0, cur)) return;
    f32x4 acc[2][2][4][2];
#pragma unroll
    for (int a = 0; a < 2; ++a)
#pragma unroll
        for (int b = 0; b < 2; ++b)
#pragma unroll
            for (int m = 0; m < 4; ++m)
#pragma unroll
                for (int n = 0; n < 2; ++n) acc[a][b][m][n] = (f32x4){0.f, 0.f, 0.f, 0.f};
    bf16x8 At[4][2], B0[2][2], B1[2][2];
    const char* cA = (const char*)g.A + (size_t)cur.pm * tstepA; const char* cB = (const char*)g.Bt + (size_t)cur.pn * tstep;
    S.a_ready(cur);
    PG8_STAGE(PG8_SB(0, 0), cB, voffB); PG8_STAGE(PG8_SA(0, 0), cA, voffA); PG8_STAGE(PG8_SB(0, 1), cB + hstep, voffB); PG8_STAGE(PG8_SA(0, 1), cA + hstepA, voffA);
    if (wr == 1) PG8_BAR;
    PG8_WAIT_V(4); PG8_BAR;
    PG8_STAGE(PG8_SB(1, 0), cB + kstep, voffB); PG8_STAGE(PG8_SA(1, 0), cA + kstepA, voffA); PG8_STAGE(PG8_SB(1, 1), cB + hstep + kstep, voffB);
    PG8_WAIT_V(6); PG8_BAR;
    for (;;) {
        const bool has_next = S.next(ui + 1, nxt);
        const char* nA = has_next ? (const char*)g.A + (size_t)nxt.pm * tstepA : cA; const char* nB = has_next ? (const char*)g.Bt + (size_t)nxt.pn * tstep : cB;
        for (int t = 0; t < nt; t += 2) {
            const bool last = (t == nt - 2);
            const char* a1 = cA + (size_t)(t + 1) * kstepA;
            const char* a2 = last ? nA : cA + (size_t)(t + 2) * kstepA; const char* b2 = last ? nB : cB + (size_t)(t + 2) * kstep;
            const char* a3 = a2 + kstepA; const char* b3 = b2 + kstep;
            if (last && has_next) S.a_ready(nxt);
            PG8_LDB(B0, 0, 0); PG8_SCHED; PG8_LDA(At, 0, 0); PG8_STAGE(PG8_SA(1, 1), a1 + hstepA, voffA);
            PG8_WAIT_L(8); PG8_BAR; PG8_WAIT_L(0); PG8_MMA(0, 0, At, B0); PG8_BAR; PG8_SCHED;
            PG8_LDB(B1, 0, 1); PG8_STAGE(PG8_SB(0, 0), b2, voffB);
            PG8_BAR; PG8_WAIT_L(0); PG8_MMA(0, 1, At, B1); PG8_BAR;
            PG8_LDA(At, 0, 1); PG8_STAGE(PG8_SA(0, 0), a2, voffA);
            PG8_BAR; PG8_WAIT_L(0); PG8_MMA(1, 0, At, B0); PG8_BAR; PG8_SCHED;
            PG8_STAGE(PG8_SB(0, 1), b2 + hstep, voffB);
            PG8_WAIT_V(6); PG8_BAR; PG8_MMA(1, 1, At, B1); PG8_BAR;
            PG8_LDB(B0, 1, 0); PG8_SCHED; PG8_LDA(At, 1, 0); PG8_STAGE(PG8_SA(0, 1), a2 + hstepA, voffA);
            PG8_WAIT_L(8); PG8_BAR; PG8_WAIT_L(0); PG8_MMA(0, 0, At, B0); PG8_BAR; PG8_SCHED;
            PG8_LDB(B1, 1, 1); PG8_STAGE(PG8_SB(1, 0), b3, voffB);
            PG8_BAR; PG8_WAIT_L(0); PG8_MMA(0, 1, At, B1); PG8_BAR;
            PG8_LDA(At, 1, 1); PG8_STAGE(PG8_SA(1, 0), a3, voffA);
            PG8_BAR; PG8_WAIT_L(0); PG8_MMA(1, 0, At, B0); PG8_BAR; PG8_SCHED;
            PG8_STAGE(PG8_SB(1, 1), b3 + hstep, voffB);
            PG8_WAIT_V(6); PG8_BAR; PG8_MMA(1, 1, At, B1); PG8_BAR;
        }
        if constexpr (!Epi::AFTER_DRAIN) { E(acc, cur, wr, wc, fr, fq); S.done(cur); }
        if (!has_next) break;
#pragma unroll
        for (int a = 0; a < 2; ++a)
#pragma unroll
            for (int b = 0; b < 2; ++b)
#pragma unroll
                for (int m = 0; m < 4; ++m)
#pragma unroll
                    for (int n = 0; n < 2; ++n) acc[a][b][m][n] = (f32x4){0.f, 0.f, 0.f, 0.f};
        cur = nxt; cA = nA; cB = nB; ++ui;
    }
    PG8_WAIT_V(0);
    if (wr == 0) PG8_BAR;
    PG8_BAR;
    if constexpr (Epi::AFTER_DRAIN) { E.fused(acc, cur, wr, wc, fr, fq, lds, wid, lane); S.done(cur); }
#undef PG8_SA
#undef PG8_SB
#undef PG8_STAGE
#undef PG8_LDA
#undef PG8_LDB
#undef PG8_MMA
#undef PG8_WAIT_V
#undef PG8_WAIT_L
#undef PG8_BAR
#undef PG8_SCHED
}
}
#ifndef PH
#define PH 0xFFFF
#endif
#ifndef REP
#define REP 0
#endif
typedef unsigned short u16;
typedef float f32x4 __attribute__((ext_vector_type(4)));
typedef float f32x2 __attribute__((ext_vector_type(2)));
typedef unsigned u32x4 __attribute__((ext_vector_type(4)));
typedef unsigned u32x2 __attribute__((ext_vector_type(2)));
typedef _Float16 h16;
typedef _Float16 h16x4 __attribute__((ext_vector_type(4)));
typedef _Float16 h16x8 __attribute__((ext_vector_type(8)));
typedef _Float16 h16x2 __attribute__((ext_vector_type(2)));
#define LAS __attribute__((address_space(3)))

constexpr int MT = 32768, TS = 16384, DM = 2048, DFF = 5632;
constexpr int LDS_BYTES = 144 * 1024;
constexpr size_t WS_HBUF = 0;
constexpr size_t WS_WBUF = 134217728;
constexpr size_t WS_WGU = WS_WBUF, WS_WD = WS_WBUF + 46137344;
constexpr size_t WS_WIN = WS_WBUF, WS_WOUT = WS_WBUF + 28311552;
constexpr size_t WS_ACT = WS_WBUF + 69206016;
constexpr size_t WS_Z = WS_WBUF + 36700160;
constexpr size_t WS_RWP = WS_Z + 285212672;
constexpr size_t WS_RWS = WS_RWP + 301989888;
constexpr size_t WS_ZG = WS_RWS + 6291456;
constexpr size_t WS_GDP = WS_ZG + 8388608;
constexpr size_t WS_GDS = WS_GDP + 150994944;
constexpr size_t WS_LRA = WS_GDS + 3145728;
constexpr size_t WS_LRU = WS_LRA + 33554432;
constexpr size_t WS_WGU2 = WS_LRU + 33554432;
constexpr size_t WS_WD2 = WS_WGU2 + 46137344;
constexpr size_t WS_HIN = WS_WD2 + 23068672;
constexpr size_t WS_BON = WS_HIN + 1048576;
constexpr size_t WS_BAR = WS_BON + 1572864;
constexpr size_t WS_W2T = WS_BAR + 16384;
constexpr size_t WS_A2T = WS_W2T + 98304;
constexpr size_t WS_G2T = WS_A2T + 98304;
constexpr size_t WS_WAT = WS_G2T + 196608;
constexpr size_t WS_WXT = WS_WAT + 65536;
constexpr size_t WS_END = WS_WXT + 65536;
static_assert(WS_END <= 1073741824ull, "workspace");
constexpr int Z1_LD = 2560, Z2_LD = 4352;
constexpr int Z2_GATE = 2304, Z2_XL = 3072, Z2_YL = 3584, Z2_ZB = 4096, Z2_ZA = 4102;

struct Params { const float* in[35]; float* out; unsigned char* ws; };

__device__ __forceinline__ int otid() { int t = threadIdx.x; asm volatile("" : "+v"(t)); return t; }
__device__ __forceinline__ int obid() { int t = blockIdx.x; asm volatile("" : "+s"(t)); return t; }
__device__ __forceinline__ int ogrid() { int t = gridDim.x; asm volatile("" : "+s"(t)); return t; }
__device__ __forceinline__ float bf2f(u16 h) { return __uint_as_float((unsigned)h << 16); }
__device__ __forceinline__ float bflo(unsigned w) { return __uint_as_float(w << 16); }
__device__ __forceinline__ float bfhi(unsigned w) { return __uint_as_float(w & 0xffff0000u); }
__device__ __forceinline__ u16 f2bf(float f) { unsigned u = __float_as_uint(f); u += 0x7FFFu + ((u >> 16) & 1u); return (u16)(u >> 16); }
__device__ __forceinline__ unsigned pk_bf(float lo, float hi) { return pg8::cvt_pk_bf16(lo, hi); }
template <int C> __device__ __forceinline__ float dppf(float v) { return __int_as_float(__builtin_amdgcn_update_dpp(0, __float_as_int(v), C, 0xF, 0xF, true)); }
template <int H> __device__ __forceinline__ float fmix(float a, unsigned hp, float c) { float d;
    if (H == 0) asm("v_fma_mix_f32 %0, %1, %2, %3 op_sel_hi:[0,1,0]" : "=v"(d) : "v"(a), "v"(hp), "v"(c));
    else        asm("v_fma_mix_f32 %0, %1, %2, %3 op_sel:[0,1,0] op_sel_hi:[0,1,0]" : "=v"(d) : "v"(a), "v"(hp), "v"(c));
    return d; }
template <int H> __device__ __forceinline__ float fmixn(float a, unsigned hp, float c) { float d;
    if (H == 0) asm("v_fma_mix_f32 %0, -%1, %2, %3 op_sel_hi:[0,1,0]" : "=v"(d) : "v"(a), "v"(hp), "v"(c));
    else        asm("v_fma_mix_f32 %0, -%1, %2, %3 op_sel:[0,1,0] op_sel_hi:[0,1,0]" : "=v"(d) : "v"(a), "v"(hp), "v"(c));
    return d; }
__device__ __forceinline__ float red16(float v) { v += dppf<0xB1>(v); v += dppf<0x4E>(v); v += dppf<0x141>(v); v += dppf<0x140>(v); return v; }
__device__ __forceinline__ float rlane(float v, int l) { return __int_as_float(__builtin_amdgcn_readlane(__float_as_int(v), l)); }
__device__ __forceinline__ float wave_sum(float v) { v = red16(v);
    v += __int_as_float(__builtin_amdgcn_update_dpp(0, __float_as_int(v), 0x142, 0xA, 0xF, false));
    v += __int_as_float(__builtin_amdgcn_update_dpp(0, __float_as_int(v), 0x143, 0xC, 0xF, false));
    return rlane(v, 63); }
__device__ __forceinline__ float sigm(float x) { return __builtin_amdgcn_rcpf(1.0f + __expf(-x)); }
__device__ __forceinline__ float softplus_(float x) { return fmaxf(x, 0.0f) + __logf(1.0f + __expf(-fabsf(x))); }
__device__ __forceinline__ float tanh_(float x) { const float e = __expf(-2.0f * fabsf(x)); const float t = (1.0f - e) * __builtin_amdgcn_rcpf(1.0f + e); return x < 0.f ? -t : t; }
__device__ __forceinline__ float gelu_tanh(float x) { return 0.5f * x * (1.0f + tanh_(0.7978845608028654f * (x + 0.044715f * x * x * x))); }

template <int MAP> __device__ __forceinline__ int rowmap(int n) {
    if (MAP == 0) return n;
    if (MAP == 1) return (n >> 7) * 256 + (n & 127);
    if (MAP == 2) return (n >> 7) * 256 + 128 + (n & 127);
    if (n < 2560 + 3072) return n;
    const int q = n - 2560;
    if (q < 3084) return 2560 + Z2_ZB + (q - 3072);
    return 2560 + Z2_XL + (q - 3084);
}
template <int MAP> __device__ __forceinline__ void conv_w(const float* __restrict__ src, u16* __restrict__ dst, int K, int N, LAS float* tile, int bsub = 0, int gsub = 0) {
    const int tid = otid(), NT = (N + 63) >> 6, KT = K >> 6; const int bidx = gsub ? bsub : obid(), gdim = gsub ? gsub : ogrid();
    for (int t = bidx; t < NT * KT; t += gdim) {
        const int nt = t % NT, kt = t / NT;
        const int c = tid & 63, r0 = tid >> 6, n = nt * 64 + c;
#pragma unroll
        for (int i = 0; i < 8; ++i) { const int r = r0 + 8 * i; tile[r * 65 + c] = (n < N) ? src[(size_t)(kt * 64 + r) * N + n] : 0.f; }
        __syncthreads();
        const int nl = tid >> 3, kq = tid & 7, n2 = nt * 64 + nl;
        if (n2 < N) {
            float v[8];
#pragma unroll
            for (int j = 0; j < 8; ++j) v[j] = tile[(kq * 8 + j) * 65 + nl];
            u32x4 w; w.x = pk_bf(v[0], v[1]); w.y = pk_bf(v[2], v[3]); w.z = pk_bf(v[4], v[5]); w.w = pk_bf(v[6], v[7]);
            *(u32x4*)(dst + (size_t)rowmap<MAP>(n2) * K + kt * 64 + kq * 8) = w;
        }
        __syncthreads();
    }
}

template <bool FINAL> __device__ __forceinline__ void norm_rows(const float* src, const float* __restrict__ gamma, u16* dst, float* copy) {
    const int tid_ = otid(); const int lane = tid_ & 63, wid = tid_ >> 6; const int bidx = obid(), gdim = ogrid();
    f32x4 g[8];
#pragma unroll
    for (int i = 0; i < 8; ++i) g[i] = *(const f32x4*)(gamma + i * 256 + lane * 4);
    for (int row = bidx * 8 + wid; row < MT; row += gdim * 8) {
        const float* p = src + (size_t)row * DM; f32x4 v[8]; float ss = 0.f;
#pragma unroll
        for (int i = 0; i < 8; ++i) { v[i] = *(const f32x4*)(p + i * 256 + lane * 4); ss += v[i][0] * v[i][0] + v[i][1] * v[i][1] + v[i][2] * v[i][2] + v[i][3] * v[i][3]; }
        ss = wave_sum(ss);
        const float rs = rsqrtf(ss * (1.0f / 2048.0f) + 1e-6f);
#pragma unroll
        for (int i = 0; i < 8; ++i) {
            const f32x4 o = v[i] * rs * g[i];
            if (FINAL) { *(f32x4*)(copy + (size_t)row * DM + i * 256 + lane * 4) = o; }
            else { u32x2 w; w.x = pk_bf(o[0], o[1]); w.y = pk_bf(o[2], o[3]); *(u32x2*)(dst + (size_t)row * DM + i * 256 + lane * 4) = w;
                   if (copy) *(f32x4*)(copy + (size_t)row * DM + i * 256 + lane * 4) = v[i]; }
        }
    }
}

struct RwP { const float *mu, *w0, *w2, *a0, *a2, *kk, *ka, *rk; };
__device__ __forceinline__ void prep_rw(const u16* __restrict__ Z1, const RwP P, h16* __restrict__ RWP, float* __restrict__ RWS, float* __restrict__ BON, u16* __restrict__ ZG, LAS float* L) {
    const int tid = otid(), lane = tid & 63; const int bidx = obid(), gdim = ogrid();
    constexpr int TT = 32, TH = 16;
    for (int tile = bidx; tile < MT / TT; tile += gdim) {
        const int m0 = tile * TT;
#pragma unroll
        for (int i = 0; i < 16; ++i) {
            const int idx = tid + 512 * i, tok = idx >> 8, cc = idx & 255, m = m0 + tok, c = 2304 + cc;
            const float zc = bf2f(Z1[(size_t)m * Z1_LD + c]);
            const float zp = ((m & (TS - 1)) == 0) ? 0.f : bf2f(Z1[(size_t)(m - 1) * Z1_LD + c]);
            const float zf = zc + P.mu[c] * (zp - zc);
            if (cc < 64) L[cc * TT + tok] = tanh_(zf);
            else if (cc < 128) L[cc * TT + tok] = zf;
            else ZG[(size_t)m * 128 + (cc - 128)] = f2bf(sigm(zf));
        }
        __syncthreads();
        const int jj = tid & 255, th = tid >> 8;
        for (int cgi = 0; cgi < 3; ++cgi) {
            const int j = jj + 256 * cgi;
            const int mA = m0 + th * TH;
            u16 lr[TH], lk[TH], lv[TH]; u16 l0r = 0, l0k = 0, l0v = 0;
            if ((mA & (TS - 1)) != 0) { const u16* zp = Z1 + (size_t)(mA - 1) * Z1_LD; l0r = zp[j]; l0k = zp[768 + j]; l0v = zp[1536 + j]; }
#pragma unroll
            for (int tk = 0; tk < TH; ++tk) { const u16* zc = Z1 + (size_t)(mA + tk) * Z1_LD; lr[tk] = zc[j]; lk[tk] = zc[768 + j]; lv[tk] = zc[1536 + j]; }
            float aw[TH], aa[TH];
            { const float w0v = P.w0[j], a0v = P.a0[j];
#pragma unroll
              for (int k = 0; k < TH; ++k) { aw[k] = w0v; aa[k] = a0v; } }
#pragma unroll 4
            for (int i = 0; i < 64; ++i) {
                const float w2v = P.w2[i * 768 + j], a2v = P.a2[i * 768 + j];
#pragma unroll
                for (int q = 0; q < 4; ++q) {
                    const f32x4 t = *(const LAS f32x4*)(L + i * TT + th * TH + 4 * q), y = *(const LAS f32x4*)(L + (64 + i) * TT + th * TH + 4 * q);
#pragma unroll
                    for (int k = 0; k < 4; ++k) { aw[4 * q + k] += t[k] * w2v; aa[4 * q + k] += y[k] * a2v; }
                }
            }
            const float mur = P.mu[j], muk = P.mu[768 + j], muv = P.mu[1536 + j];
            const float kkc = P.kk[j], kac = P.ka[j], rkc = P.rk[j];
            const int hh = j >> 6;
            float pr = bf2f(l0r), pk = bf2f(l0k), pv = bf2f(l0v);
            float w1 = 0.f, dl1 = 0.f, bb1 = 0.f, kp1 = 0.f, br1 = 0.f, kr1 = 0.f;
#pragma unroll
            for (int tk = 0; tk < TH; ++tk) {
                const int m = mA + tk, b = m >> 14, t = m & (TS - 1);
                const float cr = bf2f(lr[tk]), ck = bf2f(lk[tk]), cv = bf2f(lv[tk]);
                const float r = cr + mur * (pr - cr), k = ck + muk * (pk - ck), v = cv + muv * (pv - cv);
                pr = cr; pk = ck; pv = cv;
                const float e = 0.6065306597f * sigm(aw[tk]);
                const float dl = 1.0f - __expf(-e);
                const float w = 1.0f - dl;
                const float a = sigm(aa[tk]);
                const float kq = k * kkc;
                const float ss = wave_sum(kq * kq);
                const float kkn = kq * rsqrtf(ss + 1e-12f);
                const float kp = k * (1.0f + (a - 1.0f) * kac);
                const float bb = kkn * a;
                const float wr = w * r;
                const float br = wave_sum(bb * r), kr = wave_sum(kp * r), bonus = wave_sum(r * kp * rkc);
                const size_t rec = (size_t)(b * 12 + hh) * TS + t;
                h16* o = RWP + (rec >> 1) * 768 + lane;
                if (lane == 0) BON[rec] = bonus;
                if ((tk & 1) == 0) {
                    o[0] = (h16)kkn; o[64] = (h16)wr; o[9 * 64] = (h16)v;
                    w1 = w; dl1 = dl; bb1 = bb; kp1 = kp; br1 = br; kr1 = kr;
                } else {
                    o[2 * 64] = (h16)(w1 * kkn); o[3 * 64] = (h16)(w1 * wr); o[4 * 64] = (h16)(dl1 + dl - dl1 * dl);
                    o[5 * 64] = (h16)(bb1 * w); o[6 * 64] = (h16)(kp1 * w); o[7 * 64] = (h16)bb; o[8 * 64] = (h16)kp; o[10 * 64] = (h16)v;
                    const float bk12 = wave_sum(bb1 * kkn), kk12 = wave_sum(kp1 * kkn), bz = wave_sum(bb1 * wr), kz = wave_sum(kp1 * wr);
                    if (lane == 0) { f32x4 sA, sB; sA[0] = br1; sA[1] = kr1; sA[2] = bk12; sA[3] = kk12; sB[0] = br; sB[1] = kr; sB[2] = bz; sB[3] = kz;
                        *(f32x4*)(RWS + (rec >> 1) * 8) = sA; *(f32x4*)(RWS + (rec >> 1) * 8 + 4) = sB; }
                }
            }
        }
        __syncthreads();
    }
}

__device__ __forceinline__ void tr_small(const float* __restrict__ src, u16* __restrict__ dst, int K) {
    const int tid = otid(); const int bidx = obid(), gdim = ogrid();
    for (int idx = bidx * 512 + tid; idx < 768 * K; idx += gdim * 512) { const int col = idx / K, k = idx - col * K; dst[idx] = f2bf(src[k * 768 + col]); }
}
typedef short bf16x8_t __attribute__((ext_vector_type(8)));
__device__ __forceinline__ void prep_rw2(const u16* __restrict__ Z1, const RwP P, const u16* __restrict__ W2T, const u16* __restrict__ A2T,
                                         h16* __restrict__ RWP, float* __restrict__ RWS, float* __restrict__ BON, u16* __restrict__ ZG, LAS unsigned char* lds) {
    const int tid = otid(), lane = tid & 63, wid = tid >> 6, fr = lane & 15, fq = lane >> 4; const int bidx = obid(), gdim = ogrid();
    constexpr int TT = 32, LST = 272;
    for (int tile = bidx; tile < MT / TT; tile += gdim) {
        const int m0 = tile * TT;
#pragma unroll
        for (int i = 0; i < 16; ++i) {
            const int idx = tid + 512 * i, tok = idx >> 8, cc = idx & 255, m = m0 + tok, c = 2304 + cc;
            const float zc = bf2f(Z1[(size_t)m * Z1_LD + c]);
            const float zp = ((m & (TS - 1)) == 0) ? 0.f : bf2f(Z1[(size_t)(m - 1) * Z1_LD + c]);
            const float zf = zc + P.mu[c] * (zp - zc);
            if (cc < 128) *(LAS u16*)(lds + tok * LST + cc * 2) = f2bf(cc < 64 ? tanh_(zf) : zf);
            else ZG[(size_t)m * 128 + (cc - 128)] = f2bf(sigm(zf));
        }
        __syncthreads();
        for (int wt = wid; wt < 24; wt += 8) {
            const int hh = wt % 12, half = wt / 12;
            const int mB = m0 + half * 16, b = mB >> 14, tB = mB & (TS - 1);
            const int j0 = hh * 64 + 4 * fr;
            f32x4 accW[4], accA[4];
#pragma unroll
            for (int n = 0; n < 4; ++n) { accW[n] = (f32x4){0.f, 0.f, 0.f, 0.f}; accA[n] = (f32x4){0.f, 0.f, 0.f, 0.f}; }
#pragma unroll
            for (int ks = 0; ks < 2; ++ks) {
                const bf16x8_t aw_ = *(const LAS bf16x8_t*)(lds + (half * 16 + fr) * LST + (ks * 32 + fq * 8) * 2);
                const bf16x8_t aa_ = *(const LAS bf16x8_t*)(lds + (half * 16 + fr) * LST + (64 + ks * 32 + fq * 8) * 2);
#pragma unroll
                for (int n = 0; n < 4; ++n) {
                    const bf16x8_t bw = *(const bf16x8_t*)(W2T + (size_t)(j0 + n) * 64 + ks * 32 + fq * 8);
                    const bf16x8_t ba = *(const bf16x8_t*)(A2T + (size_t)(j0 + n) * 64 + ks * 32 + fq * 8);
                    accW[n] = __builtin_amdgcn_mfma_f32_16x16x32_bf16(aw_, bw, accW[n], 0, 0, 0);
                    accA[n] = __builtin_amdgcn_mfma_f32_16x16x32_bf16(aa_, ba, accA[n], 0, 0, 0);
                }
            }
            const f32x4 w0v = *(const f32x4*)(P.w0 + j0), a0v = *(const f32x4*)(P.a0 + j0), mur = *(const f32x4*)(P.mu + j0), muk = *(const f32x4*)(P.mu + 768 + j0), muv = *(const f32x4*)(P.mu + 1536 + j0);
            const f32x4 kkc = *(const f32x4*)(P.kk + j0), kac = *(const f32x4*)(P.ka + j0), rkc = *(const f32x4*)(P.rk + j0);
            u32x2 zr[5], zk[5], zv[5];
#pragma unroll
            for (int q = 0; q < 5; ++q) {
                const int m = mB + 4 * fq + q - 1;
                if (q == 0 && ((m + 1) & (TS - 1)) == 0) { zr[0] = (u32x2){0u, 0u}; zk[0] = zr[0]; zv[0] = zr[0]; }
                else { const u16* zc = Z1 + (size_t)m * Z1_LD + j0; zr[q] = *(const u32x2*)zc; zk[q] = *(const u32x2*)(zc + 768); zv[q] = *(const u32x2*)(zc + 1536); }
            }
            f32x4 w1, dl1, bb1, kp1; float br1 = 0.f, kr1 = 0.f;
#pragma unroll
            for (int r = 0; r < 4; ++r) {
                const int t = tB + 4 * fq + r;
                const size_t rec = (size_t)(b * 12 + hh) * TS + t;
                f32x4 pr, pk, pv, cr, ck, cv;
                pr[0] = bflo(zr[r].x); pr[1] = bfhi(zr[r].x); pr[2] = bflo(zr[r].y); pr[3] = bfhi(zr[r].y);
                pk[0] = bflo(zk[r].x); pk[1] = bfhi(zk[r].x); pk[2] = bflo(zk[r].y); pk[3] = bfhi(zk[r].y);
                pv[0] = bflo(zv[r].x); pv[1] = bfhi(zv[r].x); pv[2] = bflo(zv[r].y); pv[3] = bfhi(zv[r].y);
                cr[0] = bflo(zr[r + 1].x); cr[1] = bfhi(zr[r + 1].x); cr[2] = bflo(zr[r + 1].y); cr[3] = bfhi(zr[r + 1].y);
                ck[0] = bflo(zk[r + 1].x); ck[1] = bfhi(zk[r + 1].x); ck[2] = bflo(zk[r + 1].y); ck[3] = bfhi(zk[r + 1].y);
                cv[0] = bflo(zv[r + 1].x); cv[1] = bfhi(zv[r + 1].x); cv[2] = bflo(zv[r + 1].y); cv[3] = bfhi(zv[r + 1].y);
                const f32x4 rr = cr + mur * (pr - cr), k = ck + muk * (pk - ck), v = cv + muv * (pv - cv);
                f32x4 w, dl, a, kq, kp;
                float ss = 0.f;
#pragma unroll
                for (int n = 0; n < 4; ++n) {
                    const float e = 0.6065306597f * sigm(accW[n][r] + w0v[n]);
                    w[n] = __expf(-e); dl[n] = 1.0f - w[n];
                    a[n] = sigm(accA[n][r] + a0v[n]);
                    kq[n] = k[n] * kkc[n]; ss += kq[n] * kq[n];
                    kp[n] = k[n] * (1.0f + (a[n] - 1.0f) * kac[n]);
                }
                ss = red16(ss);
                const float rn = rsqrtf(ss + 1e-12f);
                const f32x4 kkn = kq * rn, bb = kkn * a, wr = w * rr;
                float br = 0.f, kr = 0.f, bonus = 0.f;
#pragma unroll
                for (int n = 0; n < 4; ++n) { br += bb[n] * rr[n]; kr += kp[n] * rr[n]; bonus += rr[n] * kp[n] * rkc[n]; }
                br = red16(br); kr = red16(kr); bonus = red16(bonus);
                h16* o = RWP + (rec >> 1) * 768 + 4 * fr;
                if (fr == 0) BON[rec] = bonus;
#define ST4(slot, vec) do { h16x4 hv_; hv_[0] = (h16)(vec)[0]; hv_[1] = (h16)(vec)[1]; hv_[2] = (h16)(vec)[2]; hv_[3] = (h16)(vec)[3]; *(h16x4*)(o + (slot) * 64) = hv_; } while (0)
                if ((r & 1) == 0) {
                    ST4(0, kkn); ST4(1, wr); ST4(9, v);
                    w1 = w; dl1 = dl; bb1 = bb; kp1 = kp; br1 = br; kr1 = kr;
                } else {
                    const f32x4 x2 = w1 * kkn, z2 = w1 * wr, d12 = dl1 + dl - dl1 * dl, B1 = bb1 * w, K1 = kp1 * w;
                    ST4(2, x2); ST4(3, z2); ST4(4, d12); ST4(5, B1); ST4(6, K1); ST4(7, bb); ST4(8, kp); ST4(10, v);
                    float bk12 = 0.f, kk12 = 0.f, bz = 0.f, kz = 0.f;
#pragma unroll
                    for (int n = 0; n < 4; ++n) { bk12 += bb1[n] * kkn[n]; kk12 += kp1[n] * kkn[n]; bz += bb1[n] * wr[n]; kz += kp1[n] * wr[n]; }
                    bk12 = red16(bk12); kk12 = red16(kk12); bz = red16(bz); kz = red16(kz);
                    if (fr == 0) { f32x4 sA, sB; sA[0] = br1; sA[1] = kr1; sA[2] = bk12; sA[3] = kk12; sB[0] = br; sB[1] = kr; sB[2] = bz; sB[3] = kz;
                        *(f32x4*)(RWS + (rec >> 1) * 8) = sA; *(f32x4*)(RWS + (rec >> 1) * 8 + 4) = sB; }
                }
#undef ST4
            }
        }
        __syncthreads();
    }
}

__device__ __forceinline__ void prep_gd(const u16* __restrict__ Z2, const float* __restrict__ cw, const float* __restrict__ alog, const float* __restrict__ dtb,
                                        h16* __restrict__ GDP, float* __restrict__ GDS) {
    const int tid_ = otid(); const int lane = tid_ & 63, wid = tid_ >> 6; const int bidx = obid(), gdim = ogrid();
    for (int task = bidx * 8 + wid; task < 6 * (MT / 32); task += gdim * 8) {
        const int hh = task % 6, chunk = task / 6, m0 = chunk * 32, b = m0 >> 14, t0 = m0 & (TS - 1);
        const int cq = hh * 128 + 2 * lane;
        float w[3][4][2];
#pragma unroll
        for (int a = 0; a < 3; ++a)
#pragma unroll
            for (int i = 0; i < 4; ++i) { const f32x2 q = *(const f32x2*)(cw + i * 2304 + a * 768 + cq); w[a][i][0] = q[0]; w[a][i][1] = q[1]; }
        float x[3][3][2];
#pragma unroll
        for (int a = 0; a < 3; ++a)
#pragma unroll
            for (int d = 0; d < 3; ++d) {
                unsigned wv = 0u;
                if (t0 != 0) wv = *(const unsigned*)(Z2 + (size_t)(m0 - 3 + d) * Z2_LD + a * 768 + cq);
                x[a][d][0] = bflo(wv); x[a][d][1] = bfhi(wv);
            }
        const float An = -__expf(alog[hh]), dtbv = dtb[hh];
        float kprev0 = 0.f, kprev1 = 0.f, al1 = 0.f, be1 = 0.f, qk1 = 0.f;
        for (int s8 = 0; s8 < 32; s8 += 8) {
          unsigned ld[8][3]; u16 ldb[8], lda[8];
#pragma unroll
          for (int k = 0; k < 8; ++k) { const u16* zr = Z2 + (size_t)(m0 + s8 + k) * Z2_LD;
#pragma unroll
              for (int a = 0; a < 3; ++a) ld[k][a] = *(const unsigned*)(zr + a * 768 + cq);
              ldb[k] = zr[Z2_ZB + hh]; lda[k] = zr[Z2_ZA + hh]; }
#pragma unroll
          for (int k = 0; k < 8; ++k) {
            const int s = s8 + k;
            float y[3][2];
#pragma unroll
            for (int a = 0; a < 3; ++a) {
                const unsigned wv = ld[k][a];
                const float c0 = bflo(wv), c1 = bfhi(wv);
                const float s0 = x[a][0][0] * w[a][0][0] + x[a][1][0] * w[a][1][0] + x[a][2][0] * w[a][2][0] + c0 * w[a][3][0];
                const float s1 = x[a][0][1] * w[a][0][1] + x[a][1][1] * w[a][1][1] + x[a][2][1] * w[a][2][1] + c1 * w[a][3][1];
                x[a][0][0] = x[a][1][0]; x[a][1][0] = x[a][2][0]; x[a][2][0] = c0;
                x[a][0][1] = x[a][1][1]; x[a][1][1] = x[a][2][1]; x[a][2][1] = c1;
                y[a][0] = s0 * sigm(s0); y[a][1] = s1 * sigm(s1);
            }
            const float sq = wave_sum(y[0][0] * y[0][0] + y[0][1] * y[0][1]);
            const float sk = wave_sum(y[1][0] * y[1][0] + y[1][1] * y[1][1]);
            const float rq = rsqrtf(sq + 1e-12f) * 0.08838834764831845f, rk = rsqrtf(sk + 1e-12f);
            const float q0 = y[0][0] * rq, q1 = y[0][1] * rq, k0 = y[1][0] * rk, k1 = y[1][1] * rk;
            const float qk = wave_sum(q0 * k0 + q1 * k1);
            const size_t rec = (size_t)(b * 6 + hh) * TS + (t0 + s);
            h16* o = GDP + rec * 384 + 2 * lane;
            h16x2 kv; kv[0] = (h16)k0; kv[1] = (h16)k1; *(h16x2*)(o) = kv;
            h16x2 qv; qv[0] = (h16)q0; qv[1] = (h16)q1; *(h16x2*)(o + 128) = qv;
            h16x2 vv; vv[0] = (h16)y[2][0]; vv[1] = (h16)y[2][1]; *(h16x2*)(o + 256) = vv;
            const float beta = sigm(bf2f(ldb[k]));
            const float alpha = __expf(An * softplus_(bf2f(lda[k]) + dtbv));
            if ((k & 1) == 0) { kprev0 = k0; kprev1 = k1; al1 = alpha; be1 = beta; qk1 = qk; }
            else {
                const float k12 = wave_sum(kprev0 * k0 + kprev1 * k1), kq12 = wave_sum(kprev0 * q0 + kprev1 * q1);
                if (lane == 0) { f32x4 sA, sB; sA[0] = al1; sA[1] = be1; sA[2] = qk1; sA[3] = k12; sB[0] = alpha; sB[1] = beta; sB[2] = qk; sB[3] = kq12;
                    *(f32x4*)(GDS + (rec - 1) * 4) = sA; *(f32x4*)(GDS + rec * 4) = sB; }
            }
          }
        }
    }
}

struct LrP { const float *cw, *cb, *wa, *ba, *wx, *bx, *lam; };
__device__ __forceinline__ void tr_blocks(const float* __restrict__ src, u16* __restrict__ dst) {
    const int tid = otid(); const int bidx = obid(), gdim = ogrid();
    for (int idx = bidx * 512 + tid; idx < 8 * 64 * 64; idx += gdim * 512) { const int n = idx >> 12, d = (idx >> 6) & 63, c = idx & 63; dst[idx] = f2bf(src[(n * 64 + c) * 64 + d]); }
}
__device__ __forceinline__ void prep_lr2(const u16* __restrict__ Z2, const LrP P, const u16* __restrict__ WAT, const u16* __restrict__ WXT, u16* __restrict__ LRA, u16* __restrict__ LRUb, LAS unsigned char* lds) {
    const int tid_ = otid(); const int lane = tid_ & 63, wid = tid_ >> 6, fr = lane & 15, fq = lane >> 4; const int bidx = obid(), gdim = ogrid();
    LAS unsigned char* Lx = lds + wid * 10240;
    LAS float* La = (LAS float*)(Lx + 2048);
    LAS float* Lb = La + 1024;
    for (int task = bidx * 8 + wid; task < 8 * (MT / 64); task += gdim * 8) {
        const int n = task & 7, chunk = task >> 3, m0 = chunk * 64, t0 = m0 & (TS - 1);
        const int ch = n * 64 + lane;
        bf16x8_t bwa[4][2], bwx[4][2];
#pragma unroll
        for (int nt = 0; nt < 4; ++nt)
#pragma unroll
            for (int ks = 0; ks < 2; ++ks) { const size_t o = (size_t)(n * 64 + nt * 16 + fr) * 64 + ks * 32 + fq * 8; bwa[nt][ks] = *(const bf16x8_t*)(WAT + o); bwx[nt][ks] = *(const bf16x8_t*)(WXT + o); }
        const float c0 = P.cw[ch], c1 = P.cw[512 + ch], c2 = P.cw[1024 + ch], c3 = P.cw[1536 + ch], cb = P.cb[ch];
        const float ba = P.ba[ch], bx = P.bx[ch];
        const float spl = -8.0f * softplus_(-P.lam[ch]);
        float x0 = 0.f, x1 = 0.f, x2 = 0.f, hl = 0.f, pc = 1.f;
        if (t0 != 0) { x0 = bf2f(Z2[(size_t)(m0 - 3) * Z2_LD + Z2_XL + ch]); x1 = bf2f(Z2[(size_t)(m0 - 2) * Z2_LD + Z2_XL + ch]); x2 = bf2f(Z2[(size_t)(m0 - 1) * Z2_LD + Z2_XL + ch]); }
        for (int s16 = 0; s16 < 64; s16 += 16) {
            u16 ldx[16];
#pragma unroll
            for (int k = 0; k < 16; ++k) ldx[k] = Z2[(size_t)(m0 + s16 + k) * Z2_LD + Z2_XL + ch];
            float xc[16];
#pragma unroll
            for (int k = 0; k < 16; ++k) {
                const float xin = bf2f(ldx[k]);
                xc[k] = x0 * c0 + x1 * c1 + x2 * c2 + xin * c3 + cb;
                x0 = x1; x1 = x2; x2 = xin;
                *(LAS u16*)(Lx + (k * 64 + lane) * 2) = f2bf(xc[k]);
            }
            f32x4 aA[4], aX[4];
#pragma unroll
            for (int nt = 0; nt < 4; ++nt) { aA[nt] = (f32x4){0.f, 0.f, 0.f, 0.f}; aX[nt] = (f32x4){0.f, 0.f, 0.f, 0.f}; }
#pragma unroll
            for (int ks = 0; ks < 2; ++ks) {
                const bf16x8_t af = *(const LAS bf16x8_t*)(Lx + (fr * 64 + ks * 32 + fq * 8) * 2);
#pragma unroll
                for (int nt = 0; nt < 4; ++nt) { aA[nt] = __builtin_amdgcn_mfma_f32_16x16x32_bf16(af, bwa[nt][ks], aA[nt], 0, 0, 0); aX[nt] = __builtin_amdgcn_mfma_f32_16x16x32_bf16(af, bwx[nt][ks], aX[nt], 0, 0, 0); }
            }
#pragma unroll
            for (int nt = 0; nt < 4; ++nt)
#pragma unroll
                for (int r = 0; r < 4; ++r) { La[(4 * fq + r) * 64 + nt * 16 + fr] = aA[nt][r]; Lb[(4 * fq + r) * 64 + nt * 16 + fr] = aX[nt][r]; }
#pragma unroll
            for (int k = 0; k < 16; ++k) {
                const int m = m0 + s16 + k;
                const float r = sigm(La[k * 64 + lane] + ba), ig = sigm(Lb[k * 64 + lane] + bx);
                const float la = spl * r;
                const float a = __expf(la);
                const float u = __builtin_amdgcn_sqrtf(1.0f - __expf(2.0f * la)) * (ig * xc[k]);
                hl = a * hl + u; pc *= a;
                LRA[(size_t)m * 512 + ch] = f2bf(pc); LRUb[(size_t)m * 512 + ch] = f2bf(hl);
            }
        }
    }
}

constexpr int RC = 32;
constexpr int RPB = 3072;
constexpr int RBUF = (RC / 2) * RPB + (RC / 2) * 32;
__device__ __forceinline__ f32x2 lo2(f32x4 v) { f32x2 r; r[0] = v[0]; r[1] = v[1]; return r; }
__device__ __forceinline__ f32x2 hi2(f32x4 v) { f32x2 r; r[0] = v[2]; r[1] = v[3]; return r; }
__device__ __forceinline__ float dot4(f32x2 sa, f32x2 sb, f32x4 v) { f32x2 t = sa * lo2(v); t = sb * hi2(v) + t; return t[0] + t[1]; }
__device__ __forceinline__ float dot8(const f32x2 (&S)[4], f32x4 va, f32x4 vb) { f32x2 t = S[0] * lo2(va); t = S[1] * hi2(va) + t; t = S[2] * lo2(vb) + t; t = S[3] * hi2(vb) + t; return t[0] + t[1]; }
template <int KIND> __device__ __forceinline__ void rec_block(const unsigned char* __restrict__ gp, const unsigned char* __restrict__ gs, u16* __restrict__ outp  ,
                                                             int rowl0  , LAS unsigned char* lds) {
    const int tid = otid(), lane = tid & 63, wid = tid >> 6, g = lane >> 4, j = lane & 15;
    const int cw = wid & 3; const bool is_ld = wid >= 4;
    const int rowl = rowl0 + cw * 4 + g;
    const int lt = cw * 64 + lane;
    constexpr int NCH = TS / RC;
    constexpr int CB = (RC / 2) * 1536;
    u32x4 st[6]; u32x4 ss0, ss1;
#define LD_ISSUE(c) do { const unsigned char* np = gp + (size_t)(c) * CB; const unsigned char* ns = gs + (size_t)(c) * (RC * 16); \
        _Pragma("unroll") for (int i = 0; i < 6; ++i) st[i] = *(const u32x4*)(np + (size_t)(lt + 256 * i) * 16); \
        if (lt < 32) ss0 = *(const u32x4*)(ns + lt * 16); } while (0)
#define LD_COMMIT(buf) do { LAS unsigned char* Bn = lds + 4096 + (buf) * RBUF; \
        _Pragma("unroll") for (int i = 0; i < 6; ++i) { const int q = lt + 256 * i, slot = (q % 96) >> 3; \
            const u32x4 w = st[i]; f32x4 a, b; \
            { const unsigned w0 = w[0], w1 = w[1], w2 = w[2], w3 = w[3]; const h16x2 h0 = __builtin_bit_cast(h16x2, w0), h1 = __builtin_bit_cast(h16x2, w1), h2 = __builtin_bit_cast(h16x2, w2), h3 = __builtin_bit_cast(h16x2, w3); \
              a[0] = (float)h0[0]; a[1] = (float)h0[1]; a[2] = (float)h1[0]; a[3] = (float)h1[1]; b[0] = (float)h2[0]; b[1] = (float)h2[1]; b[2] = (float)h3[0]; b[3] = (float)h3[1]; } \
            if (KIND == 0 && slot == 4) { a = 1.0f - a; b = 1.0f - b; } \
            *(LAS f32x4*)(Bn + q * 32) = a; *(LAS f32x4*)(Bn + q * 32 + 16) = b; } \
        if (lt < 32) *(LAS u32x4*)(Bn + (RC / 2) * RPB + lt * 16) = ss0; } while (0)
#define Y_OUT(c) do { const LAS float* yb = (const LAS float*)(lds + ((c) & 1) * 2048); const int stp = lt >> 3, rp = (lt & 7) * 2; \
        const f32x2 yv = *(const LAS f32x2*)(yb + stp * 16 + rp); *(unsigned*)(outp + ((size_t)(c) * RC + stp) * DM + rp) = pk_bf(yv[0], yv[1]); } while (0)
    if (is_ld) { LD_ISSUE(0); LD_COMMIT(0); LD_ISSUE(1); }
    __syncthreads();
    f32x2 Sv[4];
#pragma unroll
    for (int i = 0; i < 4; ++i) { Sv[i][0] = 0.f; Sv[i][1] = 0.f; }
    for (int c = 0; c < NCH; ++c) {
        if (is_ld) {
            if (c + 1 < NCH) { LD_COMMIT((c + 1) & 1); if (c + 2 < NCH) LD_ISSUE(c + 2); }
            if (c > 0) Y_OUT(c - 1);
        } else {
            const LAS unsigned char* B = lds + 4096 + (c & 1) * RBUF;
            const LAS unsigned char* Sc = B + (RC / 2) * RPB;
            LAS float* yw = (LAS float*)(lds + (c & 1) * 2048) + (cw * 4 + g);
            if (KIND == 0) {
                f32x4 n_kk, n_wr, n_x2, n_z2, n_W, n_B1, n_K1, n_b2, n_kp2, n_sA, n_sB; float n_v1, n_v2;
#define RW_LD(p) do { const LAS unsigned char* Pp = B + (p) * RPB + j * 16; \
                    n_kk = *(const LAS f32x4*)(Pp); n_wr = *(const LAS f32x4*)(Pp + 256); n_x2 = *(const LAS f32x4*)(Pp + 512); n_z2 = *(const LAS f32x4*)(Pp + 768); \
                    n_W = *(const LAS f32x4*)(Pp + 1024); n_B1 = *(const LAS f32x4*)(Pp + 1280); n_K1 = *(const LAS f32x4*)(Pp + 1536); n_b2 = *(const LAS f32x4*)(Pp + 1792); n_kp2 = *(const LAS f32x4*)(Pp + 2048); \
                    n_v1 = *(const LAS float*)(B + (p) * RPB + 2304 + rowl * 4); n_v2 = *(const LAS float*)(B + (p) * RPB + 2560 + rowl * 4); \
                    n_sA = *(const LAS f32x4*)(Sc + (p) * 32); n_sB = *(const LAS f32x4*)(Sc + (p) * 32 + 16); } while (0)
                RW_LD(0);
#pragma unroll 16
                for (int p = 0; p < RC / 2; ++p) {
                    const f32x4 kk = n_kk, wr = n_wr, x2 = n_x2, z2 = n_z2, W = n_W, B1 = n_B1, K1 = n_K1, b2 = n_b2, kp2 = n_kp2, sA = n_sA, sB = n_sB; const float v1 = n_v1, v2 = n_v2;
                    { const int pn = (p + 1 < RC / 2) ? p + 1 : p; RW_LD(pn); }
                    float d0 = dot4(Sv[0], Sv[1], kk), d1 = dot4(Sv[0], Sv[1], wr), d2 = dot4(Sv[0], Sv[1], x2), d3 = dot4(Sv[0], Sv[1], z2);
                    d0 = red16(d0); d1 = red16(d1); d2 = red16(d2); d3 = red16(d3);
                    const float sa1 = d0;
                    const float y1 = d1 - sa1 * sA[0] + v1 * sA[1];
                    const float sa2 = d2 - sa1 * sA[2] + v1 * sA[3];
                    const float y2 = (d3 - sa1 * sB[2] + v1 * sB[3]) - sa2 * sB[0] + v2 * sB[1];
                    yw[(2 * p) * 16] = y1; yw[(2 * p + 1) * 16] = y2;
                    const float n1 = -sa1, n2 = -sa2;
                    Sv[0] = lo2(b2) * n2 + (lo2(kp2) * v2 + (lo2(B1) * n1 + (lo2(K1) * v1 + Sv[0] * lo2(W))));
                    Sv[1] = hi2(b2) * n2 + (hi2(kp2) * v2 + (hi2(B1) * n1 + (hi2(K1) * v1 + Sv[1] * hi2(W))));
                }
            } else {
                f32x4 n_k1a, n_k1b, n_q1a, n_q1b, n_k2a, n_k2b, n_q2a, n_q2b, n_sA, n_sB; float n_v1, n_v2;
#define GD_LD(p) do { const LAS unsigned char* Pp = B + (p) * RPB + j * 32; \
                    n_k1a = *(const LAS f32x4*)(Pp); n_k1b = *(const LAS f32x4*)(Pp + 16); n_q1a = *(const LAS f32x4*)(Pp + 512); n_q1b = *(const LAS f32x4*)(Pp + 528); \
                    n_k2a = *(const LAS f32x4*)(Pp + 1536); n_k2b = *(const LAS f32x4*)(Pp + 1552); n_q2a = *(const LAS f32x4*)(Pp + 2048); n_q2b = *(const LAS f32x4*)(Pp + 2064); \
                    n_v1 = *(const LAS float*)(B + (p) * RPB + 1024 + rowl * 4); n_v2 = *(const LAS float*)(B + (p) * RPB + 2560 + rowl * 4); \
                    n_sA = *(const LAS f32x4*)(Sc + (p) * 32); n_sB = *(const LAS f32x4*)(Sc + (p) * 32 + 16); } while (0)
                GD_LD(0);
#pragma unroll 16
                for (int p = 0; p < RC / 2; ++p) {
                    const f32x4 k1a = n_k1a, k1b = n_k1b, q1a = n_q1a, q1b = n_q1b, k2a = n_k2a, k2b = n_k2b, q2a = n_q2a, q2b = n_q2b, sA = n_sA, sB = n_sB; const float v1 = n_v1, v2 = n_v2;
                    { const int pn = (p + 1 < RC / 2) ? p + 1 : p; GD_LD(pn); }
                    float a1 = dot8(Sv, k1a, k1b), c1 = dot8(Sv, q1a, q1b), a2 = dot8(Sv, k2a, k2b), c2 = dot8(Sv, q2a, q2b);
                    a1 = red16(a1); c1 = red16(c1); a2 = red16(a2); c2 = red16(c2);
                    const float al1 = sA[0], al2 = sB[0];
                    const float vn1 = sA[1] * (v1 - al1 * a1);
                    const float o1 = al1 * c1 + sA[2] * vn1;
                    const float vn2 = sB[1] * (v2 - al2 * (al1 * a2 + sA[3] * vn1));
                    const float o2 = al2 * (al1 * c2 + sB[3] * vn1) + sB[2] * vn2;
                    yw[(2 * p) * 16] = o1; yw[(2 * p + 1) * 16] = o2;
                    const float cS = al1 * al2, w1 = al2 * vn1;
                    Sv[0] = lo2(k2a) * vn2 + (lo2(k1a) * w1 + Sv[0] * cS);
                    Sv[1] = hi2(k2a) * vn2 + (hi2(k1a) * w1 + Sv[1] * cS);
                    Sv[2] = lo2(k2b) * vn2 + (lo2(k1b) * w1 + Sv[2] * cS);
                    Sv[3] = hi2(k2b) * vn2 + (hi2(k1b) * w1 + Sv[3] * cS);
                }
            }
        }
        __syncthreads();
    }
    if (is_ld) Y_OUT(NCH - 1);
#undef LD_ISSUE
#undef LD_COMMIT
#undef Y_OUT
}
__device__ __forceinline__ void lru_carry(int grp  , const u16* __restrict__ LRA, const u16* __restrict__ LRUb, float* __restrict__ HIN) {
    const int lane = otid() & 63;
    const int b = grp >> 3, ch = (grp & 7) * 64 + lane;
    float h = 0.f;
    for (int c = 0; c < TS / 64; c += 8) {
        float a[8], u[8];
#pragma unroll
        for (int k = 0; k < 8; ++k) { const size_t m = (size_t)b * TS + (c + k) * 64 + 63; a[k] = bf2f(LRA[m * 512 + ch]); u[k] = bf2f(LRUb[m * 512 + ch]); }
#pragma unroll
        for (int k = 0; k < 8; ++k) { HIN[((size_t)b * 256 + c + k) * 512 + ch] = h; h = a[k] * h + u[k]; }
    }
}
__device__ __forceinline__ void post_lr(u16* __restrict__ MIX, const u16* __restrict__ Z2, const u16* __restrict__ LRA, const u16* __restrict__ LRUb, const float* __restrict__ HIN) {
    const int tid = otid(); const int bidx = obid(), gdim = ogrid();
    for (int it = bidx * 512 + tid; it < MT * 128; it += gdim * 512) {
        const int m = it >> 7, c4 = (it & 127) * 4, b = m >> 14, chunk = (m & (TS - 1)) >> 6;
        const u32x2 pw = *(const u32x2*)(LRA + (size_t)m * 512 + c4), hw = *(const u32x2*)(LRUb + (size_t)m * 512 + c4); const f32x4 hin = *(const f32x4*)(HIN + ((size_t)b * 256 + chunk) * 512 + c4);
        f32x4 pc, hl; pc[0] = bflo(pw.x); pc[1] = bfhi(pw.x); pc[2] = bflo(pw.y); pc[3] = bfhi(pw.y); hl[0] = bflo(hw.x); hl[1] = bfhi(hw.x); hl[2] = bflo(hw.y); hl[3] = bfhi(hw.y);
        const u32x2 yw = *(const u32x2*)(Z2 + (size_t)m * Z2_LD + Z2_YL + c4);
        const f32x4 h = hl + pc * hin;
        u32x2 o; o.x = pk_bf(h[0] * gelu_tanh(bflo(yw.x)), h[1] * gelu_tanh(bfhi(yw.x))); o.y = pk_bf(h[2] * gelu_tanh(bflo(yw.y)), h[3] * gelu_tanh(bfhi(yw.y)));
        *(u32x2*)(MIX + (size_t)m * DM + 1536 + c4) = o;
    }
}

__device__ __forceinline__ void post_rw(u16* __restrict__ MIX, const h16* __restrict__ RWP, const float* __restrict__ BON, const u16* __restrict__ ZG,
                                        const float* __restrict__ g2, const float* __restrict__ lng, const float* __restrict__ lnb) {
    const int tid_ = otid(); const int lane = tid_ & 63, wid = tid_ >> 6; const int bidx = obid(), gdim = ogrid();
    for (int task = bidx * 8 + wid; task < 12 * (MT / 64); task += gdim * 8) {
        const int hh = task % 12, chunk = task / 12, m0 = chunk * 64, b = m0 >> 14, t0 = m0 & (TS - 1);
        const int col = hh * 64 + lane;
        float gc[128];
#pragma unroll
        for (int i = 0; i < 128; ++i) gc[i] = g2[i * 768 + col];
        const float lg = lng[col], lb = lnb[col];
        for (int s4 = 0; s4 < 64; s4 += 4) {
          u16 ly[4]; h16 lv[4]; float lbon[4]; unsigned lsw[4];
#pragma unroll
          for (int k = 0; k < 4; ++k) { const int m = m0 + s4 + k; const size_t rec = (size_t)(b * 12 + hh) * TS + (t0 + s4 + k);
              ly[k] = MIX[(size_t)m * DM + col]; lv[k] = RWP[(rec >> 1) * 768 + (9 + (int)(rec & 1)) * 64 + lane]; lbon[k] = BON[rec]; lsw[k] = *(const unsigned*)(ZG + (size_t)m * 128 + 2 * lane); }
#pragma unroll
          for (int k = 0; k < 4; ++k) {
            const int m = m0 + s4 + k;
            const float y = bf2f(ly[k]);
            const float mean = wave_sum(y) * (1.0f / 64.0f);
            const float d = y - mean;
            const float var = wave_sum(d * d) * (1.0f / 64.0f);
            const float yn = d * rsqrtf(var + 64e-5f) * lg + lb;
            const float v = (float)lv[k];
            const float bonus = lbon[k];
            const unsigned sw = lsw[k];
            const float s0 = bflo(sw), s1 = bfhi(sw);
            float ga = 0.f, gb = 0.f;
#pragma unroll
            for (int i = 0; i < 64; ++i) { ga += rlane(s0, i) * gc[2 * i]; gb += rlane(s1, i) * gc[2 * i + 1]; }
            MIX[(size_t)m * DM + col] = f2bf((yn + bonus * v) * (ga + gb));
          }
        }
    }
}
__device__ __forceinline__ void post_rw2(u16* __restrict__ MIX, const h16* __restrict__ RWP, const float* __restrict__ BON, const u16* __restrict__ ZG,
                                         const u16* __restrict__ G2T, const float* __restrict__ lng, const float* __restrict__ lnb) {
    const int tid_ = otid(); const int lane = tid_ & 63, wid = tid_ >> 6, fr = lane & 15, fq = lane >> 4; const int bidx = obid(), gdim = ogrid();
    for (int task = bidx * 8 + wid; task < 12 * (MT / 16); task += gdim * 8) {
        const int hh = task % 12, chunk = task / 12, mB = chunk * 16, b = mB >> 14, tB = mB & (TS - 1);
        const int j0 = hh * 64 + 4 * fr;
        u32x2 yw[4]; h16x4 vv[4]; float bon[4];
#pragma unroll
        for (int r = 0; r < 4; ++r) { const int m = mB + 4 * fq + r; const size_t rec = (size_t)(b * 12 + hh) * TS + (tB + 4 * fq + r);
            yw[r] = *(const u32x2*)(MIX + (size_t)m * DM + j0); vv[r] = *(const h16x4*)(RWP + (rec >> 1) * 768 + (9 + (int)(rec & 1)) * 64 + 4 * fr); bon[r] = BON[rec]; }
        const f32x4 lg = *(const f32x4*)(lng + j0), lb = *(const f32x4*)(lnb + j0);
        f32x4 acc[4];
#pragma unroll
        for (int n = 0; n < 4; ++n) acc[n] = (f32x4){0.f, 0.f, 0.f, 0.f};
#pragma unroll
        for (int ks = 0; ks < 4; ++ks) {
            const bf16x8_t a_ = *(const bf16x8_t*)(ZG + (size_t)(mB + fr) * 128 + ks * 32 + fq * 8);
#pragma unroll
            for (int n = 0; n < 4; ++n) { const bf16x8_t b_ = *(const bf16x8_t*)(G2T + (size_t)(j0 + n) * 128 + ks * 32 + fq * 8);
                acc[n] = __builtin_amdgcn_mfma_f32_16x16x32_bf16(a_, b_, acc[n], 0, 0, 0); }
        }
#pragma unroll
        for (int r = 0; r < 4; ++r) {
            const int m = mB + 4 * fq + r;
            f32x4 y; y[0] = bflo(yw[r].x); y[1] = bfhi(yw[r].x); y[2] = bflo(yw[r].y); y[3] = bfhi(yw[r].y);
            const float mean = red16((y[0] + y[1]) + (y[2] + y[3])) * (1.0f / 64.0f);
            const f32x4 d = y - mean;
            const float var = red16((d[0] * d[0] + d[1] * d[1]) + (d[2] * d[2] + d[3] * d[3])) * (1.0f / 64.0f);
            const float rs = rsqrtf(var + 64e-5f);
            f32x4 o;
#pragma unroll
            for (int n = 0; n < 4; ++n) o[n] = (d[n] * rs * lg[n] + lb[n] + bon[r] * (float)vv[r][n]) * acc[n][r];
            u32x2 w; w.x = pk_bf(o[0], o[1]); w.y = pk_bf(o[2], o[3]);
            *(u32x2*)(MIX + (size_t)m * DM + j0) = w;
        }
    }
}
__device__ __forceinline__ void post_gd(u16* __restrict__ MIX, const u16* __restrict__ Z2, const float* __restrict__ ng) {
    const int tid_ = otid(); const int lane = tid_ & 63, wid = tid_ >> 6; const int bidx = obid(), gdim = ogrid();
    for (int task = bidx * 8 + wid; task < 6 * (MT / 32); task += gdim * 8) {
        const int hh = task % 6, chunk = task / 6, m0 = chunk * 32;
        const float n0 = ng[2 * lane], n1 = ng[2 * lane + 1];
        for (int s8 = 0; s8 < 32; s8 += 8) {
          unsigned lo[8], lg[8];
#pragma unroll
          for (int k = 0; k < 8; ++k) { const int m = m0 + s8 + k; lo[k] = *(const unsigned*)(MIX + (size_t)m * DM + 768 + hh * 128 + 2 * lane); lg[k] = *(const unsigned*)(Z2 + (size_t)m * Z2_LD + Z2_GATE + hh * 128 + 2 * lane); }
#pragma unroll
          for (int k = 0; k < 8; ++k) {
            const int m = m0 + s8 + k;
            unsigned* op = (unsigned*)(MIX + (size_t)m * DM + 768 + hh * 128 + 2 * lane);
            const unsigned ow = lo[k];
            const float o0 = bflo(ow), o1 = bfhi(ow);
            const float ss = wave_sum(o0 * o0 + o1 * o1);
            const float rs = rsqrtf(ss * (1.0f / 128.0f) + 1e-6f);
            const unsigned gw = lg[k];
            const float g0 = bflo(gw), g1 = bfhi(gw);
            *op = pk_bf(o0 * rs * n0 * (g0 * sigm(g0)), o1 * rs * n1 * (g1 * sigm(g1)));
          }
        }
    }
}

#define XB_TMO      128
#define XB_XCNT(j)  (256  + 64 * (j))
#define XB_XSUB(j)  (1280 + 64 * (j))
#define XB_XGEN(j)  (2304 + 64 * (j))
#define XB_TOP      3328
#define XB_TOPGEN   3392
#define XCD_BAR_WORDS 3456
#define XB_SPIN_CAP (1u << 18)

__device__ __forceinline__ unsigned xb_ld(unsigned* p)              { return __hip_atomic_load(p, __ATOMIC_RELAXED, __HIP_MEMORY_SCOPE_AGENT); }
__device__ __forceinline__ unsigned xb_add(unsigned* p, unsigned v) { return __hip_atomic_fetch_add(p, v, __ATOMIC_RELAXED, __HIP_MEMORY_SCOPE_AGENT); }
__device__ __forceinline__ unsigned xb_xcc_id() { return (unsigned)__builtin_amdgcn_s_getreg((3 << 11) | 20) & 0xFu; }
#define XB_SPIN(cond, bar) do { unsigned _sp = 0; while (cond) { __builtin_amdgcn_s_sleep(1); \
    if ((++_sp & 255u) == 0u) { if (xb_ld(&(bar)[XB_TMO])) break; if (_sp > XB_SPIN_CAP) { atomicAdd(&(bar)[XB_TMO], 1u); break; } } } } while (0)

struct XcdBarrier {
    unsigned* bar; unsigned x;
    volatile LAS unsigned* st;
};

__device__ __forceinline__ XcdBarrier xcd_barrier_post(unsigned* bar, volatile LAS unsigned* st) {
    XcdBarrier b; b.bar = bar; b.x = xb_xcc_id(); b.st = st;
    if (threadIdx.x == 0) (void)xb_add(&bar[XB_XCNT(b.x)], 1u);
    return b;
}
__device__ __forceinline__ void xcd_barrier_complete(unsigned* bar, unsigned x, unsigned& nloc, unsigned& nx) {
    const unsigned G = gridDim.x * gridDim.y * gridDim.z;
    unsigned sum, cnt, mine, sp = 0u;
    for (;;) {
        sum = 0u; cnt = 0u; mine = 0u;
#pragma unroll
        for (unsigned j = 0; j < 16; ++j) { const unsigned c = xb_ld(&bar[XB_XCNT(j)]); sum += c; cnt += (c > 0u) ? 1u : 0u; mine = (j == x) ? c : mine; }
        if (sum == G) break;
        __builtin_amdgcn_s_sleep(1);
        if ((++sp & 255u) == 0u) { if (xb_ld(&bar[XB_TMO])) break; if (sp > XB_SPIN_CAP) { atomicAdd(&bar[XB_TMO], 1u); break; } }
    }
    nloc = mine > 0u ? mine : 1u; nx = cnt > 0u ? cnt : 1u;
}

__device__ __forceinline__ void xcd_barrier(const XcdBarrier& b) {
    asm volatile("s_waitcnt vmcnt(0)" ::: "memory");
    __syncthreads();
    if (threadIdx.x == 0) {
        unsigned* bar = b.bar;
        __builtin_amdgcn_s_waitcnt(0);
        unsigned nloc = b.st[0], nx = b.st[1];
        if (nloc == 0u) { xcd_barrier_complete(bar, b.x, nloc, nx); b.st[0] = nloc; b.st[1] = nx; }
        const unsigned old = xb_add(&bar[XB_XSUB(b.x)], 1u);
        const unsigned gen = old / nloc;
        if (old + 1u == (gen + 1u) * nloc) {
            __builtin_amdgcn_fence(__ATOMIC_RELEASE, "agent");
            asm volatile("s_waitcnt vmcnt(0)" ::: "memory");
            const unsigned og = xb_add(&bar[XB_TOP], 1u);
            const unsigned tg = og / nx;
            if (og + 1u == (tg + 1u) * nx) xb_add(&bar[XB_TOPGEN], 1u);
            else XB_SPIN(xb_ld(&bar[XB_TOPGEN]) == tg, bar);
            __builtin_amdgcn_fence(__ATOMIC_ACQUIRE, "agent");
            xb_add(&bar[XB_XGEN(b.x)], 1u);
            asm volatile("s_waitcnt vmcnt(0)" ::: "memory");
        } else {
            XB_SPIN(xb_ld(&bar[XB_XGEN(b.x)]) == gen, bar);
            __builtin_amdgcn_fence(__ATOMIC_ACQUIRE, "agent");
            asm volatile("s_waitcnt vmcnt(0)" ::: "memory");
        }
    }
    __syncthreads();
}
__device__ __forceinline__ const float* getp(const LAS unsigned* TAB, int k) {
    const unsigned lo = __builtin_amdgcn_readfirstlane(TAB[2 * k]), hi = __builtin_amdgcn_readfirstlane(TAB[2 * k + 1]);
    return (const float*)(((unsigned long long)hi << 32) | lo);
}
__global__ void __launch_bounds__(512, 2) fwd_mega(Params p) {
    extern __shared__ __attribute__((aligned(16))) unsigned char lds_raw[];
    LAS unsigned char* lds = (LAS unsigned char*)lds_raw;
    cg::grid_group grid = cg::this_grid();
#if REP & 256
#define GSYNC() do { xcd_barrier(xbar); xcd_barrier(xbar); } while (0)
#else
#define GSYNC() xcd_barrier(xbar)
#endif
    unsigned char* ws = p.ws;
    u16* HBUF = (u16*)(ws + WS_HBUF); u16* WGU = (u16*)(ws + WS_WGU); u16* WD = (u16*)(ws + WS_WD); u16* WIN = (u16*)(ws + WS_WIN); u16* WOUT = (u16*)(ws + WS_WOUT);
    u16* ACT = (u16*)(ws + WS_ACT); u16* Z = (u16*)(ws + WS_Z); h16* RWPp = (h16*)(ws + WS_RWP); float* RWSp = (float*)(ws + WS_RWS); u16* ZG = (u16*)(ws + WS_ZG);
    h16* GDPp = (h16*)(ws + WS_GDP); float* GDSp = (float*)(ws + WS_GDS); u16* LRA = (u16*)(ws + WS_LRA); u16* LRUb = (u16*)(ws + WS_LRU); u16* WGU2 = (u16*)(ws + WS_WGU2); u16* WD2 = (u16*)(ws + WS_WD2);
    const bool pre2 = gridDim.x > 208;     float* HIN = (float*)(ws + WS_HIN); float* BONp = (float*)(ws + WS_BON);
    float* X = p.out;
    const int G = gridDim.x, bid = blockIdx.x;
    LAS unsigned* TAB = (LAS unsigned*)(lds + 131072 + 1024);
    if (threadIdx.x == 0) {
#pragma unroll
        for (int i = 0; i < 35; ++i) { const unsigned long long a = (unsigned long long)p.in[i]; TAB[2 * i] = (unsigned)a; TAB[2 * i + 1] = (unsigned)(a >> 32); }
    }
    volatile LAS unsigned* xst = (volatile LAS unsigned*)(lds + 131072 + 512);
    if (threadIdx.x < 2) xst[threadIdx.x] = 0u;
    __syncthreads();
    const XcdBarrier xbar = xcd_barrier_post((unsigned*)(ws + WS_BAR), xst);
    grid.sync();
#define INP(k) getp(TAB, (k))

    for (int l = 0; l < 2; ++l) {
        for (int half = 0; half < 2; ++half) {
            const float* ng = INP(half ? 30 : 1) + (size_t)l * DM;
            const float* wg = INP(half ? 31 : 2) + (size_t)l * DM * DFF;
            const float* wu = INP(half ? 32 : 3) + (size_t)l * DM * DFF;
            const float* wd = INP(half ? 33 : 4) + (size_t)l * DM * DFF;
#if PH & 1
            u16* const WGUc = (half && pre2) ? WGU2 : WGU; u16* const WDc = (half && pre2) ? WD2 : WD;
            if (!(half && pre2)) {
            conv_w<1>(wg, WGUc, DM, DFF, (LAS float*)lds);
            conv_w<2>(wu, WGUc, DM, DFF, (LAS float*)lds);
            conv_w<0>(wd, WDc, DFF, DM, (LAS float*)lds);
            }
#endif
#if PH & 2
            if (l == 0 && half == 0) norm_rows<false>(INP(0), ng, HBUF, nullptr); else norm_rows<false>(X, ng, HBUF, nullptr);
#endif
#if REP & 32
            conv_w<1>(wg, WGU, DM, DFF, (LAS float*)lds);
            conv_w<2>(wu, WGU, DM, DFF, (LAS float*)lds);
            conv_w<0>(wd, WD, DFF, DM, (LAS float*)lds);
#endif
#if REP & 64
            if (l == 0 && half == 0) norm_rows<false>(INP(0), ng, HBUF, X); else norm_rows<false>(X, ng, HBUF, nullptr);
#endif
            GSYNC();
#if PH & 4
            { pg8::Gemm g{HBUF, WGUc, MT, 2 * DFF, DM}; pg8::StaticOrder S; S.init(MT, 2 * DFF, G, bid); pg8::EpiGU E{ACT, DFF};
              pg8::gemm_phase<pg8::EpiGU, pg8::StaticOrder>(lds, g, S, E);
#if REP & 1
              GSYNC(); pg8::gemm_phase<pg8::EpiGU, pg8::StaticOrder>(lds, g, S, E);
#endif
            }
#endif
            GSYNC();
#if PH & 8
            { pg8::Gemm g{ACT, WDc, MT, DM, DFF}; pg8::StaticOrder S; S.init(MT, DM, G, bid); pg8::EpiResid E{(l == 0 && half == 0) ? INP(0) : (const float*)X, X, DM, (REP & 2) ? 0.25f : 0.5f};
              pg8::gemm_phase<pg8::EpiResid, pg8::StaticOrder, true>(lds, g, S, E);
#if REP & 2
              GSYNC(); pg8::gemm_phase<pg8::EpiResid, pg8::StaticOrder, true>(lds, g, S, E);
#endif
            }
#endif
            GSYNC();
            if (half == 1) continue;
#if PH & 16
            conv_w<3>(INP(6) + (size_t)l * DM * 6668, WIN, DM, 6668, (LAS float*)lds);
            conv_w<0>(INP(29) + (size_t)l * DM * DM, WOUT, DM, DM, (LAS float*)lds);
            tr_small(INP(9) + l * 64 * 768, (u16*)(ws + WS_W2T), 64); tr_small(INP(11) + l * 64 * 768, (u16*)(ws + WS_A2T), 64); tr_small(INP(12) + l * 128 * 768, (u16*)(ws + WS_G2T), 128);
            tr_blocks(INP(24) + l * 8 * 64 * 64, (u16*)(ws + WS_WAT)); tr_blocks(INP(26) + l * 8 * 64 * 64, (u16*)(ws + WS_WXT));
            norm_rows<false>(X, INP(5) + (size_t)l * DM, HBUF, nullptr);
#endif
            GSYNC();
#if PH & 32
            { pg8::Gemm g{HBUF, WIN, MT, 2560, DM}; pg8::StaticOrder S; S.init(MT, 2560, G, bid); pg8::EpiZ E{Z, Z1_LD};
              pg8::gemm_phase<pg8::EpiZ, pg8::StaticOrder>(lds, g, S, E); }
#endif
            GSYNC();
#if PH & 64
            { RwP P{INP(7) + l * 2560, INP(8) + l * 768, INP(9) + l * 64 * 768, INP(10) + l * 768, INP(11) + l * 64 * 768, INP(13) + l * 768, INP(14) + l * 768, INP(15) + l * 768};
              prep_rw2(Z, P, (const u16*)(ws + WS_W2T), (const u16*)(ws + WS_A2T), RWPp, RWSp, BONp, ZG, lds);
#if REP & 8
              prep_rw2(Z, P, (const u16*)(ws + WS_W2T), (const u16*)(ws + WS_A2T), RWPp, RWSp, BONp, ZG, lds);
#endif
            }
#endif
            GSYNC();
#if PH & 128
            { pg8::Gemm g{HBUF, WIN + (size_t)2560 * DM, MT, 4352, DM}; pg8::StaticOrder S; S.init(MT, 4352, G, bid); pg8::EpiZ E{Z, Z2_LD};
              pg8::gemm_phase<pg8::EpiZ, pg8::StaticOrder>(lds, g, S, E); }
#endif
            GSYNC();
#if PH & 256
            prep_gd(Z, INP(18) + l * 4 * 2304, INP(19) + l * 6, INP(20) + l * 6, GDPp, GDSp);
#endif
#if PH & 512
            { LrP P{INP(22) + l * 4 * 512, INP(23) + l * 512, INP(24) + l * 8 * 64 * 64, INP(25) + l * 512, INP(26) + l * 8 * 64 * 64, INP(27) + l * 512, INP(28) + l * 512};
              prep_lr2(Z, P, (const u16*)(ws + WS_WAT), (const u16*)(ws + WS_WXT), LRA, LRUb, lds);
            }
#endif
            GSYNC();
#if PH & 1024
            for (int rep_ = 0; rep_ < ((REP & 4) ? 2 : 1); ++rep_)
            for (int task = bid; task < 208; task += G) {
                if (task < 96) { const int bh = task >> 2, q4 = task & 3, b = bh / 12, hh = bh % 12;
                    rec_block<0>((const unsigned char*)RWPp + (size_t)bh * TS * 768, (const unsigned char*)RWSp + (size_t)bh * TS * 16,
                                 HBUF + (size_t)b * TS * DM + hh * 64 + q4 * 16, q4 * 16, lds); }
                else if (task < 192) { const int gb = task - 96, bh = gb >> 3, o8 = gb & 7, b = bh / 6, hh = bh % 6;
                    rec_block<1>((const unsigned char*)GDPp + (size_t)bh * TS * 768, (const unsigned char*)GDSp + (size_t)bh * TS * 16,
                                 HBUF + (size_t)b * TS * DM + 768 + hh * 128 + o8 * 16, o8 * 16, lds); }
                else if (threadIdx.x < 64) lru_carry(task - 192, LRA, LRUb, HIN);
            }
            if (pre2 && bid >= 208) {
                conv_w<1>(INP(31) + (size_t)l * DM * DFF, WGU2, DM, DFF, (LAS float*)lds, bid - 208, G - 208);
                conv_w<2>(INP(32) + (size_t)l * DM * DFF, WGU2, DM, DFF, (LAS float*)lds, bid - 208, G - 208);
                conv_w<0>(INP(33) + (size_t)l * DM * DFF, WD2, DFF, DM, (LAS float*)lds, bid - 208, G - 208);
            }
#endif
            GSYNC();
#if PH & 2048
            post_rw2(HBUF, RWPp, BONp, ZG, (const u16*)(ws + WS_G2T), INP(16) + l * 768, INP(17) + l * 768);
#endif
#if PH & 4096
            post_gd(HBUF, Z, INP(21) + l * 128);
            post_lr(HBUF, Z, LRA, LRUb, HIN);
#endif
            GSYNC();
#if PH & 8192
            { pg8::Gemm g{HBUF, WOUT, MT, DM, DM}; pg8::StaticOrder S; S.init(MT, DM, G, bid); pg8::EpiResid E{X, X, DM, 1.0f};
              pg8::gemm_phase<pg8::EpiResid, pg8::StaticOrder>(lds, g, S, E); }
#endif
            GSYNC();
        }
    }
    norm_rows<true>(X, INP(34), nullptr, X);
}

extern "C" void kernel_launch(void* const* d_in, const int* in_sizes, int n_in, void* d_out, int out_size, void* d_ws, size_t ws_size, hipStream_t stream) {
    static int grid_blocks = 0;
    if (!grid_blocks) {
        int dev = 0, cus = 0, per_cu = 0;
        (void)hipGetDevice(&dev);
        (void)hipDeviceGetAttribute(&cus, hipDeviceAttributeMultiprocessorCount, dev);
        (void)hipFuncSetAttribute((const void*)fwd_mega, hipFuncAttributeMaxDynamicSharedMemorySize, LDS_BYTES);
        (void)hipOccupancyMaxActiveBlocksPerMultiprocessor(&per_cu, (const void*)fwd_mega, 512, LDS_BYTES);
        grid_blocks = cus > 0 ? cus : 256;
        if (ws_size < WS_END) fprintf(stderr, "kernel_launch: workspace too small: %zu < %zu\n", ws_size, (size_t)WS_END);
        fprintf(stderr, "kernel_launch: cus %d occupancy %d ws %zu n_in %d\n", cus, per_cu, ws_size, n_in);
    }
    Params p{};
    for (int i = 0; i < 35; ++i) p.in[i] = (const float*)d_in[i];
    p.out = (float*)d_out; p.ws = (unsigned char*)d_ws;
    (void)hipMemsetAsync((unsigned char*)d_ws + WS_BAR, 0, 16384, stream);
    void* args[] = {&p};
    hipError_t e = hipLaunchCooperativeKernel((const void*)fwd_mega, dim3(grid_blocks), dim3(512), args, LDS_BYTES, stream);
    if (e != hipSuccess) fprintf(stderr, "cooperative launch failed: %s (grid %d)\n", hipGetErrorString(e), grid_blocks);
}
```

```cpp
#include <hip/hip_runtime.h>
#include <hip/hip_cooperative_groups.h>
#include <cstdio>
namespace cg = cooperative_groups;
#include <hip/hip_runtime.h>
namespace pg8 {
#define PG8_LAS __attribute__((address_space(3)))
typedef unsigned short bf16_t;
typedef short bf16x8 __attribute__((ext_vector_type(8)));
typedef float f32x4 __attribute__((ext_vector_type(4)));
typedef unsigned u32x4 __attribute__((ext_vector_type(4)));
constexpr int BM = 256, BK = 64, HALF = 128, HTB = HALF * BK * 2  , STAGE_BYTES = 8 * HTB, NXCD = 8, WGM = 8;

__host__ __device__ __forceinline__ int lds_byte(int r, int c) { const int st = (r >> 4) * 2 + (c >> 5), rr = r & 15, cc = c & 31, ob = rr * 64 + cc * 2; return st * 1024 + (ob ^ (((ob >> 9) & 1) << 5)); }
__host__ __device__ __forceinline__ void stage_rc(int b, int& R, int& C) { const int st = b / 1024, sb = b % 1024, swz = sb ^ (((sb >> 9) & 1) << 5); R = (st >> 1) * 16 + swz / 64; C = (st & 1) * 32 + (swz % 64) / 2; }
__host__ __device__ __forceinline__ int perm32(int rho) { const int n = rho >> 4, i = rho & 15; return 8 * (i >> 2) + 4 * n + (i & 3); }

struct Unit { int pm, pn; };
struct Gemm { const bf16_t* A; const bf16_t* Bt; int M, N, K; };

struct StaticOrder {
    int nM, nN, nwg, G, c;
    __host__ __device__ void init(int M, int N, int G_, int c_) { nM = M / BM; nN = N / BM; nwg = nM * nN; G = G_; c = c_; }
    __host__ __device__ bool next(int i, Unit& u) const {
        const long L = (long)i * G + c; if (L >= nwg) return false;
        int wgid = (int)L; { const int q = nwg / NXCD, r = nwg % NXCD, xcd = wgid % NXCD, off = wgid / NXCD; wgid = (xcd < r ? xcd * (q + 1) : r * (q + 1) + (xcd - r) * q) + off; }
        const int nig = WGM * nN, gid = wgid / nig, fm = gid * WGM, gsz = (nM - fm) < WGM ? (nM - fm) : WGM;
        u.pm = fm + ((wgid % nig) % gsz); u.pn = (wgid % nig) / gsz; return true;
    }
    __device__ __forceinline__ void a_ready(const Unit&) const {}
    __device__ __forceinline__ void done(const Unit&) const {}
};
__device__ __forceinline__ unsigned cvt_pk_bf16(float lo, float hi) { unsigned r; asm volatile("v_cvt_pk_bf16_f32 %0, %1, %2" : "=v"(r) : "v"(lo), "v"(hi)); return r; }
typedef float f32x2 __attribute__((ext_vector_type(2)));
typedef unsigned u32x2 __attribute__((ext_vector_type(2)));
__device__ __forceinline__ float fast_silu(float g) { return g * __builtin_amdgcn_rcpf(1.0f + __expf(-g)); }
struct EpiGU {
    static constexpr bool PERM = true, AFTER_DRAIN = false;
    bf16_t* O; int ldc;
    __device__ __forceinline__ void operator()(const f32x4 (&acc)[2][2][4][2], const Unit& u, int wr, int wc, int fr, int fq) const {
        const int rl0 = wr * 64 + fr, col0 = u.pn * HALF + wc * 32 + 8 * fq;
        bf16_t* const blk = O + ((size_t)u.pm * (ldc >> 6) + (col0 >> 6)) * (BM * 64) + (col0 & 63);
#pragma unroll
        for (int ai = 0; ai < 2; ++ai)
#pragma unroll
            for (int m = 0; m < 4; ++m) { bf16_t* rowp = blk + (size_t)(rl0 + ai * HALF + m * 16) * 64;
                const f32x4 g0 = acc[ai][0][m][0], g1 = acc[ai][0][m][1], u0 = acc[ai][1][m][0], u1 = acc[ai][1][m][1];
                f32x4 h0, h1;
#pragma unroll
                for (int j = 0; j < 4; ++j) { h0[j] = fast_silu(g0[j]) * u0[j]; h1[j] = fast_silu(g1[j]) * u1[j]; }
                u32x4 w; w.x = cvt_pk_bf16(h0[0], h0[1]); w.y = cvt_pk_bf16(h0[2], h0[3]); w.z = cvt_pk_bf16(h1[0], h1[1]); w.w = cvt_pk_bf16(h1[2], h1[3]);
                *(u32x4*)rowp = w; }
    }
};
struct EpiZ {
    static constexpr bool PERM = true, AFTER_DRAIN = false;
    bf16_t* O; int ldc;
    __device__ __forceinline__ void operator()(const f32x4 (&acc)[2][2][4][2], const Unit& u, int wr, int wc, int fr, int fq) const {
        const int row0 = u.pm * BM + wr * 64 + fr, col0 = u.pn * BM + wc * 32 + 8 * fq;
#pragma unroll
        for (int ai = 0; ai < 2; ++ai)
#pragma unroll
            for (int m = 0; m < 4; ++m) { bf16_t* rowp = O + (size_t)(row0 + ai * HALF + m * 16) * ldc + col0;
#pragma unroll
                for (int bj = 0; bj < 2; ++bj) { const f32x4 v0 = acc[ai][bj][m][0], v1 = acc[ai][bj][m][1];
                    u32x4 w; w.x = cvt_pk_bf16(v0[0], v0[1]); w.y = cvt_pk_bf16(v0[2], v0[3]); w.z = cvt_pk_bf16(v1[0], v1[1]); w.w = cvt_pk_bf16(v1[2], v1[3]);
                    *(u32x4*)(rowp + bj * HALF) = w; } }
    }
};
struct EpiResid {
    static constexpr bool PERM = true, AFTER_DRAIN = false;
    const float* Xs; float* X; int ldc; float scale;
    __device__ __forceinline__ void operator()(const f32x4 (&acc)[2][2][4][2], const Unit& u, int wr, int wc, int fr, int fq) const {
        const int row0 = u.pm * BM + wr * 64 + fr, col0 = u.pn * BM + wc * 32 + 8 * fq;
#pragma unroll
        for (int ai = 0; ai < 2; ++ai)
#pragma unroll
            for (int m = 0; m < 4; ++m) { const size_t off = (size_t)(row0 + ai * HALF + m * 16) * ldc + col0;
#pragma unroll
                for (int bj = 0; bj < 2; ++bj) { const size_t o2 = off + bj * HALF;
                    const f32x4 x0 = *(const f32x4*)(Xs + o2) + acc[ai][bj][m][0] * scale, x1 = *(const f32x4*)(Xs + o2 + 4) + acc[ai][bj][m][1] * scale;
                    *(f32x4*)(X + o2) = x0; *(f32x4*)(X + o2 + 4) = x1; } }
    }
};
template <class Epi, class Sched, bool ABLK = false>
__device__ __forceinline__ void gemm_phase(PG8_LAS unsigned char* lds, const Gemm g, const Sched& S, const Epi& E) {
    int tid_o = threadIdx.x; asm volatile("" : "+v"(tid_o));
    const int tid = tid_o, wid = __builtin_amdgcn_readfirstlane(tid >> 6), lane = tid & 63, wr = wid >> 2, wc = wid & 3, fr = lane & 15, fq = lane >> 4;
    const int K = g.K, nt = K / BK;
    unsigned voffA[2], voffB[2];
#pragma unroll
    for (int i = 0; i < 2; ++i) { int R, C; stage_rc(tid * 16 + i * 8192, R, C); const int Rb = Epi::PERM ? ((R & ~31) + perm32(R & 31)) : R;
        voffA[i] = ABLK ? (unsigned)(R * BK + C) * 2u : (unsigned)(R * K + C) * 2u; voffB[i] = (unsigned)(Rb * K + C) * 2u; }
    const size_t kstep = (size_t)(BK * 2);
    const size_t hstep = (size_t)HALF * K * 2;
    const size_t tstep = 2 * hstep;
    const size_t kstepA = ABLK ? (size_t)(BM * BK * 2) : kstep, hstepA = ABLK ? (size_t)(HALF * BK * 2) : hstep, tstepA = tstep;
    const unsigned ldsw = (unsigned)wid * 1024u;
    const int aoff = lds_byte(wr * 64 + fr, fq * 8), boff = lds_byte(wc * 32 + fr, fq * 8);
#define PG8_SA(b, h) (((b) * 2 + (h)) * HTB)
#define PG8_SB(b, h) ((4 + (b) * 2 + (h)) * HTB)
#define PG8_STAGE(bufoff, gbase, voff) do { _Pragma("unroll") for (int _i = 0; _i < 2; ++_i) \
        __builtin_amdgcn_global_load_lds((const unsigned*)((const char*)(gbase) + (voff)[_i]), (PG8_LAS unsigned*)(lds + (bufoff) + ldsw + _i * 8192), 16, 0, 0); } while (0)
#define PG8_LDA(dst, b, h) do { _Pragma("unroll") for (int m = 0; m < 4; ++m) _Pragma("unroll") for (int k = 0; k < 2; ++k) dst[m][k] = *(const PG8_LAS bf16x8*)(lds + PG8_SA(b, h) + aoff + m * 2048 + k * 1024); } while (0)
#define PG8_LDB(dst, b, h) do { _Pragma("unroll") for (int n = 0; n < 2; ++n) _Pragma("unroll") for (int k = 0; k < 2; ++k) dst[n][k] = *(const PG8_LAS bf16x8*)(lds + PG8_SB(b, h) + boff + n * 2048 + k * 1024); } while (0)
#define PG8_MMA(ai, bj, At, Bt) do { __builtin_amdgcn_s_setprio(1); _Pragma("unroll") for (int m = 0; m < 4; ++m) _Pragma("unroll") for (int n = 0; n < 2; ++n) _Pragma("unroll") for (int k = 0; k < 2; ++k) \
        acc[ai][bj][m][n] = __builtin_amdgcn_mfma_f32_16x16x32_bf16(Bt[n][k], At[m][k], acc[ai][bj][m][n], 0, 0, 0); __builtin_amdgcn_s_setprio(0); } while (0)
#define PG8_WAIT_V(n) asm volatile("s_waitcnt vmcnt(" #n ")" ::: "memory")
#define PG8_WAIT_L(n) asm volatile("s_waitcnt lgkmcnt(" #n ")" ::: "memory")
#define PG8_BAR __builtin_amdgcn_s_barrier()
#define PG8_SCHED __builtin_amdgcn_sched_barrier(0)
    Unit cur, nxt; int ui = 0;
    if (!S.next(0, cur)) return;
    f32x4 acc[2][2][4][2];
#pragma unroll
    for (int a = 0; a < 2; ++a)
#pragma unroll
        for (int b = 0; b < 2; ++b)
#pragma unroll
            for (int m = 0; m < 4; ++m)
#pragma unroll
                for (int n = 0; n < 2; ++n) acc[a][b][m][n] = (f32x4){0.f, 0.f, 0.f, 0.f};
    bf16x8 At[4][2], B0[2][2], B1[2][2];
    const char* cA = (const char*)g.A + (size_t)cur.pm * tstepA; const char* cB = (const char*)g.Bt + (size_t)cur.pn * tstep;
    S.a_ready(cur);
    PG8_STAGE(PG8_SB(0, 0), cB, voffB); PG8_STAGE(PG8_SA(0, 0), cA, voffA); PG8_STAGE(PG8_SB(0, 1), cB + hstep, voffB); PG8_STAGE(PG8_SA(0, 1), cA + hstepA, voffA);
    if (wr == 1) PG8_BAR;
    PG8_WAIT_V(4); PG8_BAR;
    PG8_STAGE(PG8_SB(1, 0), cB + kstep, voffB); PG8_STAGE(PG8_SA(1, 0), cA + kstepA, voffA); PG8_STAGE(PG8_SB(1, 1), cB + hstep + kstep, voffB);
    PG8_WAIT_V(6); PG8_BAR;
    for (;;) {
        const bool has_next = S.next(ui + 1, nxt);
        const char* nA = has_next ? (const char*)g.A + (size_t)nxt.pm * tstepA : cA; const char* nB = has_next ? (const char*)g.Bt + (size_t)nxt.pn * tstep : cB;
        for (int t = 0; t < nt; t += 2) {
            const bool last = (t == nt - 2);
            const char* a1 = cA + (size_t)(t + 1) * kstepA;
            const char* a2 = last ? nA : cA + (size_t)(t + 2) * kstepA; const char* b2 = last ? nB : cB + (size_t)(t + 2) * kstep;
            const char* a3 = a2 + kstepA; const char* b3 = b2 + kstep;
            if (last && has_next) S.a_ready(nxt);
            PG8_LDB(B0, 0, 0); PG8_SCHED; PG8_LDA(At, 0, 0); PG8_STAGE(PG8_SA(1, 1), a1 + hstepA, voffA);
            PG8_WAIT_L(8); PG8_BAR; PG8_WAIT_L(0); PG8_MMA(0, 0, At, B0); PG8_BAR; PG8_SCHED;
            PG8_LDB(B1, 0, 1); PG8_STAGE(PG8_SB(0, 0), b2, voffB);
            PG8_BAR; PG8_WAIT_L(0); PG8_MMA(0, 1, At, B1); PG8_BAR;
            PG8_LDA(At, 0, 1); PG8_STAGE(PG8_SA(0, 0), a2, voffA);
            PG8_BAR; PG8_WAIT_L(0); PG8_MMA(1, 0, At, B0); PG8_BAR; PG8_SCHED;
            PG8_STAGE(PG8_SB(0, 1), b2 + hstep, voffB);
            PG8_WAIT_V(6); PG8_BAR; PG8_MMA(1, 1, At, B1); PG8_BAR;
            PG8_LDB(B0, 1, 0); PG8_SCHED; PG8_LDA(At, 1, 0); PG8_STAGE(PG8_SA(0, 1), a2 + hstepA, voffA);
            PG8_WAIT_L(8); PG8_BAR; PG8_WAIT_L(0); PG8_MMA(0, 0, At, B0); PG8_BAR; PG8_SCHED;
            PG8_LDB(B1, 1, 1); PG8_STAGE(PG8_SB(1, 0), b3, voffB);
            PG8_BAR; PG8_WAIT_L(0); PG8_MMA(0, 1, At, B1); PG8_BAR;
            PG8_LDA(At, 1, 1); PG8_STAGE(PG8_SA(1, 0), a3, voffA);
            PG8_BAR; PG8_WAIT_L(0); PG8_MMA(1, 0, At, B0); PG8_BAR; PG8_SCHED;
            PG8_STAGE(PG8_SB(1, 1), b3 + hstep, voffB);
            PG8_WAIT_V(6); PG8_BAR; PG8_MMA(1, 1, At, B1); PG8_BAR;
        }
        if constexpr (!Epi::AFTER_DRAIN) { E(acc, cur, wr, wc, fr, fq); S.done(cur); }
        if (!has_next) break;
#pragma unroll
        for (int a = 0; a < 2; ++a)
#pragma unroll
            for (int b = 0; b < 2; ++b)
#pragma unroll
                for (int m = 0; m < 4; ++m)
#pragma unroll
                    for (int n = 0; n < 2; ++n) acc[a][b][m][n] = (f32x4){0.f, 0.f, 0.f, 0.f};
        cur = nxt; cA = nA; cB = nB; ++ui;
    }
    PG8_WAIT_V(0);
    if (wr == 0) PG8_BAR;
    PG8_BAR;
    if constexpr (Epi::AFTER_DRAIN) { E.fused(acc, cur, wr, wc, fr, fq, lds, wid, lane); S.done(cur); }
#undef PG8_SA
#undef PG8_SB
#undef PG8_STAGE
#undef PG8_LDA
#undef PG8_LDB
#undef PG8_MMA
#undef PG8_WAIT_V
#undef PG8_WAIT_L
#undef PG8_BAR
#undef PG8_SCHED
}
}
#ifndef PH
#define PH 0xFFFF
#endif
#ifndef REP
#define REP 0
#endif
typedef unsigned short u16;
typedef float f32x4 __attribute__((ext_vector_type(4)));
typedef float f32x2 __attribute__((ext_vector_type(2)));
typedef unsigned u32x4 __attribute__((ext_vector_type(4)));
typedef unsigned u32x2 __attribute__((ext_vector_type(2)));
typedef _Float16 h16;
typedef _Float16 h16x4 __attribute__((ext_vector_type(4)));
typedef _Float16 h16x8 __attribute__((ext_vector_type(8)));
typedef _Float16 h16x2 __attribute__((ext_vector_type(2)));
#define LAS __attribute__((address_space(3)))

constexpr int MT = 32768, TS = 16384, DM = 2048, DFF = 5632;
constexpr int LDS_BYTES = 144 * 1024;
constexpr size_t WS_HBUF = 0;
constexpr size_t WS_WBUF = 134217728;
constexpr size_t WS_WGU = WS_WBUF, WS_WD = WS_WBUF + 46137344;
constexpr size_t WS_WIN = WS_WBUF, WS_WOUT = WS_WBUF + 28311552;
constexpr size_t WS_ACT = WS_WBUF + 69206016;
constexpr size_t WS_Z = WS_WBUF + 36700160;
constexpr size_t WS_RWP = WS_Z + 285212672;
constexpr size_t WS_RWS = WS_RWP + 301989888;
constexpr size_t WS_ZG = WS_RWS + 6291456;
constexpr size_t WS_GDP = WS_ZG + 8388608;
constexpr size_t WS_GDS = WS_GDP + 150994944;
constexpr size_t WS_LRA = WS_GDS + 3145728;
constexpr size_t WS_LRU = WS_LRA + 33554432;
constexpr size_t WS_WGU2 = WS_LRU + 33554432;
constexpr size_t WS_WD2 = WS_WGU2 + 46137344;
constexpr size_t WS_HIN = WS_WD2 + 23068672;
constexpr size_t WS_BON = WS_HIN + 1048576;
constexpr size_t WS_BAR = WS_BON + 1572864;
constexpr size_t WS_W2T = WS_BAR + 16384;
constexpr size_t WS_A2T = WS_W2T + 98304;
constexpr size_t WS_G2T = WS_A2T + 98304;
constexpr size_t WS_WAT = WS_G2T + 196608;
constexpr size_t WS_WXT = WS_WAT + 65536;
constexpr size_t WS_END = WS_WXT + 65536;
static_assert(WS_END <= 1073741824ull, "workspace");
constexpr int Z1_LD = 2560, Z2_LD = 4352;
constexpr int Z2_GATE = 2304, Z2_XL = 3072, Z2_YL = 3584, Z2_ZB = 4096, Z2_ZA = 4102;

struct Params { const float* in[35]; float* out; unsigned char* ws; };

__device__ __forceinline__ int otid() { int t = threadIdx.x; asm volatile("" : "+v"(t)); return t; }
__device__ __forceinline__ int obid() { int t = blockIdx.x; asm volatile("" : "+s"(t)); return t; }
__device__ __forceinline__ int ogrid() { int t = gridDim.x; asm volatile("" : "+s"(t)); return t; }
__device__ __forceinline__ float bf2f(u16 h) { return __uint_as_float((unsigned)h << 16); }
__device__ __forceinline__ float bflo(unsigned w) { return __uint_as_float(w << 16); }
__device__ __forceinline__ float bfhi(unsigned w) { return __uint_as_float(w & 0xffff0000u); }
__device__ __forceinline__ u16 f2bf(float f) { unsigned u = __float_as_uint(f); u += 0x7FFFu + ((u >> 16) & 1u); return (u16)(u >> 16); }
__device__ __forceinline__ unsigned pk_bf(float lo, float hi) { return pg8::cvt_pk_bf16(lo, hi); }
template <int C> __device__ __forceinline__ float dppf(float v) { return __int_as_float(__builtin_amdgcn_update_dpp(0, __float_as_int(v), C, 0xF, 0xF, true)); }
template <int H> __device__ __forceinline__ float fmix(float a, unsigned hp, float c) { float d;
    if (H == 0) asm("v_fma_mix_f32 %0, %1, %2, %3 op_sel_hi:[0,1,0]" : "=v"(d) : "v"(a), "v"(hp), "v"(c));
    else        asm("v_fma_mix_f32 %0, %1, %2, %3 op_sel:[0,1,0] op_sel_hi:[0,1,0]" : "=v"(d) : "v"(a), "v"(hp), "v"(c));
    return d; }
template <int H> __device__ __forceinline__ float fmixn(float a, unsigned hp, float c) { float d;
    if (H == 0) asm("v_fma_mix_f32 %0, -%1, %2, %3 op_sel_hi:[0,1,0]" : "=v"(d) : "v"(a), "v"(hp), "v"(c));
    else        asm("v_fma_mix_f32 %0, -%1, %2, %3 op_sel:[0,1,0] op_sel_hi:[0,1,0]" : "=v"(d) : "v"(a), "v"(hp), "v"(c));
    return d; }
__device__ __forceinline__ float red16(float v) { v += dppf<0xB1>(v); v += dppf<0x4E>(v); v += dppf<0x141>(v); v += dppf<0x140>(v); return v; }
__device__ __forceinline__ float rlane(float v, int l) { return __int_as_float(__builtin_amdgcn_readlane(__float_as_int(v), l)); }
__device__ __forceinline__ float wave_sum(float v) { v = red16(v);
    v += __int_as_float(__builtin_amdgcn_update_dpp(0, __float_as_int(v), 0x142, 0xA, 0xF, false));
    v += __int_as_float(__builtin_amdgcn_update_dpp(0, __float_as_int(v), 0x143, 0xC, 0xF, false));
    return rlane(v, 63); }
__device__ __forceinline__ float sigm(float x) { return __builtin_amdgcn_rcpf(1.0f + __expf(-x)); }
__device__ __forceinline__ float softplus_(float x) { return fmaxf(x, 0.0f) + __logf(1.0f + __expf(-fabsf(x))); }
__device__ __forceinline__ float tanh_(float x) { const float e = __expf(-2.0f * fabsf(x)); const float t = (1.0f - e) * __builtin_amdgcn_rcpf(1.0f + e); return x < 0.f ? -t : t; }
__device__ __forceinline__ float gelu_tanh(float x) { return 0.5f * x * (1.0f + tanh_(0.7978845608028654f * (x + 0.044715f * x * x * x))); }

template <int MAP> __device__ __forceinline__ int rowmap(int n) {
    if (MAP == 0) return n;
    if (MAP == 1) return (n >> 7) * 256 + (n & 127);
    if (MAP == 2) return (n >> 7) * 256 + 128 + (n & 127);
    if (n < 2560 + 3072) return n;
    const int q = n - 2560;
    if (q < 3084) return 2560 + Z2_ZB + (q - 3072);
    return 2560 + Z2_XL + (q - 3084);
}
template <int MAP> __device__ __forceinline__ void conv_w(const float* __restrict__ src, u16* __restrict__ dst, int K, int N, LAS float* tile, int bsub = 0, int gsub = 0) {
    const int tid = otid(), NT = (N + 63) >> 6, KT = K >> 6; const int bidx = gsub ? bsub : obid(), gdim = gsub ? gsub : ogrid();
    for (int t = bidx; t < NT * KT; t += gdim) {
        const int nt = t % NT, kt = t / NT;
        const int c = tid & 63, r0 = tid >> 6, n = nt * 64 + c;
#pragma unroll
        for (int i = 0; i < 8; ++i) { const int r = r0 + 8 * i; tile[r * 65 + c] = (n < N) ? src[(size_t)(kt * 64 + r) * N + n] : 0.f; }
        __syncthreads();
        const int nl = tid >> 3, kq = tid & 7, n2 = nt * 64 + nl;
        if (n2 < N) {
            float v[8];
#pragma unroll
            for (int j = 0; j < 8; ++j) v[j] = tile[(kq * 8 + j) * 65 + nl];
            u32x4 w; w.x = pk_bf(v[0], v[1]); w.y = pk_bf(v[2], v[3]); w.z = pk_bf(v[4], v[5]); w.w = pk_bf(v[6], v[7]);
            *(u32x4*)(dst + (size_t)rowmap<MAP>(n2) * K + kt * 64 + kq * 8) = w;
        }
        __syncthreads();
    }
}

template <bool FINAL> __device__ __forceinline__ void norm_rows(const float* src, const float* __restrict__ gamma, u16* dst, float* copy) {
    const int tid_ = otid(); const int lane = tid_ & 63, wid = tid_ >> 6; const int bidx = obid(), gdim = ogrid();
    f32x4 g[8];
#pragma unroll
    for (int i = 0; i < 8; ++i) g[i] = *(const f32x4*)(gamma + i * 256 + lane * 4);
    for (int row = bidx * 8 + wid; row < MT; row += gdim * 8) {
        const float* p = src + (size_t)row * DM; f32x4 v[8]; float ss = 0.f;
#pragma unroll
        for (int i = 0; i < 8; ++i) { v[i] = *(const f32x4*)(p + i * 256 + lane * 4); ss += v[i][0] * v[i][0] + v[i][1] * v[i][1] + v[i][2] * v[i][2] + v[i][3] * v[i][3]; }
        ss = wave_sum(ss);
        const float rs = rsqrtf(ss * (1.0f / 2048.0f) + 1e-6f);
#pragma unroll
        for (int i = 0; i < 8; ++i) {
            const f32x4 o = v[i] * rs * g[i];
            if (FINAL) { *(f32x4*)(copy + (size_t)row * DM + i * 256 + lane * 4) = o; }
            else { u32x2 w; w.x = pk_bf(o[0], o[1]); w.y = pk_bf(o[2], o[3]); *(u32x2*)(dst + (size_t)row * DM + i * 256 + lane * 4) = w;
                   if (copy) *(f32x4*)(copy + (size_t)row * DM + i * 256 + lane * 4) = v[i]; }
        }
    }
}

struct RwP { const float *mu, *w0, *w2, *a0, *a2, *kk, *ka, *rk; };
__device__ __forceinline__ void prep_rw(const u16* __restrict__ Z1, const RwP P, h16* __restrict__ RWP, float* __restrict__ RWS, float* __restrict__ BON, u16* __restrict__ ZG, LAS float* L) {
    const int tid = otid(), lane = tid & 63; const int bidx = obid(), gdim = ogrid();
    constexpr int TT = 32, TH = 16;
    for (int tile = bidx; tile < MT / TT; tile += gdim) {
        const int m0 = tile * TT;
#pragma unroll
        for (int i = 0; i < 16; ++i) {
            const int idx = tid + 512 * i, tok = idx >> 8, cc = idx & 255, m = m0 + tok, c = 2304 + cc;
            const float zc = bf2f(Z1[(size_t)m * Z1_LD + c]);
            const float zp = ((m & (TS - 1)) == 0) ? 0.f : bf2f(Z1[(size_t)(m - 1) * Z1_LD + c]);
            const float zf = zc + P.mu[c] * (zp - zc);
            if (cc < 64) L[cc * TT + tok] = tanh_(zf);
            else if (cc < 128) L[cc * TT + tok] = zf;
            else ZG[(size_t)m * 128 + (cc - 128)] = f2bf(sigm(zf));
        }
        __syncthreads();
        const int jj = tid & 255, th = tid >> 8;
        for (int cgi = 0; cgi < 3; ++cgi) {
            const int j = jj + 256 * cgi;
            const int mA = m0 + th * TH;
            u16 lr[TH], lk[TH], lv[TH]; u16 l0r = 0, l0k = 0, l0v = 0;
            if ((mA & (TS - 1)) != 0) { const u16* zp = Z1 + (size_t)(mA - 1) * Z1_LD; l0r = zp[j]; l0k = zp[768 + j]; l0v = zp[1536 + j]; }
#pragma unroll
            for (int tk = 0; tk < TH; ++tk) { const u16* zc = Z1 + (size_t)(mA + tk) * Z1_LD; lr[tk] = zc[j]; lk[tk] = zc[768 + j]; lv[tk] = zc[1536 + j]; }
            float aw[TH], aa[TH];
            { const float w0v = P.w0[j], a0v = P.a0[j];
#pragma unroll
              for (int k = 0; k < TH; ++k) { aw[k] = w0v; aa[k] = a0v; } }
#pragma unroll 4
            for (int i = 0; i < 64; ++i) {
                const float w2v = P.w2[i * 768 + j], a2v = P.a2[i * 768 + j];
#pragma unroll
                for (int q = 0; q < 4; ++q) {
                    const f32x4 t = *(const LAS f32x4*)(L + i * TT + th * TH + 4 * q), y = *(const LAS f32x4*)(L + (64 + i) * TT + th * TH + 4 * q);
#pragma unroll
                    for (int k = 0; k < 4; ++k) { aw[4 * q + k] += t[k] * w2v; aa[4 * q + k] += y[k] * a2v; }
                }
            }
            const float mur = P.mu[j], muk = P.mu[768 + j], muv = P.mu[1536 + j];
            const float kkc = P.kk[j], kac = P.ka[j], rkc = P.rk[j];
            const int hh = j >> 6;
            float pr = bf2f(l0r), pk = bf2f(l0k), pv = bf2f(l0v);
            float w1 = 0.f, dl1 = 0.f, bb1 = 0.f, kp1 = 0.f, br1 = 0.f, kr1 = 0.f;
#pragma unroll
            for (int tk = 0; tk < TH; ++tk) {
                const int m = mA + tk, b = m >> 14, t = m & (TS - 1);
                const float cr = bf2f(lr[tk]), ck = bf2f(lk[tk]), cv = bf2f(lv[tk]);
                const float r = cr + mur * (pr - cr), k = ck + muk * (pk - ck), v = cv + muv * (pv - cv);
                pr = cr; pk = ck; pv = cv;
                const float e = 0.6065306597f * sigm(aw[tk]);
                const float dl = 1.0f - __expf(-e);
                const float w = 1.0f - dl;
                const float a = sigm(aa[tk]);
                const float kq = k * kkc;
                const float ss = wave_sum(kq * kq);
                const float kkn = kq * rsqrtf(ss + 1e-12f);
                const float kp = k * (1.0f + (a - 1.0f) * kac);
                const float bb = kkn * a;
                const float wr = w * r;
                const float br = wave_sum(bb * r), kr = wave_sum(kp * r), bonus = wave_sum(r * kp * rkc);
                const size_t rec = (size_t)(b * 12 + hh) * TS + t;
                h16* o = RWP + (rec >> 1) * 768 + lane;
                if (lane == 0) BON[rec] = bonus;
                if ((tk & 1) == 0) {
                    o[0] = (h16)kkn; o[64] = (h16)wr; o[9 * 64] = (h16)v;
                    w1 = w; dl1 = dl; bb1 = bb; kp1 = kp; br1 = br; kr1 = kr;
                } else {
                    o[2 * 64] = (h16)(w1 * kkn); o[3 * 64] = (h16)(w1 * wr); o[4 * 64] = (h16)(dl1 + dl - dl1 * dl);
                    o[5 * 64] = (h16)(bb1 * w); o[6 * 64] = (h16)(kp1 * w); o[7 * 64] = (h16)bb; o[8 * 64] = (h16)kp; o[10 * 64] = (h16)v;
                    const float bk12 = wave_sum(bb1 * kkn), kk12 = wave_sum(kp1 * kkn), bz = wave_sum(bb1 * wr), kz = wave_sum(kp1 * wr);
                    if (lane == 0) { f32x4 sA, sB; sA[0] = br1; sA[1] = kr1; sA[2] = bk12; sA[3] = kk12; sB[0] = br; sB[1] = kr; sB[2] = bz; sB[3] = kz;
                        *(f32x4*)(RWS + (rec >> 1) * 8) = sA; *(f32x4*)(RWS + (rec >> 1) * 8 + 4) = sB; }
                }
            }
        }
        __syncthreads();
    }
}

__device__ __forceinline__ void tr_small(const float* __restrict__ src, u16* __restrict__ dst, int K) {
    const int tid = otid(); const int bidx = obid(), gdim = ogrid();
    for (int idx = bidx * 512 + tid; idx < 768 * K; idx += gdim * 512) { const int col = idx / K, k = idx - col * K; dst[idx] = f2bf(src[k * 768 + col]); }
}
typedef short bf16x8_t __attribute__((ext_vector_type(8)));
__device__ __forceinline__ void prep_rw2(const u16* __restrict__ Z1, const RwP P, const u16* __restrict__ W2T, const u16* __restrict__ A2T,
                                         h16* __restrict__ RWP, float* __restrict__ RWS, float* __restrict__ BON, u16* __restrict__ ZG, LAS unsigned char* lds) {
    const int tid = otid(), lane = tid & 63, wid = tid >> 6, fr = lane & 15, fq = lane >> 4; const int bidx = obid(), gdim = ogrid();
    constexpr int TT = 32, LST = 272;
    for (int tile = bidx; tile < MT / TT; tile += gdim) {
        const int m0 = tile * TT;
#pragma unroll
        for (int i = 0; i < 16; ++i) {
            const int idx = tid + 512 * i, tok = idx >> 8, cc = idx & 255, m = m0 + tok, c = 2304 + cc;
            const float zc = bf2f(Z1[(size_t)m * Z1_LD + c]);
            const float zp = ((m & (TS - 1)) == 0) ? 0.f : bf2f(Z1[(size_t)(m - 1) * Z1_LD + c]);
            const float zf = zc + P.mu[c] * (zp - zc);
            if (cc < 128) *(LAS u16*)(lds + tok * LST + cc * 2) = f2bf(cc < 64 ? tanh_(zf) : zf);
            else ZG[(size_t)m * 128 + (cc - 128)] = f2bf(sigm(zf));
        }
        __syncthreads();
        for (int wt = wid; wt < 24; wt += 8) {
            const int hh = wt % 12, half = wt / 12;
            const int mB = m0 + half * 16, b = mB >> 14, tB = mB & (TS - 1);
            const int j0 = hh * 64 + 4 * fr;
            f32x4 accW[4], accA[4];
#pragma unroll
            for (int n = 0; n < 4; ++n) { accW[n] = (f32x4){0.f, 0.f, 0.f, 0.f}; accA[n] = (f32x4){0.f, 0.f, 0.f, 0.f}; }
#pragma unroll
            for (int ks = 0; ks < 2; ++ks) {
                const bf16x8_t aw_ = *(const LAS bf16x8_t*)(lds + (half * 16 + fr) * LST + (ks * 32 + fq * 8) * 2);
                const bf16x8_t aa_ = *(const LAS bf16x8_t*)(lds + (half * 16 + fr) * LST + (64 + ks * 32 + fq * 8) * 2);
#pragma unroll
                for (int n = 0; n < 4; ++n) {
                    const bf16x8_t bw = *(const bf16x8_t*)(W2T + (size_t)(j0 + n) * 64 + ks * 32 + fq * 8);
                    const bf16x8_t ba = *(const bf16x8_t*)(A2T + (size_t)(j0 + n) * 64 + ks * 32 + fq * 8);
                    accW[n] = __builtin_amdgcn_mfma_f32_16x16x32_bf16(aw_, bw, accW[n], 0, 0, 0);
                    accA[n] = __builtin_amdgcn_mfma_f32_16x16x32_bf16(aa_, ba, accA[n], 0, 0, 0);
                }
            }
            const f32x4 w0v = *(const f32x4*)(P.w0 + j0), a0v = *(const f32x4*)(P.a0 + j0), mur = *(const f32x4*)(P.mu + j0), muk = *(const f32x4*)(P.mu + 768 + j0), muv = *(const f32x4*)(P.mu + 1536 + j0);
            const f32x4 kkc = *(const f32x4*)(P.kk + j0), kac = *(const f32x4*)(P.ka + j0), rkc = *(const f32x4*)(P.rk + j0);
            u32x2 zr[5], zk[5], zv[5];
#pragma unroll
            for (int q = 0; q < 5; ++q) {
                const int m = mB + 4 * fq + q - 1;
                if (q == 0 && ((m + 1) & (TS - 1)) == 0) { zr[0] = (u32x2){0u, 0u}; zk[0] = zr[0]; zv[0] = zr[0]; }
                else { const u16* zc = Z1 + (size_t)m * Z1_LD + j0; zr[q] = *(const u32x2*)zc; zk[q] = *(const u32x2*)(zc + 768); zv[q] = *(const u32x2*)(zc + 1536); }
            }
            f32x4 w1, dl1, bb1, kp1; float br1 = 0.f, kr1 = 0.f;
#pragma unroll
            for (int r = 0; r < 4; ++r) {
                const int t = tB + 4 * fq + r;
                const size_t rec = (size_t)(b * 12 + hh) * TS + t;
                f32x4 pr, pk, pv, cr, ck, cv;
                pr[0] = bflo(zr[r].x); pr[1] = bfhi(zr[r].x); pr[2] = bflo(zr[r].y); pr[3] = bfhi(zr[r].y);
                pk[0] = bflo(zk[r].x); pk[1] = bfhi(zk[r].x); pk[2] = bflo(zk[r].y); pk[3] = bfhi(zk[r].y);
                pv[0] = bflo(zv[r].x); pv[1] = bfhi(zv[r].x); pv[2] = bflo(zv[r].y); pv[3] = bfhi(zv[r].y);
                cr[0] = bflo(zr[r + 1].x); cr[1] = bfhi(zr[r + 1].x); cr[2] = bflo(zr[r + 1].y); cr[3] = bfhi(zr[r + 1].y);
                ck[0] = bflo(zk[r + 1].x); ck[1] = bfhi(zk[r + 1].x); ck[2] = bflo(zk[r + 1].y); ck[3] = bfhi(zk[r + 1].y);
                cv[0] = bflo(zv[r + 1].x); cv[1] = bfhi(zv[r + 1].x); cv[2] = bflo(zv[r + 1].y); cv[3] = bfhi(zv[r + 1].y);
                const f32x4 rr = cr + mur * (pr - cr), k = ck + muk * (pk - ck), v = cv + muv * (pv - cv);
                f32x4 w, dl, a, kq, kp;
                float ss = 0.f;
#pragma unroll
                for (int n = 0; n < 4; ++n) {
                    const float e = 0.6065306597f * sigm(accW[n][r] + w0v[n]);
                    w[n] = __expf(-e); dl[n] = 1.0f - w[n];
                    a[n] = sigm(accA[n][r] + a0v[n]);
                    kq[n] = k[n] * kkc[n]; ss += kq[n] * kq[n];
                    kp[n] = k[n] * (1.0f + (a[n] - 1.0f) * kac[n]);
                }
                ss = red16(ss);
                const float rn = rsqrtf(ss + 1e-12f);
                const f32x4 kkn = kq * rn, bb = kkn * a, wr = w * rr;
                float br = 0.f, kr = 0.f, bonus = 0.f;
#pragma unroll
                for (int n = 0; n < 4; ++n) { br += bb[n] * rr[n]; kr += kp[n] * rr[n]; bonus += rr[n] * kp[n] * rkc[n]; }
                br = red16(br); kr = red16(kr); bonus = red16(bonus);
                h16* o = RWP + (rec >> 1) * 768 + 4 * fr;
                if (fr == 0) BON[rec] = bonus;
#define ST4(slot, vec) do { h16x4 hv_; hv_[0] = (h16)(vec)[0]; hv_[1] = (h16)(vec)[1]; hv_[2] = (h16)(vec)[2]; hv_[3] = (h16)(vec)[3]; *(h16x4*)(o + (slot) * 64) = hv_; } while (0)
                if ((r & 1) == 0) {
                    ST4(0, kkn); ST4(1, wr); ST4(9, v);
                    w1 = w; dl1 = dl; bb1 = bb; kp1 = kp; br1 = br; kr1 = kr;
                } else {
                    const f32x4 x2 = w1 * kkn, z2 = w1 * wr, d12 = dl1 + dl - dl1 * dl, B1 = bb1 * w, K1 = kp1 * w;
                    ST4(2, x2); ST4(3, z2); ST4(4, d12); ST4(5, B1); ST4(6, K1); ST4(7, bb); ST4(8, kp); ST4(10, v);
                    float bk12 = 0.f, kk12 = 0.f, bz = 0.f, kz = 0.f;
#pragma unroll
                    for (int n = 0; n < 4; ++n) { bk12 += bb1[n] * kkn[n]; kk12 += kp1[n] * kkn[n]; bz += bb1[n] * wr[n]; kz += kp1[n] * wr[n]; }
                    bk12 = red16(bk12); kk12 = red16(kk12); bz = red16(bz); kz = red16(kz);
                    if (fr == 0) { f32x4 sA, sB; sA[0] = br1; sA[1] = kr1; sA[2] = bk12; sA[3] = kk12; sB[0] = br; sB[1] = kr; sB[2] = bz; sB[3] = kz;
                        *(f32x4*)(RWS + (rec >> 1) * 8) = sA; *(f32x4*)(RWS + (rec >> 1) * 8 + 4) = sB; }
                }
#undef ST4
            }
        }
        __syncthreads();
    }
}

__device__ __forceinline__ void prep_gd(const u16* __restrict__ Z2, const float* __restrict__ cw, const float* __restrict__ alog, const float* __restrict__ dtb,
                                        h16* __restrict__ GDP, float* __restrict__ GDS) {
    const int tid_ = otid(); const int lane = tid_ & 63, wid = tid_ >> 6; const int bidx = obid(), gdim = ogrid();
    for (int task = bidx * 8 + wid; task < 6 * (MT / 32); task += gdim * 8) {
        const int hh = task % 6, chunk = task / 6, m0 = chunk * 32, b = m0 >> 14, t0 = m0 & (TS - 1);
        const int cq = hh * 128 + 2 * lane;
        float w[3][4][2];
#pragma unroll
        for (int a = 0; a < 3; ++a)
#pragma unroll
            for (int i = 0; i < 4; ++i) { const f32x2 q = *(const f32x2*)(cw + i * 2304 + a * 768 + cq); w[a][i][0] = q[0]; w[a][i][1] = q[1]; }
        float x[3][3][2];
#pragma unroll
        for (int a = 0; a < 3; ++a)
#pragma unroll
            for (int d = 0; d < 3; ++d) {
                unsigned wv = 0u;
                if (t0 != 0) wv = *(const unsigned*)(Z2 + (size_t)(m0 - 3 + d) * Z2_LD + a * 768 + cq);
                x[a][d][0] = bflo(wv); x[a][d][1] = bfhi(wv);
            }
        const float An = -__expf(alog[hh]), dtbv = dtb[hh];
        float kprev0 = 0.f, kprev1 = 0.f, al1 = 0.f, be1 = 0.f, qk1 = 0.f;
        for (int s8 = 0; s8 < 32; s8 += 8) {
          unsigned ld[8][3]; u16 ldb[8], lda[8];
#pragma unroll
          for (int k = 0; k < 8; ++k) { const u16* zr = Z2 + (size_t)(m0 + s8 + k) * Z2_LD;
#pragma unroll
              for (int a = 0; a < 3; ++a) ld[k][a] = *(const unsigned*)(zr + a * 768 + cq);
              ldb[k] = zr[Z2_ZB + hh]; lda[k] = zr[Z2_ZA + hh]; }
#pragma unroll
          for (int k = 0; k < 8; ++k) {
            const int s = s8 + k;
            float y[3][2];
#pragma unroll
            for (int a = 0; a < 3; ++a) {
                const unsigned wv = ld[k][a];
                const float c0 = bflo(wv), c1 = bfhi(wv);
                const float s0 = x[a][0][0] * w[a][0][0] + x[a][1][0] * w[a][1][0] + x[a][2][0] * w[a][2][0] + c0 * w[a][3][0];
                const float s1 = x[a][0][1] * w[a][0][1] + x[a][1][1] * w[a][1][1] + x[a][2][1] * w[a][2][1] + c1 * w[a][3][1];
                x[a][0][0] = x[a][1][0]; x[a][1][0] = x[a][2][0]; x[a][2][0] = c0;
                x[a][0][1] = x[a][1][1]; x[a][1][1] = x[a][2][1]; x[a][2][1] = c1;
                y[a][0] = s0 * sigm(s0); y[a][1] = s1 * sigm(s1);
            }
            const float sq = wave_sum(y[0][0] * y[0][0] + y[0][1] * y[0][1]);
            const float sk = wave_sum(y[1][0] * y[1][0] + y[1][1] * y[1][1]);
            const float rq = rsqrtf(sq + 1e-12f) * 0.08838834764831845f, rk = rsqrtf(sk + 1e-12f);
            const float q0 = y[0][0] * rq, q1 = y[0][1] * rq, k0 = y[1][0] * rk, k1 = y[1][1] * rk;
            const float qk = wave_sum(q0 * k0 + q1 * k1);
            const size_t rec = (size_t)(b * 6 + hh) * TS + (t0 + s);
            h16* o = GDP + rec * 384 + 2 * lane;
            h16x2 kv; kv[0] = (h16)k0; kv[1] = (h16)k1; *(h16x2*)(o) = kv;
            h16x2 qv; qv[0] = (h16)q0; qv[1] = (h16)q1; *(h16x2*)(o + 128) = qv;
            h16x2 vv; vv[0] = (h16)y[2][0]; vv[1] = (h16)y[2][1]; *(h16x2*)(o + 256) = vv;
            const float beta = sigm(bf2f(ldb[k]));
            const float alpha = __expf(An * softplus_(bf2f(lda[k]) + dtbv));
            if ((k & 1) == 0) { kprev0 = k0; kprev1 = k1; al1 = alpha; be1 = beta; qk1 = qk; }
            else {
                const float k12 = wave_sum(kprev0 * k0 + kprev1 * k1), kq12 = wave_sum(kprev0 * q0 + kprev1 * q1);
                if (lane == 0) { f32x4 sA, sB; sA[0] = al1; sA[1] = be1; sA[2] = qk1; sA[3] = k12; sB[0] = alpha; sB[1] = beta; sB[2] = qk; sB[3] = kq12;
                    *(f32x4*)(GDS + (rec - 1) * 4) = sA; *(f32x4*)(GDS + rec * 4) = sB; }
            }
          }
        }
    }
}

struct LrP { const float *cw, *cb, *wa, *ba, *wx, *bx, *lam; };
__device__ __forceinline__ void tr_blocks(const float* __restrict__ src, u16* __restrict__ dst) {
    const int tid = otid(); const int bidx = obid(), gdim = ogrid();
    for (int idx = bidx * 512 + tid; idx < 8 * 64 * 64; idx += gdim * 512) { const int n = idx >> 12, d = (idx >> 6) & 63, c = idx & 63; dst[idx] = f2bf(src[(n * 64 + c) * 64 + d]); }
}
__device__ __forceinline__ void prep_lr2(const u16* __restrict__ Z2, const LrP P, const u16* __restrict__ WAT, const u16* __restrict__ WXT, u16* __restrict__ LRA, u16* __restrict__ LRUb, LAS unsigned char* lds) {
    const int tid_ = otid(); const int lane = tid_ & 63, wid = tid_ >> 6, fr = lane & 15, fq = lane >> 4; const int bidx = obid(), gdim = ogrid();
    LAS unsigned char* Lx = lds + wid * 10240;
    LAS float* La = (LAS float*)(Lx + 2048);
    LAS float* Lb = La + 1024;
    for (int task = bidx * 8 + wid; task < 8 * (MT / 64); task += gdim * 8) {
        const int n = task & 7, chunk = task >> 3, m0 = chunk * 64, t0 = m0 & (TS - 1);
        const int ch = n * 64 + lane;
        bf16x8_t bwa[4][2], bwx[4][2];
#pragma unroll
        for (int nt = 0; nt < 4; ++nt)
#pragma unroll
            for (int ks = 0; ks < 2; ++ks) { const size_t o = (size_t)(n * 64 + nt * 16 + fr) * 64 + ks * 32 + fq * 8; bwa[nt][ks] = *(const bf16x8_t*)(WAT + o); bwx[nt][ks] = *(const bf16x8_t*)(WXT + o); }
        const float c0 = P.cw[ch], c1 = P.cw[512 + ch], c2 = P.cw[1024 + ch], c3 = P.cw[1536 + ch], cb = P.cb[ch];
        const float ba = P.ba[ch], bx = P.bx[ch];
        const float spl = -8.0f * softplus_(-P.lam[ch]);
        float x0 = 0.f, x1 = 0.f, x2 = 0.f, hl = 0.f, pc = 1.f;
        if (t0 != 0) { x0 = bf2f(Z2[(size_t)(m0 - 3) * Z2_LD + Z2_XL + ch]); x1 = bf2f(Z2[(size_t)(m0 - 2) * Z2_LD + Z2_XL + ch]); x2 = bf2f(Z2[(size_t)(m0 - 1) * Z2_LD + Z2_XL + ch]); }
        for (int s16 = 0; s16 < 64; s16 += 16) {
            u16 ldx[16];
#pragma unroll
            for (int k = 0; k < 16; ++k) ldx[k] = Z2[(size_t)(m0 + s16 + k) * Z2_LD + Z2_XL + ch];
            float xc[16];
#pragma unroll
            for (int k = 0; k < 16; ++k) {
                const float xin = bf2f(ldx[k]);
                xc[k] = x0 * c0 + x1 * c1 + x2 * c2 + xin * c3 + cb;
                x0 = x1; x1 = x2; x2 = xin;
                *(LAS u16*)(Lx + (k * 64 + lane) * 2) = f2bf(xc[k]);
            }
            f32x4 aA[4], aX[4];
#pragma unroll
            for (int nt = 0; nt < 4; ++nt) { aA[nt] = (f32x4){0.f, 0.f, 0.f, 0.f}; aX[nt] = (f32x4){0.f, 0.f, 0.f, 0.f}; }
#pragma unroll
            for (int ks = 0; ks < 2; ++ks) {
                const bf16x8_t af = *(const LAS bf16x8_t*)(Lx + (fr * 64 + ks * 32 + fq * 8) * 2);
#pragma unroll
                for (int nt = 0; nt < 4; ++nt) { aA[nt] = __builtin_amdgcn_mfma_f32_16x16x32_bf16(af, bwa[nt][ks], aA[nt], 0, 0, 0); aX[nt] = __builtin_amdgcn_mfma_f32_16x16x32_bf16(af, bwx[nt][ks], aX[nt], 0, 0, 0); }
            }
#pragma unroll
            for (int nt = 0; nt < 4; ++nt)
#pragma unroll
                for (int r = 0; r < 4; ++r) { La[(4 * fq + r) * 64 + nt * 16 + fr] = aA[nt][r]; Lb[(4 * fq + r) * 64 + nt * 16 + fr] = aX[nt][r]; }
#pragma unroll
            for (int k = 0; k < 16; ++k) {
                const int m = m0 + s16 + k;
                const float r = sigm(La[k * 64 + lane] + ba), ig = sigm(Lb[k * 64 + lane] + bx);
                const float la = spl * r;
                const float a = __expf(la);
                const float u = __builtin_amdgcn_sqrtf(1.0f - __expf(2.0f * la)) * (ig * xc[k]);
                hl = a * hl + u; pc *= a;
                LRA[(size_t)m * 512 + ch] = f2bf(pc); LRUb[(size_t)m * 512 + ch] = f2bf(hl);
            }
        }
    }
}

constexpr int RC = 32;
constexpr int RPB = 3072;
constexpr int RBUF = (RC / 2) * RPB + (RC / 2) * 32;
__device__ __forceinline__ f32x2 lo2(f32x4 v) { f32x2 r; r[0] = v[0]; r[1] = v[1]; return r; }
__device__ __forceinline__ f32x2 hi2(f32x4 v) { f32x2 r; r[0] = v[2]; r[1] = v[3]; return r; }
__device__ __forceinline__ float dot4(f32x2 sa, f32x2 sb, f32x4 v) { f32x2 t = sa * lo2(v); t = sb * hi2(v) + t; return t[0] + t[1]; }
__device__ __forceinline__ float dot8(const f32x2 (&S)[4], f32x4 va, f32x4 vb) { f32x2 t = S[0] * lo2(va); t = S[1] * hi2(va) + t; t = S[2] * lo2(vb) + t; t = S[3] * hi2(vb) + t; return t[0] + t[1]; }
template <int KIND> __device__ __forceinline__ void rec_block(const unsigned char* __restrict__ gp, const unsigned char* __restrict__ gs, u16* __restrict__ outp  ,
                                                             int rowl0  , LAS unsigned char* lds) {
    const int tid = otid(), lane = tid & 63, wid = tid >> 6, g = lane >> 4, j = lane & 15;
    const int cw = wid & 3; const bool is_ld = wid >= 4;
    const int rowl = rowl0 + cw * 4 + g;
    const int lt = cw * 64 + lane;
    constexpr int NCH = TS / RC;
    constexpr int CB = (RC / 2) * 1536;
    u32x4 st[6]; u32x4 ss0, ss1;
#define LD_ISSUE(c) do { const unsigned char* np = gp + (size_t)(c) * CB; const unsigned char* ns = gs + (size_t)(c) * (RC * 16); \
        _Pragma("unroll") for (int i = 0; i < 6; ++i) st[i] = *(const u32x4*)(np + (size_t)(lt + 256 * i) * 16); \
        if (lt < 32) ss0 = *(const u32x4*)(ns + lt * 16); } while (0)
#define LD_COMMIT(buf) do { LAS unsigned char* Bn = lds + 4096 + (buf) * RBUF; \
        _Pragma("unroll") for (int i = 0; i < 6; ++i) { const int q = lt + 256 * i, slot = (q % 96) >> 3; \
            const u32x4 w = st[i]; f32x4 a, b; \
            { const unsigned w0 = w[0], w1 = w[1], w2 = w[2], w3 = w[3]; const h16x2 h0 = __builtin_bit_cast(h16x2, w0), h1 = __builtin_bit_cast(h16x2, w1), h2 = __builtin_bit_cast(h16x2, w2), h3 = __builtin_bit_cast(h16x2, w3); \
              a[0] = (float)h0[0]; a[1] = (float)h0[1]; a[2] = (float)h1[0]; a[3] = (float)h1[1]; b[0] = (float)h2[0]; b[1] = (float)h2[1]; b[2] = (float)h3[0]; b[3] = (float)h3[1]; } \
            if (KIND == 0 && slot == 4) { a = 1.0f - a; b = 1.0f - b; } \
            *(LAS f32x4*)(Bn + q * 32) = a; *(LAS f32x4*)(Bn + q * 32 + 16) = b; } \
        if (lt < 32) *(LAS u32x4*)(Bn + (RC / 2) * RPB + lt * 16) = ss0; } while (0)
#define Y_OUT(c) do { const LAS float* yb = (const LAS float*)(lds + ((c) & 1) * 2048); const int stp = lt >> 3, rp = (lt & 7) * 2; \
        const f32x2 yv = *(const LAS f32x2*)(yb + stp * 16 + rp); *(unsigned*)(outp + ((size_t)(c) * RC + stp) * DM + rp) = pk_bf(yv[0], yv[1]); } while (0)
    if (is_ld) { LD_ISSUE(0); LD_COMMIT(0); LD_ISSUE(1); }
    __syncthreads();
    f32x2 Sv[4];
#pragma unroll
    for (int i = 0; i < 4; ++i) { Sv[i][0] = 0.f; Sv[i][1] = 0.f; }
    for (int c = 0; c < NCH; ++c) {
        if (is_ld) {
            if (c + 1 < NCH) { LD_COMMIT((c + 1) & 1); if (c + 2 < NCH) LD_ISSUE(c + 2); }
            if (c > 0) Y_OUT(c - 1);
        } else {
            const LAS unsigned char* B = lds + 4096 + (c & 1) * RBUF;
            const LAS unsigned char* Sc = B + (RC / 2) * RPB;
            LAS float* yw = (LAS float*)(lds + (c & 1) * 2048) + (cw * 4 + g);
            if (KIND == 0) {
                f32x4 n_kk, n_wr, n_x2, n_z2, n_W, n_B1, n_K1, n_b2, n_kp2, n_sA, n_sB; float n_v1, n_v2;
#define RW_LD(p) do { const LAS unsigned char* Pp = B + (p) * RPB + j * 16; \
                    n_kk = *(const LAS f32x4*)(Pp); n_wr = *(const LAS f32x4*)(Pp + 256); n_x2 = *(const LAS f32x4*)(Pp + 512); n_z2 = *(const LAS f32x4*)(Pp + 768); \
                    n_W = *(const LAS f32x4*)(Pp + 1024); n_B1 = *(const LAS f32x4*)(Pp + 1280); n_K1 = *(const LAS f32x4*)(Pp + 1536); n_b2 = *(const LAS f32x4*)(Pp + 1792); n_kp2 = *(const LAS f32x4*)(Pp + 2048); \
                    n_v1 = *(const LAS float*)(B + (p) * RPB + 2304 + rowl * 4); n_v2 = *(const LAS float*)(B + (p) * RPB + 2560 + rowl * 4); \
                    n_sA = *(const LAS f32x4*)(Sc + (p) * 32); n_sB = *(const LAS f32x4*)(Sc + (p) * 32 + 16); } while (0)
                RW_LD(0);
#pragma unroll 16
                for (int p = 0; p < RC / 2; ++p) {
                    const f32x4 kk = n_kk, wr = n_wr, x2 = n_x2, z2 = n_z2, W = n_W, B1 = n_B1, K1 = n_K1, b2 = n_b2, kp2 = n_kp2, sA = n_sA, sB = n_sB; const float v1 = n_v1, v2 = n_v2;
                    { const int pn = (p + 1 < RC / 2) ? p + 1 : p; RW_LD(pn); }
                    float d0 = dot4(Sv[0], Sv[1], kk), d1 = dot4(Sv[0], Sv[1], wr), d2 = dot4(Sv[0], Sv[1], x2), d3 = dot4(Sv[0], Sv[1], z2);
                    d0 = red16(d0); d1 = red16(d1); d2 = red16(d2); d3 = red16(d3);
                    const float sa1 = d0;
                    const float y1 = d1 - sa1 * sA[0] + v1 * sA[1];
                    const float sa2 = d2 - sa1 * sA[2] + v1 * sA[3];
                    const float y2 = (d3 - sa1 * sB[2] + v1 * sB[3]) - sa2 * sB[0] + v2 * sB[1];
                    yw[(2 * p) * 16] = y1; yw[(2 * p + 1) * 16] = y2;
                    const float n1 = -sa1, n2 = -sa2;
                    Sv[0] = lo2(b2) * n2 + (lo2(kp2) * v2 + (lo2(B1) * n1 + (lo2(K1) * v1 + Sv[0] * lo2(W))));
                    Sv[1] = hi2(b2) * n2 + (hi2(kp2) * v2 + (hi2(B1) * n1 + (hi2(K1) * v1 + Sv[1] * hi2(W))));
                }
            } else {
                f32x4 n_k1a, n_k1b, n_q1a, n_q1b, n_k2a, n_k2b, n_q2a, n_q2b, n_sA, n_sB; float n_v1, n_v2;
#define GD_LD(p) do { const LAS unsigned char* Pp = B + (p) * RPB + j * 32; \
                    n_k1a = *(const LAS f32x4*)(Pp); n_k1b = *(const LAS f32x4*)(Pp + 16); n_q1a = *(const LAS f32x4*)(Pp + 512); n_q1b = *(const LAS f32x4*)(Pp + 528); \
                    n_k2a = *(const LAS f32x4*)(Pp + 1536); n_k2b = *(const LAS f32x4*)(Pp + 1552); n_q2a = *(const LAS f32x4*)(Pp + 2048); n_q2b = *(const LAS f32x4*)(Pp + 2064); \
                    n_v1 = *(const LAS float*)(B + (p) * RPB + 1024 + rowl * 4); n_v2 = *(const LAS float*)(B + (p) * RPB + 2560 + rowl * 4); \
                    n_sA = *(const LAS f32x4*)(Sc + (p) * 32); n_sB = *(const LAS f32x4*)(Sc + (p) * 32 + 16); } while (0)
                GD_LD(0);
#pragma unroll 16
                for (int p = 0; p < RC / 2; ++p) {
                    const f32x4 k1a = n_k1a, k1b = n_k1b, q1a = n_q1a, q1b = n_q1b, k2a = n_k2a, k2b = n_k2b, q2a = n_q2a, q2b = n_q2b, sA = n_sA, sB = n_sB; const float v1 = n_v1, v2 = n_v2;
                    { const int pn = (p + 1 < RC / 2) ? p + 1 : p; GD_LD(pn); }
                    float a1 = dot8(Sv, k1a, k1b), c1 = dot8(Sv, q1a, q1b), a2 = dot8(Sv, k2a, k2b), c2 = dot8(Sv, q2a, q2b);
                    a1 = red16(a1); c1 = red16(c1); a2 = red16(a2); c2 = red16(c2);
                    const float al1 = sA[0], al2 = sB[0];
                    const float vn1 = sA[1] * (v1 - al1 * a1);
                    const float o1 = al1 * c1 + sA[2] * vn1;
                    const float vn2 = sB[1] * (v2 - al2 * (al1 * a2 + sA[3] * vn1));
                    const float o2 = al2 * (al1 * c2 + sB[3] * vn1) + sB[2] * vn2;
                    yw[(2 * p) * 16] = o1; yw[(2 * p + 1) * 16] = o2;
                    const float cS = al1 * al2, w1 = al2 * vn1;
                    Sv[0] = lo2(k2a) * vn2 + (lo2(k1a) * w1 + Sv[0] * cS);
                    Sv[1] = hi2(k2a) * vn2 + (hi2(k1a) * w1 + Sv[1] * cS);
                    Sv[2] = lo2(k2b) * vn2 + (lo2(k1b) * w1 + Sv[2] * cS);
                    Sv[3] = hi2(k2b) * vn2 + (hi2(k1b) * w1 + Sv[3] * cS);
                }
            }
        }
        __syncthreads();
    }
    if (is_ld) Y_OUT(NCH - 1);
#undef LD_ISSUE
#undef LD_COMMIT
#undef Y_OUT
}
__device__ __forceinline__ void lru_carry(int grp  , const u16* __restrict__ LRA, const u16* __restrict__ LRUb, float* __restrict__ HIN) {
    const int lane = otid() & 63;
    const int b = grp >> 3, ch = (grp & 7) * 64 + lane;
    float h = 0.f;
    for (int c = 0; c < TS / 64; c += 8) {
        float a[8], u[8];
#pragma unroll
        for (int k = 0; k < 8; ++k) { const size_t m = (size_t)b * TS + (c + k) * 64 + 63; a[k] = bf2f(LRA[m * 512 + ch]); u[k] = bf2f(LRUb[m * 512 + ch]); }
#pragma unroll
        for (int k = 0; k < 8; ++k) { HIN[((size_t)b * 256 + c + k) * 512 + ch] = h; h = a[k] * h + u[k]; }
    }
}
__device__ __forceinline__ void post_lr(u16* __restrict__ MIX, const u16* __restrict__ Z2, const u16* __restrict__ LRA, const u16* __restrict__ LRUb, const float* __restrict__ HIN) {
    const int tid = otid(); const int bidx = obid(), gdim = ogrid();
    for (int it = bidx * 512 + tid; it < MT * 128; it += gdim * 512) {
        const int m = it >> 7, c4 = (it & 127) * 4, b = m >> 14, chunk = (m & (TS - 1)) >> 6;
        const u32x2 pw = *(const u32x2*)(LRA + (size_t)m * 512 + c4), hw = *(const u32x2*)(LRUb + (size_t)m * 512 + c4); const f32x4 hin = *(const f32x4*)(HIN + ((size_t)b * 256 + chunk) * 512 + c4);
        f32x4 pc, hl; pc[0] = bflo(pw.x); pc[1] = bfhi(pw.x); pc[2] = bflo(pw.y); pc[3] = bfhi(pw.y); hl[0] = bflo(hw.x); hl[1] = bfhi(hw.x); hl[2] = bflo(hw.y); hl[3] = bfhi(hw.y);
        const u32x2 yw = *(const u32x2*)(Z2 + (size_t)m * Z2_LD + Z2_YL + c4);
        const f32x4 h = hl + pc * hin;
        u32x2 o; o.x = pk_bf(h[0] * gelu_tanh(bflo(yw.x)), h[1] * gelu_tanh(bfhi(yw.x))); o.y = pk_bf(h[2] * gelu_tanh(bflo(yw.y)), h[3] * gelu_tanh(bfhi(yw.y)));
        *(u32x2*)(MIX + (size_t)m * DM + 1536 + c4) = o;
    }
}

__device__ __forceinline__ void post_rw(u16* __restrict__ MIX, const h16* __restrict__ RWP, const float* __restrict__ BON, const u16* __restrict__ ZG,
                                        const float* __restrict__ g2, const float* __restrict__ lng, const float* __restrict__ lnb) {
    const int tid_ = otid(); const int lane = tid_ & 63, wid = tid_ >> 6; const int bidx = obid(), gdim = ogrid();
    for (int task = bidx * 8 + wid; task < 12 * (MT / 64); task += gdim * 8) {
        const int hh = task % 12, chunk = task / 12, m0 = chunk * 64, b = m0 >> 14, t0 = m0 & (TS - 1);
        const int col = hh * 64 + lane;
        float gc[128];
#pragma unroll
        for (int i = 0; i < 128; ++i) gc[i] = g2[i * 768 + col];
        const float lg = lng[col], lb = lnb[col];
        for (int s4 = 0; s4 < 64; s4 += 4) {
          u16 ly[4]; h16 lv[4]; float lbon[4]; unsigned lsw[4];
#pragma unroll
          for (int k = 0; k < 4; ++k) { const int m = m0 + s4 + k; const size_t rec = (size_t)(b * 12 + hh) * TS + (t0 + s4 + k);
              ly[k] = MIX[(size_t)m * DM + col]; lv[k] = RWP[(rec >> 1) * 768 + (9 + (int)(rec & 1)) * 64 + lane]; lbon[k] = BON[rec]; lsw[k] = *(const unsigned*)(ZG + (size_t)m * 128 + 2 * lane); }
#pragma unroll
          for (int k = 0; k < 4; ++k) {
            const int m = m0 + s4 + k;
            const float y = bf2f(ly[k]);
            const float mean = wave_sum(y) * (1.0f / 64.0f);
            const float d = y - mean;
            const float var = wave_sum(d * d) * (1.0f / 64.0f);
            const float yn = d * rsqrtf(var + 64e-5f) * lg + lb;
            const float v = (float)lv[k];
            const float bonus = lbon[k];
            const unsigned sw = lsw[k];
            const float s0 = bflo(sw), s1 = bfhi(sw);
            float ga = 0.f, gb = 0.f;
#pragma unroll
            for (int i = 0; i < 64; ++i) { ga += rlane(s0, i) * gc[2 * i]; gb += rlane(s1, i) * gc[2 * i + 1]; }
            MIX[(size_t)m * DM + col] = f2bf((yn + bonus * v) * (ga + gb));
          }
        }
    }
}
__device__ __forceinline__ void post_rw2(u16* __restrict__ MIX, const h16* __restrict__ RWP, const float* __restrict__ BON, const u16* __restrict__ ZG,
                                         const u16* __restrict__ G2T, const float* __restrict__ lng, const float* __restrict__ lnb) {
    const int tid_ = otid(); const int lane = tid_ & 63, wid = tid_ >> 6, fr = lane & 15, fq = lane >> 4; const int bidx = obid(), gdim = ogrid();
    for (int task = bidx * 8 + wid; task < 12 * (MT / 16); task += gdim * 8) {
        const int hh = task % 12, chunk = task / 12, mB = chunk * 16, b = mB >> 14, tB = mB & (TS - 1);
        const int j0 = hh * 64 + 4 * fr;
        u32x2 yw[4]; h16x4 vv[4]; float bon[4];
#pragma unroll
        for (int r = 0; r < 4; ++r) { const int m = mB + 4 * fq + r; const size_t rec = (size_t)(b * 12 + hh) * TS + (tB + 4 * fq + r);
            yw[r] = *(const u32x2*)(MIX + (size_t)m * DM + j0); vv[r] = *(const h16x4*)(RWP + (rec >> 1) * 768 + (9 + (int)(rec & 1)) * 64 + 4 * fr); bon[r] = BON[rec]; }
        const f32x4 lg = *(const f32x4*)(lng + j0), lb = *(const f32x4*)(lnb + j0);
        f32x4 acc[4];
#pragma unroll
        for (int n = 0; n < 4; ++n) acc[n] = (f32x4){0.f, 0.f, 0.f, 0.f};
#pragma unroll
        for (int ks = 0; ks < 4; ++ks) {
            const bf16x8_t a_ = *(const bf16x8_t*)(ZG + (size_t)(mB + fr) * 128 + ks * 32 + fq * 8);
#pragma unroll
            for (int n = 0; n < 4; ++n) { const bf16x8_t b_ = *(const bf16x8_t*)(G2T + (size_t)(j0 + n) * 128 + ks * 32 + fq * 8);
                acc[n] = __builtin_amdgcn_mfma_f32_16x16x32_bf16(a_, b_, acc[n], 0, 0, 0); }
        }
#pragma unroll
        for (int r = 0; r < 4; ++r) {
            const int m = mB + 4 * fq + r;
            f32x4 y; y[0] = bflo(yw[r].x); y[1] = bfhi(yw[r].x); y[2] = bflo(yw[r].y); y[3] = bfhi(yw[r].y);
            const float mean = red16((y[0] + y[1]) + (y[2] + y[3])) * (1.0f / 64.0f);
            const f32x4 d = y - mean;
            const float var = red16((d[0] * d[0] + d[1] * d[1]) + (d[2] * d[2] + d[3] * d[3])) * (1.0f / 64.0f);
            const float rs = rsqrtf(var + 64e-5f);
            f32x4 o;
#pragma unroll
            for (int n = 0; n < 4; ++n) o[n] = (d[n] * rs * lg[n] + lb[n] + bon[r] * (float)vv[r][n]) * acc[n][r];
            u32x2 w; w.x = pk_bf(o[0], o[1]); w.y = pk_bf(o[2], o[3]);
            *(u32x2*)(MIX + (size_t)m * DM + j0) = w;
        }
    }
}
__device__ __forceinline__ void post_rw_head(u16* __restrict__ MIX, const h16* __restrict__ RWP, const float* __restrict__ BON, const u16* __restrict__ ZG,
                                             const u16* __restrict__ G2T, const float* __restrict__ lng, const float* __restrict__ lnb, int b, int hh, int chunk0, int nchunk) {
    const int tid_ = otid(); const int lane = tid_ & 63, wid = tid_ >> 6, fr = lane & 15, fq = lane >> 4;
    const int j0 = hh * 64 + 4 * fr;
    bf16x8_t bg[4][4];
#pragma unroll
    for (int ks = 0; ks < 4; ++ks)
#pragma unroll
        for (int n = 0; n < 4; ++n) bg[ks][n] = *(const bf16x8_t*)(G2T + (size_t)(j0 + n) * 128 + ks * 32 + fq * 8);
    const f32x4 lg = *(const f32x4*)(lng + j0), lb = *(const f32x4*)(lnb + j0);
    for (int ci = wid; ci < nchunk; ci += 8) {
        const int tB = (chunk0 + ci) * 16, mB = b * TS + tB;
        u32x2 yw[4]; h16x4 vv[4]; float bon[4];
#pragma unroll
        for (int r = 0; r < 4; ++r) { const int m = mB + 4 * fq + r; const size_t rec = (size_t)(b * 12 + hh) * TS + (tB + 4 * fq + r);
            yw[r] = *(const u32x2*)(MIX + (size_t)m * DM + j0); vv[r] = *(const h16x4*)(RWP + (rec >> 1) * 768 + (9 + (int)(rec & 1)) * 64 + 4 * fr); bon[r] = BON[rec]; }
        f32x4 acc[4];
#pragma unroll
        for (int n = 0; n < 4; ++n) acc[n] = (f32x4){0.f, 0.f, 0.f, 0.f};
#pragma unroll
        for (int ks = 0; ks < 4; ++ks) {
            const bf16x8_t a_ = *(const bf16x8_t*)(ZG + (size_t)(mB + fr) * 128 + ks * 32 + fq * 8);
#pragma unroll
            for (int n = 0; n < 4; ++n) acc[n] = __builtin_amdgcn_mfma_f32_16x16x32_bf16(a_, bg[ks][n], acc[n], 0, 0, 0);
        }
#pragma unroll
        for (int r = 0; r < 4; ++r) {
            const int m = mB + 4 * fq + r;
            f32x4 y; y[0] = bflo(yw[r].x); y[1] = bfhi(yw[r].x); y[2] = bflo(yw[r].y); y[3] = bfhi(yw[r].y);
            const float mean = red16((y[0] + y[1]) + (y[2] + y[3])) * (1.0f / 64.0f);
            const f32x4 d = y - mean;
            const float var = red16((d[0] * d[0] + d[1] * d[1]) + (d[2] * d[2] + d[3] * d[3])) * (1.0f / 64.0f);
            const float rs = rsqrtf(var + 64e-5f);
            f32x4 o;
#pragma unroll
            for (int n = 0; n < 4; ++n) o[n] = (d[n] * rs * lg[n] + lb[n] + bon[r] * (float)vv[r][n]) * acc[n][r];
            u32x2 w; w.x = pk_bf(o[0], o[1]); w.y = pk_bf(o[2], o[3]);
            *(u32x2*)(MIX + (size_t)m * DM + j0) = w;
        }
    }
}
__device__ __forceinline__ void post_gd(u16* __restrict__ MIX, const u16* __restrict__ Z2, const float* __restrict__ ng) {
    const int tid_ = otid(); const int lane = tid_ & 63, wid = tid_ >> 6; const int bidx = obid(), gdim = ogrid();
    for (int task = bidx * 8 + wid; task < 6 * (MT / 32); task += gdim * 8) {
        const int hh = task % 6, chunk = task / 6, m0 = chunk * 32;
        const float n0 = ng[2 * lane], n1 = ng[2 * lane + 1];
        for (int s8 = 0; s8 < 32; s8 += 8) {
          unsigned lo[8], lg[8];
#pragma unroll
          for (int k = 0; k < 8; ++k) { const int m = m0 + s8 + k; lo[k] = *(const unsigned*)(MIX + (size_t)m * DM + 768 + hh * 128 + 2 * lane); lg[k] = *(const unsigned*)(Z2 + (size_t)m * Z2_LD + Z2_GATE + hh * 128 + 2 * lane); }
#pragma unroll
          for (int k = 0; k < 8; ++k) {
            const int m = m0 + s8 + k;
            unsigned* op = (unsigned*)(MIX + (size_t)m * DM + 768 + hh * 128 + 2 * lane);
            const unsigned ow = lo[k];
            const float o0 = bflo(ow), o1 = bfhi(ow);
            const float ss = wave_sum(o0 * o0 + o1 * o1);
            const float rs = rsqrtf(ss * (1.0f / 128.0f) + 1e-6f);
            const unsigned gw = lg[k];
            const float g0 = bflo(gw), g1 = bfhi(gw);
            *op = pk_bf(o0 * rs * n0 * (g0 * sigm(g0)), o1 * rs * n1 * (g1 * sigm(g1)));
          }
        }
    }
}

#define XB_TMO      128
#define XB_XCNT(j)  (256  + 64 * (j))
#define XB_XSUB(j)  (1280 + 64 * (j))
#define XB_XGEN(j)  (2304 + 64 * (j))
#define XB_TOP      3328
#define XB_TOPGEN   3392
#define XCD_BAR_WORDS 3456
#define XB_SPIN_CAP (1u << 18)

__device__ __forceinline__ unsigned xb_ld(unsigned* p)              { return __hip_atomic_load(p, __ATOMIC_RELAXED, __HIP_MEMORY_SCOPE_AGENT); }
__device__ __forceinline__ unsigned xb_add(unsigned* p, unsigned v) { return __hip_atomic_fetch_add(p, v, __ATOMIC_RELAXED, __HIP_MEMORY_SCOPE_AGENT); }
__device__ __forceinline__ unsigned xb_xcc_id() { return (unsigned)__builtin_amdgcn_s_getreg((3 << 11) | 20) & 0xFu; }
#define XB_SPIN(cond, bar) do { unsigned _sp = 0; while (cond) { __builtin_amdgcn_s_sleep(1); \
    if ((++_sp & 255u) == 0u) { if (xb_ld(&(bar)[XB_TMO])) break; if (_sp > XB_SPIN_CAP) { atomicAdd(&(bar)[XB_TMO], 1u); break; } } } } while (0)

struct XcdBarrier {
    unsigned* bar; unsigned x;
    volatile LAS unsigned* st;
};

__device__ __forceinline__ XcdBarrier xcd_barrier_post(unsigned* bar, volatile LAS unsigned* st) {
    XcdBarrier b; b.bar = bar; b.x = xb_xcc_id(); b.st = st;
    if (threadIdx.x == 0) (void)xb_add(&bar[XB_XCNT(b.x)], 1u);
    return b;
}
__device__ __forceinline__ void xcd_barrier_complete(unsigned* bar, unsigned x, unsigned& nloc, unsigned& nx) {
    const unsigned G = gridDim.x * gridDim.y * gridDim.z;
    unsigned sum, cnt, mine, sp = 0u;
    for (;;) {
        sum = 0u; cnt = 0u; mine = 0u;
#pragma unroll
        for (unsigned j = 0; j < 16; ++j) { const unsigned c = xb_ld(&bar[XB_XCNT(j)]); sum += c; cnt += (c > 0u) ? 1u : 0u; mine = (j == x) ? c : mine; }
        if (sum == G) break;
        __builtin_amdgcn_s_sleep(1);
        if ((++sp & 255u) == 0u) { if (xb_ld(&bar[XB_TMO])) break; if (sp > XB_SPIN_CAP) { atomicAdd(&bar[XB_TMO], 1u); break; } }
    }
    nloc = mine > 0u ? mine : 1u; nx = cnt > 0u ? cnt : 1u;
}

__device__ __forceinline__ void xcd_barrier(const XcdBarrier& b) {
    asm volatile("s_waitcnt vmcnt(0)" ::: "memory");
    __syncthreads();
    if (threadIdx.x == 0) {
        unsigned* bar = b.bar;
        __builtin_amdgcn_s_waitcnt(0);
        unsigned nloc = b.st[0], nx = b.st[1];
        if (nloc == 0u) { xcd_barrier_complete(bar, b.x, nloc, nx); b.st[0] = nloc; b.st[1] = nx; }
        const unsigned old = xb_add(&bar[XB_XSUB(b.x)], 1u);
        const unsigned gen = old / nloc;
        if (old + 1u == (gen + 1u) * nloc) {
            __builtin_amdgcn_fence(__ATOMIC_RELEASE, "agent");
            asm volatile("s_waitcnt vmcnt(0)" ::: "memory");
            const unsigned og = xb_add(&bar[XB_TOP], 1u);
            const unsigned tg = og / nx;
            if (og + 1u == (tg + 1u) * nx) xb_add(&bar[XB_TOPGEN], 1u);
            else XB_SPIN(xb_ld(&bar[XB_TOPGEN]) == tg, bar);
            __builtin_amdgcn_fence(__ATOMIC_ACQUIRE, "agent");
            xb_add(&bar[XB_XGEN(b.x)], 1u);
            asm volatile("s_waitcnt vmcnt(0)" ::: "memory");
        } else {
            XB_SPIN(xb_ld(&bar[XB_XGEN(b.x)]) == gen, bar);
            __builtin_amdgcn_fence(__ATOMIC_ACQUIRE, "agent");
            asm volatile("s_waitcnt vmcnt(0)" ::: "memory");
        }
    }
    __syncthreads();
}
__device__ __forceinline__ const float* getp(const LAS unsigned* TAB, int k) {
    const unsigned lo = __builtin_amdgcn_readfirstlane(TAB[2 * k]), hi = __builtin_amdgcn_readfirstlane(TAB[2 * k + 1]);
    return (const float*)(((unsigned long long)hi << 32) | lo);
}
__global__ void __launch_bounds__(512, 2) fwd_mega(Params p) {
    extern __shared__ __attribute__((aligned(16))) unsigned char lds_raw[];
    LAS unsigned char* lds = (LAS unsigned char*)lds_raw;
    cg::grid_group grid = cg::this_grid();
#if REP & 256
#define GSYNC() do { xcd_barrier(xbar); xcd_barrier(xbar); } while (0)
#else
#define GSYNC() xcd_barrier(xbar)
#endif
    unsigned char* ws = p.ws;
    u16* HBUF = (u16*)(ws + WS_HBUF); u16* WGU = (u16*)(ws + WS_WGU); u16* WD = (u16*)(ws + WS_WD); u16* WIN = (u16*)(ws + WS_WIN); u16* WOUT = (u16*)(ws + WS_WOUT);
    u16* ACT = (u16*)(ws + WS_ACT); u16* Z = (u16*)(ws + WS_Z); h16* RWPp = (h16*)(ws + WS_RWP); float* RWSp = (float*)(ws + WS_RWS); u16* ZG = (u16*)(ws + WS_ZG);
    h16* GDPp = (h16*)(ws + WS_GDP); float* GDSp = (float*)(ws + WS_GDS); u16* LRA = (u16*)(ws + WS_LRA); u16* LRUb = (u16*)(ws + WS_LRU); u16* WGU2 = (u16*)(ws + WS_WGU2); u16* WD2 = (u16*)(ws + WS_WD2);
    const bool pre2 = gridDim.x > 208;     float* HIN = (float*)(ws + WS_HIN); float* BONp = (float*)(ws + WS_BON);
    float* X = p.out;
    const int G = gridDim.x, bid = blockIdx.x;
    LAS unsigned* TAB = (LAS unsigned*)(lds + 131072 + 1024);
    if (threadIdx.x == 0) {
#pragma unroll
        for (int i = 0; i < 35; ++i) { const unsigned long long a = (unsigned long long)p.in[i]; TAB[2 * i] = (unsigned)a; TAB[2 * i + 1] = (unsigned)(a >> 32); }
    }
    volatile LAS unsigned* xst = (volatile LAS unsigned*)(lds + 131072 + 512);
    if (threadIdx.x < 2) xst[threadIdx.x] = 0u;
    __syncthreads();
    const XcdBarrier xbar = xcd_barrier_post((unsigned*)(ws + WS_BAR), xst);
    grid.sync();
#define INP(k) getp(TAB, (k))

    for (int l = 0; l < 2; ++l) {
        for (int half = 0; half < 2; ++half) {
            const float* ng = INP(half ? 30 : 1) + (size_t)l * DM;
            const float* wg = INP(half ? 31 : 2) + (size_t)l * DM * DFF;
            const float* wu = INP(half ? 32 : 3) + (size_t)l * DM * DFF;
            const float* wd = INP(half ? 33 : 4) + (size_t)l * DM * DFF;
#if PH & 1
            u16* const WGUc = (half && pre2) ? WGU2 : WGU; u16* const WDc = (half && pre2) ? WD2 : WD;
            if (!(half && pre2)) {
            conv_w<1>(wg, WGUc, DM, DFF, (LAS float*)lds);
            conv_w<2>(wu, WGUc, DM, DFF, (LAS float*)lds);
            conv_w<0>(wd, WDc, DFF, DM, (LAS float*)lds);
            }
#endif
#if PH & 2
            if (l == 0 && half == 0) norm_rows<false>(INP(0), ng, HBUF, nullptr); else norm_rows<false>(X, ng, HBUF, nullptr);
#endif
#if REP & 32
            conv_w<1>(wg, WGU, DM, DFF, (LAS float*)lds);
            conv_w<2>(wu, WGU, DM, DFF, (LAS float*)lds);
            conv_w<0>(wd, WD, DFF, DM, (LAS float*)lds);
#endif
#if REP & 64
            if (l == 0 && half == 0) norm_rows<false>(INP(0), ng, HBUF, X); else norm_rows<false>(X, ng, HBUF, nullptr);
#endif
            GSYNC();
#if PH & 4
            { pg8::Gemm g{HBUF, WGUc, MT, 2 * DFF, DM}; pg8::StaticOrder S; S.init(MT, 2 * DFF, G, bid); pg8::EpiGU E{ACT, DFF};
              pg8::gemm_phase<pg8::EpiGU, pg8::StaticOrder>(lds, g, S, E);
#if REP & 1
              GSYNC(); pg8::gemm_phase<pg8::EpiGU, pg8::StaticOrder>(lds, g, S, E);
#endif
            }
#endif
            GSYNC();
#if PH & 8
            { pg8::Gemm g{ACT, WDc, MT, DM, DFF}; pg8::StaticOrder S; S.init(MT, DM, G, bid); pg8::EpiResid E{(l == 0 && half == 0) ? INP(0) : (const float*)X, X, DM, (REP & 2) ? 0.25f : 0.5f};
              pg8::gemm_phase<pg8::EpiResid, pg8::StaticOrder, true>(lds, g, S, E);
#if REP & 2
              GSYNC(); pg8::gemm_phase<pg8::EpiResid, pg8::StaticOrder, true>(lds, g, S, E);
#endif
            }
#endif
            GSYNC();
            if (half == 1) continue;
#if PH & 16
            conv_w<3>(INP(6) + (size_t)l * DM * 6668, WIN, DM, 6668, (LAS float*)lds);
            conv_w<0>(INP(29) + (size_t)l * DM * DM, WOUT, DM, DM, (LAS float*)lds);
            tr_small(INP(9) + l * 64 * 768, (u16*)(ws + WS_W2T), 64); tr_small(INP(11) + l * 64 * 768, (u16*)(ws + WS_A2T), 64); tr_small(INP(12) + l * 128 * 768, (u16*)(ws + WS_G2T), 128);
            tr_blocks(INP(24) + l * 8 * 64 * 64, (u16*)(ws + WS_WAT)); tr_blocks(INP(26) + l * 8 * 64 * 64, (u16*)(ws + WS_WXT));
            norm_rows<false>(X, INP(5) + (size_t)l * DM, HBUF, nullptr);
#endif
            GSYNC();
#if PH & 32
            { pg8::Gemm g{HBUF, WIN, MT, 2560, DM}; pg8::StaticOrder S; S.init(MT, 2560, G, bid); pg8::EpiZ E{Z, Z1_LD};
              pg8::gemm_phase<pg8::EpiZ, pg8::StaticOrder>(lds, g, S, E); }
#endif
            GSYNC();
#if PH & 64
            { RwP P{INP(7) + l * 2560, INP(8) + l * 768, INP(9) + l * 64 * 768, INP(10) + l * 768, INP(11) + l * 64 * 768, INP(13) + l * 768, INP(14) + l * 768, INP(15) + l * 768};
              prep_rw2(Z, P, (const u16*)(ws + WS_W2T), (const u16*)(ws + WS_A2T), RWPp, RWSp, BONp, ZG, lds);
#if REP & 8
              prep_rw2(Z, P, (const u16*)(ws + WS_W2T), (const u16*)(ws + WS_A2T), RWPp, RWSp, BONp, ZG, lds);
#endif
            }
#endif
            GSYNC();
#if PH & 128
            { pg8::Gemm g{HBUF, WIN + (size_t)2560 * DM, MT, 4352, DM}; pg8::StaticOrder S; S.init(MT, 4352, G, bid); pg8::EpiZ E{Z, Z2_LD};
              pg8::gemm_phase<pg8::EpiZ, pg8::StaticOrder>(lds, g, S, E); }
#endif
            GSYNC();
#if PH & 256
            prep_gd(Z, INP(18) + l * 4 * 2304, INP(19) + l * 6, INP(20) + l * 6, GDPp, GDSp);
#endif
#if PH & 512
            { LrP P{INP(22) + l * 4 * 512, INP(23) + l * 512, INP(24) + l * 8 * 64 * 64, INP(25) + l * 512, INP(26) + l * 8 * 64 * 64, INP(27) + l * 512, INP(28) + l * 512};
              prep_lr2(Z, P, (const u16*)(ws + WS_WAT), (const u16*)(ws + WS_WXT), LRA, LRUb, lds);
            }
#endif
            GSYNC();
#if PH & 1024
            for (int rep_ = 0; rep_ < ((REP & 4) ? 2 : 1); ++rep_)
            for (int task = bid; task < 208; task += G) {
                if (task < 96) { const int bh = task >> 2, q4 = task & 3, b = bh / 12, hh = bh % 12;
                    rec_block<0>((const unsigned char*)RWPp + (size_t)bh * TS * 768, (const unsigned char*)RWSp + (size_t)bh * TS * 16,
                                 HBUF + (size_t)b * TS * DM + hh * 64 + q4 * 16, q4 * 16, lds);
                    __threadfence();
                    __syncthreads();
                    if (threadIdx.x == 0) {
                        unsigned* cnt = (unsigned*)(ws + WS_BAR + 14336) + bh;
                        __hip_atomic_fetch_add(cnt, 1u, __ATOMIC_RELAXED, __HIP_MEMORY_SCOPE_AGENT);
                        const unsigned want = 4u * (unsigned)(l + 1); unsigned spins = 0;
                        while (__hip_atomic_load(cnt, __ATOMIC_RELAXED, __HIP_MEMORY_SCOPE_AGENT) < want) { __builtin_amdgcn_s_sleep(8); if (++spins > (1u << 22)) break; }
                        __builtin_amdgcn_fence(__ATOMIC_ACQUIRE, "agent");
                        asm volatile("s_waitcnt vmcnt(0)" ::: "memory");
                    }
                    __syncthreads();
                    post_rw_head(HBUF, RWPp, BONp, ZG, (const u16*)(ws + WS_G2T), INP(16) + l * 768, INP(17) + l * 768, b, hh, q4 * (TS / 64), TS / 64); }
                else if (task < 192) { const int gb = task - 96, bh = gb >> 3, o8 = gb & 7, b = bh / 6, hh = bh % 6;
                    rec_block<1>((const unsigned char*)GDPp + (size_t)bh * TS * 768, (const unsigned char*)GDSp + (size_t)bh * TS * 16,
                                 HBUF + (size_t)b * TS * DM + 768 + hh * 128 + o8 * 16, o8 * 16, lds); }
                else if (threadIdx.x < 64) lru_carry(task - 192, LRA, LRUb, HIN);
            }
            if (pre2 && bid >= 208) {
                conv_w<1>(INP(31) + (size_t)l * DM * DFF, WGU2, DM, DFF, (LAS float*)lds, bid - 208, G - 208);
                conv_w<2>(INP(32) + (size_t)l * DM * DFF, WGU2, DM, DFF, (LAS float*)lds, bid - 208, G - 208);
                conv_w<0>(INP(33) + (size_t)l * DM * DFF, WD2, DFF, DM, (LAS float*)lds, bid - 208, G - 208);
            }
#endif
            GSYNC();
#if PH & 2048
#endif
#if PH & 4096
            post_gd(HBUF, Z, INP(21) + l * 128);
            post_lr(HBUF, Z, LRA, LRUb, HIN);
#endif
            GSYNC();
#if PH & 8192
            { pg8::Gemm g{HBUF, WOUT, MT, DM, DM}; pg8::StaticOrder S; S.init(MT, DM, G, bid); pg8::EpiResid E{X, X, DM, 1.0f};
              pg8::gemm_phase<pg8::EpiResid, pg8::StaticOrder>(lds, g, S, E); }
#endif
            GSYNC();
        }
    }
    norm_rows<true>(X, INP(34), nullptr, X);
}

extern "C" void kernel_launch(void* const* d_in, const int* in_sizes, int n_in, void* d_out, int out_size, void* d_ws, size_t ws_size, hipStream_t stream) {
    static int grid_blocks = 0;
    if (!grid_blocks) {
        int dev = 0, cus = 0, per_cu = 0;
        (void)hipGetDevice(&dev);
        (void)hipDeviceGetAttribute(&cus, hipDeviceAttributeMultiprocessorCount, dev);
        (void)hipFuncSetAttribute((const void*)fwd_mega, hipFuncAttributeMaxDynamicSharedMemorySize, LDS_BYTES);
        (void)hipOccupancyMaxActiveBlocksPerMultiprocessor(&per_cu, (const void*)fwd_mega, 512, LDS_BYTES);
        grid_blocks = cus > 0 ? cus : 256;
        if (ws_size < WS_END) fprintf(stderr, "kernel_launch: workspace too small: %zu < %zu\n", ws_size, (size_t)WS_END);
        fprintf(stderr, "kernel_launch: cus %d occupancy %d ws %zu n_in %d\n", cus, per_cu, ws_size, n_in);
    }
    Params p{};
    for (int i = 0; i < 35; ++i) p.in[i] = (const float*)d_in[i];
    p.out = (float*)d_out; p.ws = (unsigned char*)d_ws;
    (void)hipMemsetAsync((unsigned char*)d_ws + WS_BAR, 0, 16384, stream);
    void* args[] = {&p};
    hipError_t e = hipLaunchCooperativeKernel((const void*)fwd_mega, dim3(grid_blocks), dim3(512), args, LDS_BYTES, stream);
    if (e != hipSuccess) fprintf(stderr, "cooperative launch failed: %s (grid %d)\n", hipGetErrorString(e), grid_blocks);
}
```

```cpp
#include <hip/hip_runtime.h>
#include <hip/hip_cooperative_groups.h>
#include <cstdio>
namespace cg = cooperative_groups;
#include <hip/hip_runtime.h>
namespace pg8 {
#define PG8_LAS __attribute__((address_space(3)))
typedef unsigned short bf16_t;
typedef short bf16x8 __attribute__((ext_vector_type(8)));
typedef float f32x4 __attribute__((ext_vector_type(4)));
typedef unsigned u32x4 __attribute__((ext_vector_type(4)));
constexpr int BM = 256, BK = 64, HALF = 128, HTB = HALF * BK * 2  , STAGE_BYTES = 8 * HTB, NXCD = 8, WGM = 8;

__host__ __device__ __forceinline__ int lds_byte(int r, int c) { const int st = (r >> 4) * 2 + (c >> 5), rr = r & 15, cc = c & 31, ob = rr * 64 + cc * 2; return st * 1024 + (ob ^ (((ob >> 9) & 1) << 5)); }
__host__ __device__ __forceinline__ void stage_rc(int b, int& R, int& C) { const int st = b / 1024, sb = b % 1024, swz = sb ^ (((sb >> 9) & 1) << 5); R = (st >> 1) * 16 + swz / 64; C = (st & 1) * 32 + (swz % 64) / 2; }
__host__ __device__ __forceinline__ int perm32(int rho) { const int n = rho >> 4, i = rho & 15; return 8 * (i >> 2) + 4 * n + (i & 3); }

struct Unit { int pm, pn; };
struct Gemm { const bf16_t* A; const bf16_t* Bt; int M, N, K; };

struct StaticOrder {
    int nM, nN, nwg, G, c;
    __host__ __device__ void init(int M, int N, int G_, int c_) { nM = M / BM; nN = N / BM; nwg = nM * nN; G = G_; c = c_; }
    __host__ __device__ bool next(int i, Unit& u) const {
        const long L = (long)i * G + c; if (L >= nwg) return false;
        int wgid = (int)L; { const int q = nwg / NXCD, r = nwg % NXCD, xcd = wgid % NXCD, off = wgid / NXCD; wgid = (xcd < r ? xcd * (q + 1) : r * (q + 1) + (xcd - r) * q) + off; }
        const int nig = WGM * nN, gid = wgid / nig, fm = gid * WGM, gsz = (nM - fm) < WGM ? (nM - fm) : WGM;
        u.pm = fm + ((wgid % nig) % gsz); u.pn = (wgid % nig) / gsz; return true;
    }
    __device__ __forceinline__ void a_ready(const Unit&) const {}
    __device__ __forceinline__ void done(const Unit&) const {}
};
__device__ __forceinline__ unsigned cvt_pk_bf16(float lo, float hi) { unsigned r; asm volatile("v_cvt_pk_bf16_f32 %0, %1, %2" : "=v"(r) : "v"(lo), "v"(hi)); return r; }
typedef float f32x2 __attribute__((ext_vector_type(2)));
typedef unsigned u32x2 __attribute__((ext_vector_type(2)));
__device__ __forceinline__ float fast_silu(float g) { return g * __builtin_amdgcn_rcpf(1.0f + __expf(-g)); }
struct EpiGU {
    static constexpr bool PERM = true, AFTER_DRAIN = false;
    bf16_t* O; int ldc;
    __device__ __forceinline__ void operator()(const f32x4 (&acc)[2][2][4][2], const Unit& u, int wr, int wc, int fr, int fq) const {
        const int rl0 = wr * 64 + fr, col0 = u.pn * HALF + wc * 32 + 8 * fq;
        bf16_t* const blk = O + ((size_t)u.pm * (ldc >> 6) + (col0 >> 6)) * (BM * 64) + (col0 & 63);
#pragma unroll
        for (int ai = 0; ai < 2; ++ai)
#pragma unroll
            for (int m = 0; m < 4; ++m) { bf16_t* rowp = blk + (size_t)(rl0 + ai * HALF + m * 16) * 64;
                const f32x4 g0 = acc[ai][0][m][0], g1 = acc[ai][0][m][1], u0 = acc[ai][1][m][0], u1 = acc[ai][1][m][1];
                f32x4 h0, h1;
#pragma unroll
                for (int j = 0; j < 4; ++j) { h0[j] = fast_silu(g0[j]) * u0[j]; h1[j] = fast_silu(g1[j]) * u1[j]; }
                u32x4 w; w.x = cvt_pk_bf16(h0[0], h0[1]); w.y = cvt_pk_bf16(h0[2], h0[3]); w.z = cvt_pk_bf16(h1[0], h1[1]); w.w = cvt_pk_bf16(h1[2], h1[3]);
                *(u32x4*)rowp = w; }
    }
};
struct EpiZ {
    static constexpr bool PERM = true, AFTER_DRAIN = false;
    bf16_t* O; int ldc;
    __device__ __forceinline__ void operator()(const f32x4 (&acc)[2][2][4][2], const Unit& u, int wr, int wc, int fr, int fq) const {
        const int row0 = u.pm * BM + wr * 64 + fr, col0 = u.pn * BM + wc * 32 + 8 * fq;
#pragma unroll
        for (int ai = 0; ai < 2; ++ai)
#pragma unroll
            for (int m = 0; m < 4; ++m) { bf16_t* rowp = O + (size_t)(row0 + ai * HALF + m * 16) * ldc + col0;
#pragma unroll
                for (int bj = 0; bj < 2; ++bj) { const f32x4 v0 = acc[ai][bj][m][0], v1 = acc[ai][bj][m][1];
                    u32x4 w; w.x = cvt_pk_bf16(v0[0], v0[1]); w.y = cvt_pk_bf16(v0[2], v0[3]); w.z = cvt_pk_bf16(v1[0], v1[1]); w.w = cvt_pk_bf16(v1[2], v1[3]);
                    *(u32x4*)(rowp + bj * HALF) = w; } }
    }
};
struct EpiResid {
    static constexpr bool PERM = true, AFTER_DRAIN = false;
    const float* Xs; float* X; int ldc; float scale;
    __device__ __forceinline__ void operator()(const f32x4 (&acc)[2][2][4][2], const Unit& u, int wr, int wc, int fr, int fq) const {
        const int row0 = u.pm * BM + wr * 64 + fr, col0 = u.pn * BM + wc * 32 + 8 * fq;
#pragma unroll
        for (int ai = 0; ai < 2; ++ai)
#pragma unroll
            for (int m = 0; m < 4; ++m) { const size_t off = (size_t)(row0 + ai * HALF + m * 16) * ldc + col0;
#pragma unroll
                for (int bj = 0; bj < 2; ++bj) { const size_t o2 = off + bj * HALF;
                    const f32x4 x0 = *(const f32x4*)(Xs + o2) + acc[ai][bj][m][0] * scale, x1 = *(const f32x4*)(Xs + o2 + 4) + acc[ai][bj][m][1] * scale;
                    *(f32x4*)(X + o2) = x0; *(f32x4*)(X + o2 + 4) = x1; } }
    }
};
template <class Epi, class Sched, bool ABLK = false>
__device__ __forceinline__ void gemm_phase(PG8_LAS unsigned char* lds, const Gemm g, const Sched& S, const Epi& E) {
    int tid_o = threadIdx.x; asm volatile("" : "+v"(tid_o));
    const int tid = tid_o, wid = __builtin_amdgcn_readfirstlane(tid >> 6), lane = tid & 63, wr = wid >> 2, wc = wid & 3, fr = lane & 15, fq = lane >> 4;
    const int K = g.K, nt = K / BK;
    unsigned voffA[2], voffB[2];
#pragma unroll
    for (int i = 0; i < 2; ++i) { int R, C; stage_rc(tid * 16 + i * 8192, R, C); const int Rb = Epi::PERM ? ((R & ~31) + perm32(R & 31)) : R;
        voffA[i] = ABLK ? (unsigned)(R * BK + C) * 2u : (unsigned)(R * K + C) * 2u; voffB[i] = (unsigned)(Rb * K + C) * 2u; }
    const size_t kstep = (size_t)(BK * 2);
    const size_t hstep = (size_t)HALF * K * 2;
    const size_t tstep = 2 * hstep;
    const size_t kstepA = ABLK ? (size_t)(BM * BK * 2) : kstep, hstepA = ABLK ? (size_t)(HALF * BK * 2) : hstep, tstepA = tstep;
    const unsigned ldsw = (unsigned)wid * 1024u;
    const int aoff = lds_byte(wr * 64 + fr, fq * 8), boff = lds_byte(wc * 32 + fr, fq * 8);
#define PG8_SA(b, h) (((b) * 2 + (h)) * HTB)
#define PG8_SB(b, h) ((4 + (b) * 2 + (h)) * HTB)
#define PG8_STAGE(bufoff, gbase, voff) do { _Pragma("unroll") for (int _i = 0; _i < 2; ++_i) \
        __builtin_amdgcn_global_load_lds((const unsigned*)((const char*)(gbase) + (voff)[_i]), (PG8_LAS unsigned*)(lds + (bufoff) + ldsw + _i * 8192), 16, 0, 0); } while (0)
#define PG8_LDA(dst, b, h) do { _Pragma("unroll") for (int m = 0; m < 4; ++m) _Pragma("unroll") for (int k = 0; k < 2; ++k) dst[m][k] = *(const PG8_LAS bf16x8*)(lds + PG8_SA(b, h) + aoff + m * 2048 + k * 1024); } while (0)
#define PG8_LDB(dst, b, h) do { _Pragma("unroll") for (int n = 0; n < 2; ++n) _Pragma("unroll") for (int k = 0; k < 2; ++k) dst[n][k] = *(const PG8_LAS bf16x8*)(lds + PG8_SB(b, h) + boff + n * 2048 + k * 1024); } while (0)
#define PG8_MMA(ai, bj, At, Bt) do { __builtin_amdgcn_s_setprio(1); _Pragma("unroll") for (int m = 0; m < 4; ++m) _Pragma("unroll") for (int n = 0; n < 2; ++n) _Pragma("unroll") for (int k = 0; k < 2; ++k) \
        acc[ai][bj][m][n] = __builtin_amdgcn_mfma_f32_16x16x32_bf16(Bt[n][k], At[m][k], acc[ai][bj][m][n], 0, 0, 0); __builtin_amdgcn_s_setprio(0); } while (0)
#define PG8_WAIT_V(n) asm volatile("s_waitcnt vmcnt(" #n ")" ::: "memory")
#define PG8_WAIT_L(n) asm volatile("s_waitcnt lgkmcnt(" #n ")" ::: "memory")
#define PG8_BAR __builtin_amdgcn_s_barrier()
#define PG8_SCHED __builtin_amdgcn_sched_barrier(0)
    Unit cur, nxt; int ui = 0;
    if (!S.next(0, cur)) return;
    f32x4 acc[2][2][4][2];
#pragma unroll
    for (int a = 0; a < 2; ++a)
#pragma unroll
        for (int b = 0; b < 2; ++b)
#pragma unroll
            for (int m = 0; m < 4; ++m)
#pragma unroll
                for (int n = 0; n < 2; ++n) acc[a][b][m][n] = (f32x4){0.f, 0.f, 0.f, 0.f};
    bf16x8 At[4][2], B0[2][2], B1[2][2];
    const char* cA = (const char*)g.A + (size_t)cur.pm * tstepA; const char* cB = (const char*)g.Bt + (size_t)cur.pn * tstep;
    S.a_ready(cur);
    PG8_STAGE(PG8_SB(0, 0), cB, voffB); PG8_STAGE(PG8_SA(0, 0), cA, voffA); PG8_STAGE(PG8_SB(0, 1), cB + hstep, voffB); PG8_STAGE(PG8_SA(0, 1), cA + hstepA, voffA);
    if (wr == 1) PG8_BAR;
    PG8_WAIT_V(4); PG8_BAR;
    PG8_STAGE(PG8_SB(1, 0), cB + kstep, voffB); PG8_STAGE(PG8_SA(1, 0), cA + kstepA, voffA); PG8_STAGE(PG8_SB(1, 1), cB + hstep + kstep, voffB);
    PG8_WAIT_V(6); PG8_BAR;
    for (;;) {
        const bool has_next = S.next(ui + 1, nxt);
        const char* nA = has_next ? (const char*)g.A + (size_t)nxt.pm * tstepA : cA; const char* nB = has_next ? (const char*)g.Bt + (size_t)nxt.pn * tstep : cB;
        for (int t = 0; t < nt; t += 2) {
            const bool last = (t == nt - 2);
            const char* a1 = cA + (size_t)(t + 1) * kstepA;
            const char* a2 = last ? nA : cA + (size_t)(t + 2) * kstepA; const char* b2 = last ? nB : cB + (size_t)(t + 2) * kstep;
            const char* a3 = a2 + kstepA; const char* b3 = b2 + kstep;
            if (last && has_next) S.a_ready(nxt);
            PG8_LDB(B0, 0, 0); PG8_SCHED; PG8_LDA(At, 0, 0); PG8_STAGE(PG8_SA(1, 1), a1 + hstepA, voffA);
            PG8_WAIT_L(8); PG8_BAR; PG8_WAIT_L(0); PG8_MMA(0, 0, At, B0); PG8_BAR; PG8_SCHED;
            PG8_LDB(B1, 0, 1); PG8_STAGE(PG8_SB(0, 0), b2, voffB);
            PG8_BAR; PG8_WAIT_L(0); PG8_MMA(0, 1, At, B1); PG8_BAR;
            PG8_LDA(At, 0, 1); PG8_STAGE(PG8_SA(0, 0), a2, voffA);
            PG8_BAR; PG8_WAIT_L(0); PG8_MMA(1, 0, At, B0); PG8_BAR; PG8_SCHED;
            PG8_STAGE(PG8_SB(0, 1), b2 + hstep, voffB);
            PG8_WAIT_V(6); PG8_BAR; PG8_MMA(1, 1, At, B1); PG8_BAR;
            PG8_LDB(B0, 1, 0); PG8_SCHED; PG8_LDA(At, 1, 0); PG8_STAGE(PG8_SA(0, 1), a2 + hstepA, voffA);
            PG8_WAIT_L(8); PG8_BAR; PG8_WAIT_L(0); PG8_MMA(0, 0, At, B0); PG8_BAR; PG8_SCHED;
            PG8_LDB(B1, 1, 1); PG8_STAGE(PG8_SB(1, 0), b3, voffB);
            PG8_BAR; PG8_WAIT_L(0); PG8_MMA(0, 1, At, B1); PG8_BAR;
            PG8_LDA(At, 1, 1); PG8_STAGE(PG8_SA(1, 0), a3, voffA);
            PG8_BAR; PG8_WAIT_L(0); PG8_MMA(1, 0, At, B0); PG8_BAR; PG8_SCHED;
            PG8_STAGE(PG8_SB(1, 1), b3 + hstep, voffB);
            PG8_WAIT_V(6); PG8_BAR; PG8_MMA(1, 1, At, B1); PG8_BAR;
        }
        if constexpr (!Epi::AFTER_DRAIN) { E(acc, cur, wr, wc, fr, fq); S.done(cur); }
        if (!has_next) break;
#pragma unroll
        for (int a = 0; a < 2; ++a)
#pragma unroll
            for (int b = 0; b < 2; ++b)
#pragma unroll
                for (int m = 0; m < 4; ++m)
#pragma unroll
                    for (int n = 0; n < 2; ++n) acc[a][b][m][n] = (f32x4){0.f, 0.f, 0.f, 0.f};
        cur = nxt; cA = nA; cB = nB; ++ui;
    }
    PG8_WAIT_V(0);
    if (wr == 0) PG8_BAR;
    PG8_BAR;
    if constexpr (Epi::AFTER_DRAIN) { E.fused(acc, cur, wr, wc, fr, fq, lds, wid, lane); S.done(cur); }
#undef PG8_SA
#undef PG8_SB
#undef PG8_STAGE
#undef PG8_LDA
#undef PG8_LDB
#undef PG8_MMA
#undef PG8_WAIT_V
#undef PG8_WAIT_L
#undef PG8_BAR
#undef PG8_SCHED
}
}
#ifndef PH
#define PH 0xFFFF
#endif
#ifndef REP
#define REP 0
#endif
typedef unsigned short u16;
typedef float f32x4 __attribute__((ext_vector_type(4)));
typedef float f32x2 __attribute__((ext_vector_type(2)));
typedef unsigned u32x4 __attribute__((ext_vector_type(4)));
typedef unsigned u32x2 __attribute__((ext_vector_type(2)));
typedef _Float16 h16;
typedef _Float16 h16x4 __attribute__((ext_vector_type(4)));
typedef _Float16 h16x8 __attribute__((ext_vector_type(8)));
typedef _Float16 h16x2 __attribute__((ext_vector_type(2)));
#define LAS __attribute__((address_space(3)))

constexpr int MT = 32768, TS = 16384, DM = 2048, DFF = 5632;
constexpr int LDS_BYTES = 144 * 1024;
constexpr size_t WS_HBUF = 0;
constexpr size_t WS_WBUF = 134217728;
constexpr size_t WS_WGU = WS_WBUF, WS_WD = WS_WBUF + 46137344;
constexpr size_t WS_WIN = WS_WBUF, WS_WOUT = WS_WBUF + 28311552;
constexpr size_t WS_ACT = WS_WBUF + 69206016;
constexpr size_t WS_Z = WS_WBUF + 36700160;
constexpr size_t WS_RWP = WS_Z + 285212672;
constexpr size_t WS_RWS = WS_RWP + 301989888;
constexpr size_t WS_ZG = WS_RWS + 6291456;
constexpr size_t WS_GDP = WS_ZG + 8388608;
constexpr size_t WS_GDS = WS_GDP + 150994944;
constexpr size_t WS_LRA = WS_GDS + 3145728;
constexpr size_t WS_LRU = WS_LRA + 33554432;
constexpr size_t WS_WGU2 = WS_LRU + 33554432;
constexpr size_t WS_WD2 = WS_WGU2 + 46137344;
constexpr size_t WS_HIN = WS_WD2 + 23068672;
constexpr size_t WS_BON = WS_HIN + 1048576;
constexpr size_t WS_BAR = WS_BON + 1572864;
constexpr size_t WS_W2T = WS_BAR + 16384;
constexpr size_t WS_A2T = WS_W2T + 98304;
constexpr size_t WS_G2T = WS_A2T + 98304;
constexpr size_t WS_WAT = WS_G2T + 196608;
constexpr size_t WS_WXT = WS_WAT + 65536;
constexpr size_t WS_END = WS_WXT + 65536;
static_assert(WS_END <= 1073741824ull, "workspace");
constexpr int Z1_LD = 2560, Z2_LD = 4352;
constexpr int Z2_GATE = 2304, Z2_XL = 3072, Z2_YL = 3584, Z2_ZB = 4096, Z2_ZA = 4102;

struct Params { const float* in[35]; float* out; unsigned char* ws; };

__device__ __forceinline__ int otid() { int t = threadIdx.x; asm volatile("" : "+v"(t)); return t; }
__device__ __forceinline__ int obid() { int t = blockIdx.x; asm volatile("" : "+s"(t)); return t; }
__device__ __forceinline__ int ogrid() { int t = gridDim.x; asm volatile("" : "+s"(t)); return t; }
__device__ __forceinline__ float bf2f(u16 h) { return __uint_as_float((unsigned)h << 16); }
__device__ __forceinline__ float bflo(unsigned w) { return __uint_as_float(w << 16); }
__device__ __forceinline__ float bfhi(unsigned w) { return __uint_as_float(w & 0xffff0000u); }
__device__ __forceinline__ u16 f2bf(float f) { unsigned u = __float_as_uint(f); u += 0x7FFFu + ((u >> 16) & 1u); return (u16)(u >> 16); }
__device__ __forceinline__ unsigned pk_bf(float lo, float hi) { return pg8::cvt_pk_bf16(lo, hi); }
template <int C> __device__ __forceinline__ float dppf(float v) { return __int_as_float(__builtin_amdgcn_update_dpp(0, __float_as_int(v), C, 0xF, 0xF, true)); }
template <int H> __device__ __forceinline__ float fmix(float a, unsigned hp, float c) { float d;
    if (H == 0) asm("v_fma_mix_f32 %0, %1, %2, %3 op_sel_hi:[0,1,0]" : "=v"(d) : "v"(a), "v"(hp), "v"(c));
    else        asm("v_fma_mix_f32 %0, %1, %2, %3 op_sel:[0,1,0] op_sel_hi:[0,1,0]" : "=v"(d) : "v"(a), "v"(hp), "v"(c));
    return d; }
template <int H> __device__ __forceinline__ float fmixn(float a, unsigned hp, float c) { float d;
    if (H == 0) asm("v_fma_mix_f32 %0, -%1, %2, %3 op_sel_hi:[0,1,0]" : "=v"(d) : "v"(a), "v"(hp), "v"(c));
    else        asm("v_fma_mix_f32 %0, -%1, %2, %3 op_sel:[0,1,0] op_sel_hi:[0,1,0]" : "=v"(d) : "v"(a), "v"(hp), "v"(c));
    return d; }
__device__ __forceinline__ float red16(float v) { v += dppf<0xB1>(v); v += dppf<0x4E>(v); v += dppf<0x141>(v); v += dppf<0x140>(v); return v; }
__device__ __forceinline__ float rlane(float v, int l) { return __int_as_float(__builtin_amdgcn_readlane(__float_as_int(v), l)); }
__device__ __forceinline__ float wave_sum(float v) { v = red16(v);
    v += __int_as_float(__builtin_amdgcn_update_dpp(0, __float_as_int(v), 0x142, 0xA, 0xF, false));
    v += __int_as_float(__builtin_amdgcn_update_dpp(0, __float_as_int(v), 0x143, 0xC, 0xF, false));
    return rlane(v, 63); }
__device__ __forceinline__ float sigm(float x) { return __builtin_amdgcn_rcpf(1.0f + __expf(-x)); }
__device__ __forceinline__ float softplus_(float x) { return fmaxf(x, 0.0f) + __logf(1.0f + __expf(-fabsf(x))); }
__device__ __forceinline__ float tanh_(float x) { const float e = __expf(-2.0f * fabsf(x)); const float t = (1.0f - e) * __builtin_amdgcn_rcpf(1.0f + e); return x < 0.f ? -t : t; }
__device__ __forceinline__ float gelu_tanh(float x) { return 0.5f * x * (1.0f + tanh_(0.7978845608028654f * (x + 0.044715f * x * x * x))); }

template <int MAP> __device__ __forceinline__ int rowmap(int n) {
    if (MAP == 0) return n;
    if (MAP == 1) return (n >> 7) * 256 + (n & 127);
    if (MAP == 2) return (n >> 7) * 256 + 128 + (n & 127);
    if (n < 2560 + 3072) return n;
    const int q = n - 2560;
    if (q < 3084) return 2560 + Z2_ZB + (q - 3072);
    return 2560 + Z2_XL + (q - 3084);
}
template <int MAP> __device__ __forceinline__ void conv_w(const float* __restrict__ src, u16* __restrict__ dst, int K, int N, LAS float* tile, int bsub = 0, int gsub = 0) {
    const int tid = otid(), NT = (N + 63) >> 6, KT = K >> 6; const int bidx = gsub ? bsub : obid(), gdim = gsub ? gsub : ogrid();
    for (int t = bidx; t < NT * KT; t += gdim) {
        const int nt = t % NT, kt = t / NT;
        const int c = tid & 63, r0 = tid >> 6, n = nt * 64 + c;
#pragma unroll
        for (int i = 0; i < 8; ++i) { const int r = r0 + 8 * i; tile[r * 65 + c] = (n < N) ? src[(size_t)(kt * 64 + r) * N + n] : 0.f; }
        __syncthreads();
        const int nl = tid >> 3, kq = tid & 7, n2 = nt * 64 + nl;
        if (n2 < N) {
            float v[8];
#pragma unroll
            for (int j = 0; j < 8; ++j) v[j] = tile[(kq * 8 + j) * 65 + nl];
            u32x4 w; w.x = pk_bf(v[0], v[1]); w.y = pk_bf(v[2], v[3]); w.z = pk_bf(v[4], v[5]); w.w = pk_bf(v[6], v[7]);
            *(u32x4*)(dst + (size_t)rowmap<MAP>(n2) * K + kt * 64 + kq * 8) = w;
        }
        __syncthreads();
    }
}

template <bool FINAL> __device__ __forceinline__ void norm_rows(const float* src, const float* __restrict__ gamma, u16* dst, float* copy) {
    const int tid_ = otid(); const int lane = tid_ & 63, wid = tid_ >> 6; const int bidx = obid(), gdim = ogrid();
    f32x4 g[8];
#pragma unroll
    for (int i = 0; i < 8; ++i) g[i] = *(const f32x4*)(gamma + i * 256 + lane * 4);
    for (int row = bidx * 8 + wid; row < MT; row += gdim * 8) {
        const float* p = src + (size_t)row * DM; f32x4 v[8]; float ss = 0.f;
#pragma unroll
        for (int i = 0; i < 8; ++i) { v[i] = *(const f32x4*)(p + i * 256 + lane * 4); ss += v[i][0] * v[i][0] + v[i][1] * v[i][1] + v[i][2] * v[i][2] + v[i][3] * v[i][3]; }
        ss = wave_sum(ss);
        const float rs = rsqrtf(ss * (1.0f / 2048.0f) + 1e-6f);
#pragma unroll
        for (int i = 0; i < 8; ++i) {
            const f32x4 o = v[i] * rs * g[i];
            if (FINAL) { *(f32x4*)(copy + (size_t)row * DM + i * 256 + lane * 4) = o; }
            else { u32x2 w; w.x = pk_bf(o[0], o[1]); w.y = pk_bf(o[2], o[3]); *(u32x2*)(dst + (size_t)row * DM + i * 256 + lane * 4) = w;
                   if (copy) *(f32x4*)(copy + (size_t)row * DM + i * 256 + lane * 4) = v[i]; }
        }
    }
}

struct RwP { const float *mu, *w0, *w2, *a0, *a2, *kk, *ka, *rk; };
__device__ __forceinline__ void prep_rw(const u16* __restrict__ Z1, const RwP P, h16* __restrict__ RWP, float* __restrict__ RWS, float* __restrict__ BON, u16* __restrict__ ZG, LAS float* L) {
    const int tid = otid(), lane = tid & 63; const int bidx = obid(), gdim = ogrid();
    constexpr int TT = 32, TH = 16;
    for (int tile = bidx; tile < MT / TT; tile += gdim) {
        const int m0 = tile * TT;
#pragma unroll
        for (int i = 0; i < 16; ++i) {
            const int idx = tid + 512 * i, tok = idx >> 8, cc = idx & 255, m = m0 + tok, c = 2304 + cc;
            const float zc = bf2f(Z1[(size_t)m * Z1_LD + c]);
            const float zp = ((m & (TS - 1)) == 0) ? 0.f : bf2f(Z1[(size_t)(m - 1) * Z1_LD + c]);
            const float zf = zc + P.mu[c] * (zp - zc);
            if (cc < 64) L[cc * TT + tok] = tanh_(zf);
            else if (cc < 128) L[cc * TT + tok] = zf;
            else ZG[(size_t)m * 128 + (cc - 128)] = f2bf(sigm(zf));
        }
        __syncthreads();
        const int jj = tid & 255, th = tid >> 8;
        for (int cgi = 0; cgi < 3; ++cgi) {
            const int j = jj + 256 * cgi;
            const int mA = m0 + th * TH;
            u16 lr[TH], lk[TH], lv[TH]; u16 l0r = 0, l0k = 0, l0v = 0;
            if ((mA & (TS - 1)) != 0) { const u16* zp = Z1 + (size_t)(mA - 1) * Z1_LD; l0r = zp[j]; l0k = zp[768 + j]; l0v = zp[1536 + j]; }
#pragma unroll
            for (int tk = 0; tk < TH; ++tk) { const u16* zc = Z1 + (size_t)(mA + tk) * Z1_LD; lr[tk] = zc[j]; lk[tk] = zc[768 + j]; lv[tk] = zc[1536 + j]; }
            float aw[TH], aa[TH];
            { const float w0v = P.w0[j], a0v = P.a0[j];
#pragma unroll
              for (int k = 0; k < TH; ++k) { aw[k] = w0v; aa[k] = a0v; } }
#pragma unroll 4
            for (int i = 0; i < 64; ++i) {
                const float w2v = P.w2[i * 768 + j], a2v = P.a2[i * 768 + j];
#pragma unroll
                for (int q = 0; q < 4; ++q) {
                    const f32x4 t = *(const LAS f32x4*)(L + i * TT + th * TH + 4 * q), y = *(const LAS f32x4*)(L + (64 + i) * TT + th * TH + 4 * q);
#pragma unroll
                    for (int k = 0; k < 4; ++k) { aw[4 * q + k] += t[k] * w2v; aa[4 * q + k] += y[k] * a2v; }
                }
            }
            const float mur = P.mu[j], muk = P.mu[768 + j], muv = P.mu[1536 + j];
            const float kkc = P.kk[j], kac = P.ka[j], rkc = P.rk[j];
            const int hh = j >> 6;
            float pr = bf2f(l0r), pk = bf2f(l0k), pv = bf2f(l0v);
            float w1 = 0.f, dl1 = 0.f, bb1 = 0.f, kp1 = 0.f, br1 = 0.f, kr1 = 0.f;
#pragma unroll
            for (int tk = 0; tk < TH; ++tk) {
                const int m = mA + tk, b = m >> 14, t = m & (TS - 1);
                const float cr = bf2f(lr[tk]), ck = bf2f(lk[tk]), cv = bf2f(lv[tk]);
                const float r = cr + mur * (pr - cr), k = ck + muk * (pk - ck), v = cv + muv * (pv - cv);
                pr = cr; pk = ck; pv = cv;
                const float e = 0.6065306597f * sigm(aw[tk]);
                const float dl = 1.0f - __expf(-e);
                const float w = 1.0f - dl;
                const float a = sigm(aa[tk]);
                const float kq = k * kkc;
                const float ss = wave_sum(kq * kq);
                const float kkn = kq * rsqrtf(ss + 1e-12f);
                const float kp = k * (1.0f + (a - 1.0f) * kac);
                const float bb = kkn * a;
                const float wr = w * r;
                const float br = wave_sum(bb * r), kr = wave_sum(kp * r), bonus = wave_sum(r * kp * rkc);
                const size_t rec = (size_t)(b * 12 + hh) * TS + t;
                h16* o = RWP + (rec >> 1) * 768 + lane;
                if (lane == 0) BON[rec] = bonus;
                if ((tk & 1) == 0) {
                    o[0] = (h16)kkn; o[64] = (h16)wr; o[9 * 64] = (h16)v;
                    w1 = w; dl1 = dl; bb1 = bb; kp1 = kp; br1 = br; kr1 = kr;
                } else {
                    o[2 * 64] = (h16)(w1 * kkn); o[3 * 64] = (h16)(w1 * wr); o[4 * 64] = (h16)(dl1 + dl - dl1 * dl);
                    o[5 * 64] = (h16)(bb1 * w); o[6 * 64] = (h16)(kp1 * w); o[7 * 64] = (h16)bb; o[8 * 64] = (h16)kp; o[10 * 64] = (h16)v;
                    const float bk12 = wave_sum(bb1 * kkn), kk12 = wave_sum(kp1 * kkn), bz = wave_sum(bb1 * wr), kz = wave_sum(kp1 * wr);
                    if (lane == 0) { f32x4 sA, sB; sA[0] = br1; sA[1] = kr1; sA[2] = bk12; sA[3] = kk12; sB[0] = br; sB[1] = kr; sB[2] = bz; sB[3] = kz;
                        *(f32x4*)(RWS + (rec >> 1) * 8) = sA; *(f32x4*)(RWS + (rec >> 1) * 8 + 4) = sB; }
                }
            }
        }
        __syncthreads();
    }
}

__device__ __forceinline__ void tr_small(const float* __restrict__ src, u16* __restrict__ dst, int K) {
    const int tid = otid(); const int bidx = obid(), gdim = ogrid();
    for (int idx = bidx * 512 + tid; idx < 768 * K; idx += gdim * 512) { const int col = idx / K, k = idx - col * K; dst[idx] = f2bf(src[k * 768 + col]); }
}
typedef short bf16x8_t __attribute__((ext_vector_type(8)));
__device__ __forceinline__ void prep_rw2(const u16* __restrict__ Z1, const RwP P, const u16* __restrict__ W2T, const u16* __restrict__ A2T,
                                         h16* __restrict__ RWP, float* __restrict__ RWS, float* __restrict__ BON, u16* __restrict__ ZG, LAS unsigned char* lds) {
    const int tid = otid(), lane = tid & 63, wid = tid >> 6, fr = lane & 15, fq = lane >> 4; const int bidx = obid(), gdim = ogrid();
    constexpr int TT = 32, LST = 272;
    for (int tile = bidx; tile < MT / TT; tile += gdim) {
        const int m0 = tile * TT;
#pragma unroll
        for (int i = 0; i < 16; ++i) {
            const int idx = tid + 512 * i, tok = idx >> 8, cc = idx & 255, m = m0 + tok, c = 2304 + cc;
            const float zc = bf2f(Z1[(size_t)m * Z1_LD + c]);
            const float zp = ((m & (TS - 1)) == 0) ? 0.f : bf2f(Z1[(size_t)(m - 1) * Z1_LD + c]);
            const float zf = zc + P.mu[c] * (zp - zc);
            if (cc < 128) *(LAS u16*)(lds + tok * LST + cc * 2) = f2bf(cc < 64 ? tanh_(zf) : zf);
            else ZG[(size_t)m * 128 + (cc - 128)] = f2bf(sigm(zf));
        }
        __syncthreads();
        for (int wt = wid; wt < 24; wt += 8) {
            const int hh = wt % 12, half = wt / 12;
            const int mB = m0 + half * 16, b = mB >> 14, tB = mB & (TS - 1);
            const int j0 = hh * 64 + 4 * fr;
            f32x4 accW[4], accA[4];
#pragma unroll
            for (int n = 0; n < 4; ++n) { accW[n] = (f32x4){0.f, 0.f, 0.f, 0.f}; accA[n] = (f32x4){0.f, 0.f, 0.f, 0.f}; }
#pragma unroll
            for (int ks = 0; ks < 2; ++ks) {
                const bf16x8_t aw_ = *(const LAS bf16x8_t*)(lds + (half * 16 + fr) * LST + (ks * 32 + fq * 8) * 2);
                const bf16x8_t aa_ = *(const LAS bf16x8_t*)(lds + (half * 16 + fr) * LST + (64 + ks * 32 + fq * 8) * 2);
#pragma unroll
                for (int n = 0; n < 4; ++n) {
                    const bf16x8_t bw = *(const bf16x8_t*)(W2T + (size_t)(j0 + n) * 64 + ks * 32 + fq * 8);
                    const bf16x8_t ba = *(const bf16x8_t*)(A2T + (size_t)(j0 + n) * 64 + ks * 32 + fq * 8);
                    accW[n] = __builtin_amdgcn_mfma_f32_16x16x32_bf16(aw_, bw, accW[n], 0, 0, 0);
                    accA[n] = __builtin_amdgcn_mfma_f32_16x16x32_bf16(aa_, ba, accA[n], 0, 0, 0);
                }
            }
            const f32x4 w0v = *(const f32x4*)(P.w0 + j0), a0v = *(const f32x4*)(P.a0 + j0), mur = *(const f32x4*)(P.mu + j0), muk = *(const f32x4*)(P.mu + 768 + j0), muv = *(const f32x4*)(P.mu + 1536 + j0);
            const f32x4 kkc = *(const f32x4*)(P.kk + j0), kac = *(const f32x4*)(P.ka + j0), rkc = *(const f32x4*)(P.rk + j0);
            u32x2 zr[5], zk[5], zv[5];
#pragma unroll
            for (int q = 0; q < 5; ++q) {
                const int m = mB + 4 * fq + q - 1;
                if (q == 0 && ((m + 1) & (TS - 1)) == 0) { zr[0] = (u32x2){0u, 0u}; zk[0] = zr[0]; zv[0] = zr[0]; }
                else { const u16* zc = Z1 + (size_t)m * Z1_LD + j0; zr[q] = *(const u32x2*)zc; zk[q] = *(const u32x2*)(zc + 768); zv[q] = *(const u32x2*)(zc + 1536); }
            }
            f32x4 w1, dl1, bb1, kp1; float br1 = 0.f, kr1 = 0.f;
#pragma unroll
            for (int r = 0; r < 4; ++r) {
                const int t = tB + 4 * fq + r;
                const size_t rec = (size_t)(b * 12 + hh) * TS + t;
                f32x4 pr, pk, pv, cr, ck, cv;
                pr[0] = bflo(zr[r].x); pr[1] = bfhi(zr[r].x); pr[2] = bflo(zr[r].y); pr[3] = bfhi(zr[r].y);
                pk[0] = bflo(zk[r].x); pk[1] = bfhi(zk[r].x); pk[2] = bflo(zk[r].y); pk[3] = bfhi(zk[r].y);
                pv[0] = bflo(zv[r].x); pv[1] = bfhi(zv[r].x); pv[2] = bflo(zv[r].y); pv[3] = bfhi(zv[r].y);
                cr[0] = bflo(zr[r + 1].x); cr[1] = bfhi(zr[r + 1].x); cr[2] = bflo(zr[r + 1].y); cr[3] = bfhi(zr[r + 1].y);
                ck[0] = bflo(zk[r + 1].x); ck[1] = bfhi(zk[r + 1].x); ck[2] = bflo(zk[r + 1].y); ck[3] = bfhi(zk[r + 1].y);
                cv[0] = bflo(zv[r + 1].x); cv[1] = bfhi(zv[r + 1].x); cv[2] = bflo(zv[r + 1].y); cv[3] = bfhi(zv[r + 1].y);
                const f32x4 rr = cr + mur * (pr - cr), k = ck + muk * (pk - ck), v = cv + muv * (pv - cv);
                f32x4 w, dl, a, kq, kp;
                float ss = 0.f;
#pragma unroll
                for (int n = 0; n < 4; ++n) {
                    const float e = 0.6065306597f * sigm(accW[n][r] + w0v[n]);
                    w[n] = __expf(-e); dl[n] = 1.0f - w[n];
                    a[n] = sigm(accA[n][r] + a0v[n]);
                    kq[n] = k[n] * kkc[n]; ss += kq[n] * kq[n];
                    kp[n] = k[n] * (1.0f + (a[n] - 1.0f) * kac[n]);
                }
                ss = red16(ss);
                const float rn = rsqrtf(ss + 1e-12f);
                const f32x4 kkn = kq * rn, bb = kkn * a, wr = w * rr;
                float br = 0.f, kr = 0.f, bonus = 0.f;
#pragma unroll
                for (int n = 0; n < 4; ++n) { br += bb[n] * rr[n]; kr += kp[n] * rr[n]; bonus += rr[n] * kp[n] * rkc[n]; }
                br = red16(br); kr = red16(kr); bonus = red16(bonus);
                h16* o = RWP + (rec >> 1) * 768 + 4 * fr;
                if (fr == 0) BON[rec] = bonus;
#define ST4(slot, vec) do { h16x4 hv_; hv_[0] = (h16)(vec)[0]; hv_[1] = (h16)(vec)[1]; hv_[2] = (h16)(vec)[2]; hv_[3] = (h16)(vec)[3]; *(h16x4*)(o + (slot) * 64) = hv_; } while (0)
                if ((r & 1) == 0) {
                    ST4(0, kkn); ST4(1, wr); ST4(9, v);
                    w1 = w; dl1 = dl; bb1 = bb; kp1 = kp; br1 = br; kr1 = kr;
                } else {
                    const f32x4 x2 = w1 * kkn, z2 = w1 * wr, d12 = dl1 + dl - dl1 * dl, B1 = bb1 * w, K1 = kp1 * w;
                    ST4(2, x2); ST4(3, z2); ST4(4, d12); ST4(5, B1); ST4(6, K1); ST4(7, bb); ST4(8, kp); ST4(10, v);
                    float bk12 = 0.f, kk12 = 0.f, bz = 0.f, kz = 0.f;
#pragma unroll
                    for (int n = 0; n < 4; ++n) { bk12 += bb1[n] * kkn[n]; kk12 += kp1[n] * kkn[n]; bz += bb1[n] * wr[n]; kz += kp1[n] * wr[n]; }
                    bk12 = red16(bk12); kk12 = red16(kk12); bz = red16(bz); kz = red16(kz);
                    if (fr == 0) { f32x4 sA, sB; sA[0] = br1; sA[1] = kr1; sA[2] = bk12; sA[3] = kk12; sB[0] = br; sB[1] = kr; sB[2] = bz; sB[3] = kz;
                        *(f32x4*)(RWS + (rec >> 1) * 8) = sA; *(f32x4*)(RWS + (rec >> 1) * 8 + 4) = sB; }
                }
#undef ST4
            }
        }
        __syncthreads();
    }
}

__device__ __forceinline__ void prep_gd(const u16* __restrict__ Z2, const float* __restrict__ cw, const float* __restrict__ alog, const float* __restrict__ dtb,
                                        h16* __restrict__ GDP, float* __restrict__ GDS) {
    const int tid_ = otid(); const int lane = tid_ & 63, wid = tid_ >> 6; const int bidx = obid(), gdim = ogrid();
    for (int task = bidx * 8 + wid; task < 6 * (MT / 32); task += gdim * 8) {
        const int hh = task % 6, chunk = task / 6, m0 = chunk * 32, b = m0 >> 14, t0 = m0 & (TS - 1);
        const int cq = hh * 128 + 2 * lane;
        float w[3][4][2];
#pragma unroll
        for (int a = 0; a < 3; ++a)
#pragma unroll
            for (int i = 0; i < 4; ++i) { const f32x2 q = *(const f32x2*)(cw + i * 2304 + a * 768 + cq); w[a][i][0] = q[0]; w[a][i][1] = q[1]; }
        float x[3][3][2];
#pragma unroll
        for (int a = 0; a < 3; ++a)
#pragma unroll
            for (int d = 0; d < 3; ++d) {
                unsigned wv = 0u;
                if (t0 != 0) wv = *(const unsigned*)(Z2 + (size_t)(m0 - 3 + d) * Z2_LD + a * 768 + cq);
                x[a][d][0] = bflo(wv); x[a][d][1] = bfhi(wv);
            }
        const float An = -__expf(alog[hh]), dtbv = dtb[hh];
        float kprev0 = 0.f, kprev1 = 0.f, al1 = 0.f, be1 = 0.f, qk1 = 0.f;
        for (int s8 = 0; s8 < 32; s8 += 8) {
          unsigned ld[8][3]; u16 ldb[8], lda[8];
#pragma unroll
          for (int k = 0; k < 8; ++k) { const u16* zr = Z2 + (size_t)(m0 + s8 + k) * Z2_LD;
#pragma unroll
              for (int a = 0; a < 3; ++a) ld[k][a] = *(const unsigned*)(zr + a * 768 + cq);
              ldb[k] = zr[Z2_ZB + hh]; lda[k] = zr[Z2_ZA + hh]; }
#pragma unroll
          for (int k = 0; k < 8; ++k) {
            const int s = s8 + k;
            float y[3][2];
#pragma unroll
            for (int a = 0; a < 3; ++a) {
                const unsigned wv = ld[k][a];
                const float c0 = bflo(wv), c1 = bfhi(wv);
                const float s0 = x[a][0][0] * w[a][0][0] + x[a][1][0] * w[a][1][0] + x[a][2][0] * w[a][2][0] + c0 * w[a][3][0];
                const float s1 = x[a][0][1] * w[a][0][1] + x[a][1][1] * w[a][1][1] + x[a][2][1] * w[a][2][1] + c1 * w[a][3][1];
                x[a][0][0] = x[a][1][0]; x[a][1][0] = x[a][2][0]; x[a][2][0] = c0;
                x[a][0][1] = x[a][1][1]; x[a][1][1] = x[a][2][1]; x[a][2][1] = c1;
                y[a][0] = s0 * sigm(s0); y[a][1] = s1 * sigm(s1);
            }
            const float sq = wave_sum(y[0][0] * y[0][0] + y[0][1] * y[0][1]);
            const float sk = wave_sum(y[1][0] * y[1][0] + y[1][1] * y[1][1]);
            const float rq = rsqrtf(sq + 1e-12f) * 0.08838834764831845f, rk = rsqrtf(sk + 1e-12f);
            const float q0 = y[0][0] * rq, q1 = y[0][1] * rq, k0 = y[1][0] * rk, k1 = y[1][1] * rk;
            const float qk = wave_sum(q0 * k0 + q1 * k1);
            const size_t rec = (size_t)(b * 6 + hh) * TS + (t0 + s);
            h16* o = GDP + rec * 384 + 2 * lane;
            h16x2 kv; kv[0] = (h16)k0; kv[1] = (h16)k1; *(h16x2*)(o) = kv;
            h16x2 qv; qv[0] = (h16)q0; qv[1] = (h16)q1; *(h16x2*)(o + 128) = qv;
            h16x2 vv; vv[0] = (h16)y[2][0]; vv[1] = (h16)y[2][1]; *(h16x2*)(o + 256) = vv;
            const float beta = sigm(bf2f(ldb[k]));
            const float alpha = __expf(An * softplus_(bf2f(lda[k]) + dtbv));
            if ((k & 1) == 0) { kprev0 = k0; kprev1 = k1; al1 = alpha; be1 = beta; qk1 = qk; }
            else {
                const float k12 = wave_sum(kprev0 * k0 + kprev1 * k1), kq12 = wave_sum(kprev0 * q0 + kprev1 * q1);
                if (lane == 0) { f32x4 sA, sB; sA[0] = al1; sA[1] = be1; sA[2] = qk1; sA[3] = k12; sB[0] = alpha; sB[1] = beta; sB[2] = qk; sB[3] = kq12;
                    *(f32x4*)(GDS + (rec - 1) * 4) = sA; *(f32x4*)(GDS + rec * 4) = sB; }
            }
          }
        }
    }
}

struct LrP { const float *cw, *cb, *wa, *ba, *wx, *bx, *lam; };
__device__ __forceinline__ void tr_blocks(const float* __restrict__ src, u16* __restrict__ dst) {
    const int tid = otid(); const int bidx = obid(), gdim = ogrid();
    for (int idx = bidx * 512 + tid; idx < 8 * 64 * 64; idx += gdim * 512) { const int n = idx >> 12, d = (idx >> 6) & 63, c = idx & 63; dst[idx] = f2bf(src[(n * 64 + c) * 64 + d]); }
}
__device__ __forceinline__ void prep_lr2(const u16* __restrict__ Z2, const LrP P, const u16* __restrict__ WAT, const u16* __restrict__ WXT, u16* __restrict__ LRA, u16* __restrict__ LRUb, LAS unsigned char* lds) {
    const int tid_ = otid(); const int lane = tid_ & 63, wid = tid_ >> 6, fr = lane & 15, fq = lane >> 4; const int bidx = obid(), gdim = ogrid();
    LAS unsigned char* Lx = lds + wid * 10240;
    LAS float* La = (LAS float*)(Lx + 2048);
    LAS float* Lb = La + 1024;
    for (int task = bidx * 8 + wid; task < 8 * (MT / 64); task += gdim * 8) {
        const int n = task & 7, chunk = task >> 3, m0 = chunk * 64, t0 = m0 & (TS - 1);
        const int ch = n * 64 + lane;
        bf16x8_t bwa[4][2], bwx[4][2];
#pragma unroll
        for (int nt = 0; nt < 4; ++nt)
#pragma unroll
            for (int ks = 0; ks < 2; ++ks) { const size_t o = (size_t)(n * 64 + nt * 16 + fr) * 64 + ks * 32 + fq * 8; bwa[nt][ks] = *(const bf16x8_t*)(WAT + o); bwx[nt][ks] = *(const bf16x8_t*)(WXT + o); }
        const float c0 = P.cw[ch], c1 = P.cw[512 + ch], c2 = P.cw[1024 + ch], c3 = P.cw[1536 + ch], cb = P.cb[ch];
        const float ba = P.ba[ch], bx = P.bx[ch];
        const float spl = -8.0f * softplus_(-P.lam[ch]);
        float x0 = 0.f, x1 = 0.f, x2 = 0.f, hl = 0.f, pc = 1.f;
        if (t0 != 0) { x0 = bf2f(Z2[(size_t)(m0 - 3) * Z2_LD + Z2_XL + ch]); x1 = bf2f(Z2[(size_t)(m0 - 2) * Z2_LD + Z2_XL + ch]); x2 = bf2f(Z2[(size_t)(m0 - 1) * Z2_LD + Z2_XL + ch]); }
        for (int s16 = 0; s16 < 64; s16 += 16) {
            u16 ldx[16];
#pragma unroll
            for (int k = 0; k < 16; ++k) ldx[k] = Z2[(size_t)(m0 + s16 + k) * Z2_LD + Z2_XL + ch];
            float xc[16];
#pragma unroll
            for (int k = 0; k < 16; ++k) {
                const float xin = bf2f(ldx[k]);
                xc[k] = x0 * c0 + x1 * c1 + x2 * c2 + xin * c3 + cb;
                x0 = x1; x1 = x2; x2 = xin;
                *(LAS u16*)(Lx + (k * 64 + lane) * 2) = f2bf(xc[k]);
            }
            f32x4 aA[4], aX[4];
#pragma unroll
            for (int nt = 0; nt < 4; ++nt) { aA[nt] = (f32x4){0.f, 0.f, 0.f, 0.f}; aX[nt] = (f32x4){0.f, 0.f, 0.f, 0.f}; }
#pragma unroll
            for (int ks = 0; ks < 2; ++ks) {
                const bf16x8_t af = *(const LAS bf16x8_t*)(Lx + (fr * 64 + ks * 32 + fq * 8) * 2);
#pragma unroll
                for (int nt = 0; nt < 4; ++nt) { aA[nt] = __builtin_amdgcn_mfma_f32_16x16x32_bf16(af, bwa[nt][ks], aA[nt], 0, 0, 0); aX[nt] = __builtin_amdgcn_mfma_f32_16x16x32_bf16(af, bwx[nt][ks], aX[nt], 0, 0, 0); }
            }
#pragma unroll
            for (int nt = 0; nt < 4; ++nt)
#pragma unroll
                for (int r = 0; r < 4; ++r) { La[(4 * fq + r) * 64 + nt * 16 + fr] = aA[nt][r]; Lb[(4 * fq + r) * 64 + nt * 16 + fr] = aX[nt][r]; }
#pragma unroll
            for (int k = 0; k < 16; ++k) {
                const int m = m0 + s16 + k;
                const float r = sigm(La[k * 64 + lane] + ba), ig = sigm(Lb[k * 64 + lane] + bx);
                const float la = spl * r;
                const float a = __expf(la);
                const float u = __builtin_amdgcn_sqrtf(1.0f - __expf(2.0f * la)) * (ig * xc[k]);
                hl = a * hl + u; pc *= a;
                LRA[(size_t)m * 512 + ch] = f2bf(pc); LRUb[(size_t)m * 512 + ch] = f2bf(hl);
            }
        }
    }
}

constexpr int RC = 32;
constexpr int RPB = 3072;
constexpr int RBUF = (RC / 2) * RPB + (RC / 2) * 32;
__device__ __forceinline__ f32x2 lo2(f32x4 v) { f32x2 r; r[0] = v[0]; r[1] = v[1]; return r; }
__device__ __forceinline__ f32x2 hi2(f32x4 v) { f32x2 r; r[0] = v[2]; r[1] = v[3]; return r; }
__device__ __forceinline__ float dot4(f32x2 sa, f32x2 sb, f32x4 v) { f32x2 t = sa * lo2(v); t = sb * hi2(v) + t; return t[0] + t[1]; }
__device__ __forceinline__ float dot8(const f32x2 (&S)[4], f32x4 va, f32x4 vb) { f32x2 t = S[0] * lo2(va); t = S[1] * hi2(va) + t; t = S[2] * lo2(vb) + t; t = S[3] * hi2(vb) + t; return t[0] + t[1]; }
template <int KIND> __device__ __forceinline__ void rec_block(const unsigned char* __restrict__ gp, const unsigned char* __restrict__ gs, u16* __restrict__ outp  ,
                                                             int rowl0  , LAS unsigned char* lds) {
    const int tid = otid(), lane = tid & 63, wid = tid >> 6, g = lane >> 4, j = lane & 15;
    const int cw = wid & 3; const bool is_ld = wid >= 4;
    const int rowl = rowl0 + cw * 4 + g;
    const int lt = cw * 64 + lane;
    constexpr int NCH = TS / RC;
    constexpr int CB = (RC / 2) * 1536;
    u32x4 st[6]; u32x4 ss0, ss1;
#define LD_ISSUE(c) do { const unsigned char* np = gp + (size_t)(c) * CB; const unsigned char* ns = gs + (size_t)(c) * (RC * 16); \
        _Pragma("unroll") for (int i = 0; i < 6; ++i) st[i] = *(const u32x4*)(np + (size_t)(lt + 256 * i) * 16); \
        if (lt < 32) ss0 = *(const u32x4*)(ns + lt * 16); } while (0)
#define LD_COMMIT(buf) do { LAS unsigned char* Bn = lds + 4096 + (buf) * RBUF; \
        _Pragma("unroll") for (int i = 0; i < 6; ++i) { const int q = lt + 256 * i, slot = (q % 96) >> 3; \
            const u32x4 w = st[i]; f32x4 a, b; \
            { const unsigned w0 = w[0], w1 = w[1], w2 = w[2], w3 = w[3]; const h16x2 h0 = __builtin_bit_cast(h16x2, w0), h1 = __builtin_bit_cast(h16x2, w1), h2 = __builtin_bit_cast(h16x2, w2), h3 = __builtin_bit_cast(h16x2, w3); \
              a[0] = (float)h0[0]; a[1] = (float)h0[1]; a[2] = (float)h1[0]; a[3] = (float)h1[1]; b[0] = (float)h2[0]; b[1] = (float)h2[1]; b[2] = (float)h3[0]; b[3] = (float)h3[1]; } \
            if (KIND == 0 && slot == 4) { a = 1.0f - a; b = 1.0f - b; } \
            *(LAS f32x4*)(Bn + q * 32) = a; *(LAS f32x4*)(Bn + q * 32 + 16) = b; } \
        if (lt < 32) *(LAS u32x4*)(Bn + (RC / 2) * RPB + lt * 16) = ss0; } while (0)
#define Y_OUT(c) do { const LAS float* yb = (const LAS float*)(lds + ((c) & 1) * 2048); const int stp = lt >> 3, rp = (lt & 7) * 2; \
        const f32x2 yv = *(const LAS f32x2*)(yb + stp * 16 + rp); *(unsigned*)(outp + ((size_t)(c) * RC + stp) * DM + rp) = pk_bf(yv[0], yv[1]); } while (0)
    if (is_ld) { LD_ISSUE(0); LD_COMMIT(0); LD_ISSUE(1); }
    __syncthreads();
    f32x2 Sv[4];
#pragma unroll
    for (int i = 0; i < 4; ++i) { Sv[i][0] = 0.f; Sv[i][1] = 0.f; }
    for (int c = 0; c < NCH; ++c) {
        if (is_ld) {
            if (c + 1 < NCH) { LD_COMMIT((c + 1) & 1); if (c + 2 < NCH) LD_ISSUE(c + 2); }
            if (c > 0) Y_OUT(c - 1);
        } else {
            const LAS unsigned char* B = lds + 4096 + (c & 1) * RBUF;
            const LAS unsigned char* Sc = B + (RC / 2) * RPB;
            LAS float* yw = (LAS float*)(lds + (c & 1) * 2048) + (cw * 4 + g);
            if (KIND == 0) {
                f32x4 n_kk, n_wr, n_x2, n_z2, n_W, n_B1, n_K1, n_b2, n_kp2, n_sA, n_sB; float n_v1, n_v2;
#define RW_LD(p) do { const LAS unsigned char* Pp = B + (p) * RPB + j * 16; \
                    n_kk = *(const LAS f32x4*)(Pp); n_wr = *(const LAS f32x4*)(Pp + 256); n_x2 = *(const LAS f32x4*)(Pp + 512); n_z2 = *(const LAS f32x4*)(Pp + 768); \
                    n_W = *(const LAS f32x4*)(Pp + 1024); n_B1 = *(const LAS f32x4*)(Pp + 1280); n_K1 = *(const LAS f32x4*)(Pp + 1536); n_b2 = *(const LAS f32x4*)(Pp + 1792); n_kp2 = *(const LAS f32x4*)(Pp + 2048); \
                    n_v1 = *(const LAS float*)(B + (p) * RPB + 2304 + rowl * 4); n_v2 = *(const LAS float*)(B + (p) * RPB + 2560 + rowl * 4); \
                    n_sA = *(const LAS f32x4*)(Sc + (p) * 32); n_sB = *(const LAS f32x4*)(Sc + (p) * 32 + 16); } while (0)
                RW_LD(0);
#pragma unroll 16
                for (int p = 0; p < RC / 2; ++p) {
                    const f32x4 kk = n_kk, wr = n_wr, x2 = n_x2, z2 = n_z2, W = n_W, B1 = n_B1, K1 = n_K1, b2 = n_b2, kp2 = n_kp2, sA = n_sA, sB = n_sB; const float v1 = n_v1, v2 = n_v2;
                    { const int pn = (p + 1 < RC / 2) ? p + 1 : p; RW_LD(pn); }
                    float d0 = dot4(Sv[0], Sv[1], kk), d1 = dot4(Sv[0], Sv[1], wr), d2 = dot4(Sv[0], Sv[1], x2), d3 = dot4(Sv[0], Sv[1], z2);
                    d0 = red16(d0); d1 = red16(d1); d2 = red16(d2); d3 = red16(d3);
                    const float sa1 = d0;
                    const float y1 = d1 - sa1 * sA[0] + v1 * sA[1];
                    const float sa2 = d2 - sa1 * sA[2] + v1 * sA[3];
                    const float y2 = (d3 - sa1 * sB[2] + v1 * sB[3]) - sa2 * sB[0] + v2 * sB[1];
                    yw[(2 * p) * 16] = y1; yw[(2 * p + 1) * 16] = y2;
                    const float n1 = -sa1, n2 = -sa2;
                    Sv[0] = lo2(b2) * n2 + (lo2(kp2) * v2 + (lo2(B1) * n1 + (lo2(K1) * v1 + Sv[0] * lo2(W))));
                    Sv[1] = hi2(b2) * n2 + (hi2(kp2) * v2 + (hi2(B1) * n1 + (hi2(K1) * v1 + Sv[1] * hi2(W))));
                }
            } else {
                f32x4 n_k1a, n_k1b, n_q1a, n_q1b, n_k2a, n_k2b, n_q2a, n_q2b, n_sA, n_sB; float n_v1, n_v2;
#define GD_LD(p) do { const LAS unsigned char* Pp = B + (p) * RPB + j * 32; \
                    n_k1a = *(const LAS f32x4*)(Pp); n_k1b = *(const LAS f32x4*)(Pp + 16); n_q1a = *(const LAS f32x4*)(Pp + 512); n_q1b = *(const LAS f32x4*)(Pp + 528); \
                    n_k2a = *(const LAS f32x4*)(Pp + 1536); n_k2b = *(const LAS f32x4*)(Pp + 1552); n_q2a = *(const LAS f32x4*)(Pp + 2048); n_q2b = *(const LAS f32x4*)(Pp + 2064); \
                    n_v1 = *(const LAS float*)(B + (p) * RPB + 1024 + rowl * 4); n_v2 = *(const LAS float*)(B + (p) * RPB + 2560 + rowl * 4); \
                    n_sA = *(const LAS f32x4*)(Sc + (p) * 32); n_sB = *(const LAS f32x4*)(Sc + (p) * 32 + 16); } while (0)
                GD_LD(0);
#pragma unroll 16
                for (int p = 0; p < RC / 2; ++p) {
                    const f32x4 k1a = n_k1a, k1b = n_k1b, q1a = n_q1a, q1b = n_q1b, k2a = n_k2a, k2b = n_k2b, q2a = n_q2a, q2b = n_q2b, sA = n_sA, sB = n_sB; const float v1 = n_v1, v2 = n_v2;
                    { const int pn = (p + 1 < RC / 2) ? p + 1 : p; GD_LD(pn); }
                    float a1 = dot8(Sv, k1a, k1b), c1 = dot8(Sv, q1a, q1b), a2 = dot8(Sv, k2a, k2b), c2 = dot8(Sv, q2a, q2b);
                    a1 = red16(a1); c1 = red16(c1); a2 = red16(a2); c2 = red16(c2);
                    const float al1 = sA[0], al2 = sB[0];
                    const float vn1 = sA[1] * (v1 - al1 * a1);
                    const float o1 = al1 * c1 + sA[2] * vn1;
                    const float vn2 = sB[1] * (v2 - al2 * (al1 * a2 + sA[3] * vn1));
                    const float o2 = al2 * (al1 * c2 + sB[3] * vn1) + sB[2] * vn2;
                    yw[(2 * p) * 16] = o1; yw[(2 * p + 1) * 16] = o2;
                    const float cS = al1 * al2, w1 = al2 * vn1;
                    Sv[0] = lo2(k2a) * vn2 + (lo2(k1a) * w1 + Sv[0] * cS);
                    Sv[1] = hi2(k2a) * vn2 + (hi2(k1a) * w1 + Sv[1] * cS);
                    Sv[2] = lo2(k2b) * vn2 + (lo2(k1b) * w1 + Sv[2] * cS);
                    Sv[3] = hi2(k2b) * vn2 + (hi2(k1b) * w1 + Sv[3] * cS);
                }
            }
        }
        __syncthreads();
    }
    if (is_ld) Y_OUT(NCH - 1);
#undef LD_ISSUE
#undef LD_COMMIT
#undef Y_OUT
}
__device__ __forceinline__ void lru_carry(int grp  , const u16* __restrict__ LRA, const u16* __restrict__ LRUb, float* __restrict__ HIN) {
    const int lane = otid() & 63;
    const int b = grp >> 3, ch = (grp & 7) * 64 + lane;
    float h = 0.f;
    for (int c = 0; c < TS / 64; c += 8) {
        float a[8], u[8];
#pragma unroll
        for (int k = 0; k < 8; ++k) { const size_t m = (size_t)b * TS + (c + k) * 64 + 63; a[k] = bf2f(LRA[m * 512 + ch]); u[k] = bf2f(LRUb[m * 512 + ch]); }
#pragma unroll
        for (int k = 0; k < 8; ++k) { HIN[((size_t)b * 256 + c + k) * 512 + ch] = h; h = a[k] * h + u[k]; }
    }
}
__device__ __forceinline__ void post_lr(u16* __restrict__ MIX, const u16* __restrict__ Z2, const u16* __restrict__ LRA, const u16* __restrict__ LRUb, const float* __restrict__ HIN, int bsub = 0, int gsub = 0) {
    const int tid = otid(); const int bidx = gsub ? bsub : obid(), gdim = gsub ? gsub : ogrid();
    for (int it = bidx * 512 + tid; it < MT * 128; it += gdim * 512) {
        const int m = it >> 7, c4 = (it & 127) * 4, b = m >> 14, chunk = (m & (TS - 1)) >> 6;
        const u32x2 pw = *(const u32x2*)(LRA + (size_t)m * 512 + c4), hw = *(const u32x2*)(LRUb + (size_t)m * 512 + c4); const f32x4 hin = *(const f32x4*)(HIN + ((size_t)b * 256 + chunk) * 512 + c4);
        f32x4 pc, hl; pc[0] = bflo(pw.x); pc[1] = bfhi(pw.x); pc[2] = bflo(pw.y); pc[3] = bfhi(pw.y); hl[0] = bflo(hw.x); hl[1] = bfhi(hw.x); hl[2] = bflo(hw.y); hl[3] = bfhi(hw.y);
        const u32x2 yw = *(const u32x2*)(Z2 + (size_t)m * Z2_LD + Z2_YL + c4);
        const f32x4 h = hl + pc * hin;
        u32x2 o; o.x = pk_bf(h[0] * gelu_tanh(bflo(yw.x)), h[1] * gelu_tanh(bfhi(yw.x))); o.y = pk_bf(h[2] * gelu_tanh(bflo(yw.y)), h[3] * gelu_tanh(bfhi(yw.y)));
        *(u32x2*)(MIX + (size_t)m * DM + 1536 + c4) = o;
    }
}

__device__ __forceinline__ void post_rw(u16* __restrict__ MIX, const h16* __restrict__ RWP, const float* __restrict__ BON, const u16* __restrict__ ZG,
                                        const float* __restrict__ g2, const float* __restrict__ lng, const float* __restrict__ lnb) {
    const int tid_ = otid(); const int lane = tid_ & 63, wid = tid_ >> 6; const int bidx = obid(), gdim = ogrid();
    for (int task = bidx * 8 + wid; task < 12 * (MT / 64); task += gdim * 8) {
        const int hh = task % 12, chunk = task / 12, m0 = chunk * 64, b = m0 >> 14, t0 = m0 & (TS - 1);
        const int col = hh * 64 + lane;
        float gc[128];
#pragma unroll
        for (int i = 0; i < 128; ++i) gc[i] = g2[i * 768 + col];
        const float lg = lng[col], lb = lnb[col];
        for (int s4 = 0; s4 < 64; s4 += 4) {
          u16 ly[4]; h16 lv[4]; float lbon[4]; unsigned lsw[4];
#pragma unroll
          for (int k = 0; k < 4; ++k) { const int m = m0 + s4 + k; const size_t rec = (size_t)(b * 12 + hh) * TS + (t0 + s4 + k);
              ly[k] = MIX[(size_t)m * DM + col]; lv[k] = RWP[(rec >> 1) * 768 + (9 + (int)(rec & 1)) * 64 + lane]; lbon[k] = BON[rec]; lsw[k] = *(const unsigned*)(ZG + (size_t)m * 128 + 2 * lane); }
#pragma unroll
          for (int k = 0; k < 4; ++k) {
            const int m = m0 + s4 + k;
            const float y = bf2f(ly[k]);
            const float mean = wave_sum(y) * (1.0f / 64.0f);
            const float d = y - mean;
            const float var = wave_sum(d * d) * (1.0f / 64.0f);
            const float yn = d * rsqrtf(var + 64e-5f) * lg + lb;
            const float v = (float)lv[k];
            const float bonus = lbon[k];
            const unsigned sw = lsw[k];
            const float s0 = bflo(sw), s1 = bfhi(sw);
            float ga = 0.f, gb = 0.f;
#pragma unroll
            for (int i = 0; i < 64; ++i) { ga += rlane(s0, i) * gc[2 * i]; gb += rlane(s1, i) * gc[2 * i + 1]; }
            MIX[(size_t)m * DM + col] = f2bf((yn + bonus * v) * (ga + gb));
          }
        }
    }
}
__device__ __forceinline__ void post_rw2(u16* __restrict__ MIX, const h16* __restrict__ RWP, const float* __restrict__ BON, const u16* __restrict__ ZG,
                                         const u16* __restrict__ G2T, const float* __restrict__ lng, const float* __restrict__ lnb) {
    const int tid_ = otid(); const int lane = tid_ & 63, wid = tid_ >> 6, fr = lane & 15, fq = lane >> 4; const int bidx = obid(), gdim = ogrid();
    for (int task = bidx * 8 + wid; task < 12 * (MT / 16); task += gdim * 8) {
        const int hh = task % 12, chunk = task / 12, mB = chunk * 16, b = mB >> 14, tB = mB & (TS - 1);
        const int j0 = hh * 64 + 4 * fr;
        u32x2 yw[4]; h16x4 vv[4]; float bon[4];
#pragma unroll
        for (int r = 0; r < 4; ++r) { const int m = mB + 4 * fq + r; const size_t rec = (size_t)(b * 12 + hh) * TS + (tB + 4 * fq + r);
            yw[r] = *(const u32x2*)(MIX + (size_t)m * DM + j0); vv[r] = *(const h16x4*)(RWP + (rec >> 1) * 768 + (9 + (int)(rec & 1)) * 64 + 4 * fr); bon[r] = BON[rec]; }
        const f32x4 lg = *(const f32x4*)(lng + j0), lb = *(const f32x4*)(lnb + j0);
        f32x4 acc[4];
#pragma unroll
        for (int n = 0; n < 4; ++n) acc[n] = (f32x4){0.f, 0.f, 0.f, 0.f};
#pragma unroll
        for (int ks = 0; ks < 4; ++ks) {
            const bf16x8_t a_ = *(const bf16x8_t*)(ZG + (size_t)(mB + fr) * 128 + ks * 32 + fq * 8);
#pragma unroll
            for (int n = 0; n < 4; ++n) { const bf16x8_t b_ = *(const bf16x8_t*)(G2T + (size_t)(j0 + n) * 128 + ks * 32 + fq * 8);
                acc[n] = __builtin_amdgcn_mfma_f32_16x16x32_bf16(a_, b_, acc[n], 0, 0, 0); }
        }
#pragma unroll
        for (int r = 0; r < 4; ++r) {
            const int m = mB + 4 * fq + r;
            f32x4 y; y[0] = bflo(yw[r].x); y[1] = bfhi(yw[r].x); y[2] = bflo(yw[r].y); y[3] = bfhi(yw[r].y);
            const float mean = red16((y[0] + y[1]) + (y[2] + y[3])) * (1.0f / 64.0f);
            const f32x4 d = y - mean;
            const float var = red16((d[0] * d[0] + d[1] * d[1]) + (d[2] * d[2] + d[3] * d[3])) * (1.0f / 64.0f);
            const float rs = rsqrtf(var + 64e-5f);
            f32x4 o;
#pragma unroll
            for (int n = 0; n < 4; ++n) o[n] = (d[n] * rs * lg[n] + lb[n] + bon[r] * (float)vv[r][n]) * acc[n][r];
            u32x2 w; w.x = pk_bf(o[0], o[1]); w.y = pk_bf(o[2], o[3]);
            *(u32x2*)(MIX + (size_t)m * DM + j0) = w;
        }
    }
}
__device__ __forceinline__ void post_rw_head(u16* __restrict__ MIX, const h16* __restrict__ RWP, const float* __restrict__ BON, const u16* __restrict__ ZG,
                                             const u16* __restrict__ G2T, const float* __restrict__ lng, const float* __restrict__ lnb, int b, int hh, int chunk0, int nchunk) {
    const int tid_ = otid(); const int lane = tid_ & 63, wid = tid_ >> 6, fr = lane & 15, fq = lane >> 4;
    const int j0 = hh * 64 + 4 * fr;
    bf16x8_t bg[4][4];
#pragma unroll
    for (int ks = 0; ks < 4; ++ks)
#pragma unroll
        for (int n = 0; n < 4; ++n) bg[ks][n] = *(const bf16x8_t*)(G2T + (size_t)(j0 + n) * 128 + ks * 32 + fq * 8);
    const f32x4 lg = *(const f32x4*)(lng + j0), lb = *(const f32x4*)(lnb + j0);
    for (int ci = wid; ci < nchunk; ci += 8) {
        const int tB = (chunk0 + ci) * 16, mB = b * TS + tB;
        u32x2 yw[4]; h16x4 vv[4]; float bon[4];
#pragma unroll
        for (int r = 0; r < 4; ++r) { const int m = mB + 4 * fq + r; const size_t rec = (size_t)(b * 12 + hh) * TS + (tB + 4 * fq + r);
            yw[r] = *(const u32x2*)(MIX + (size_t)m * DM + j0); vv[r] = *(const h16x4*)(RWP + (rec >> 1) * 768 + (9 + (int)(rec & 1)) * 64 + 4 * fr); bon[r] = BON[rec]; }
        f32x4 acc[4];
#pragma unroll
        for (int n = 0; n < 4; ++n) acc[n] = (f32x4){0.f, 0.f, 0.f, 0.f};
#pragma unroll
        for (int ks = 0; ks < 4; ++ks) {
            const bf16x8_t a_ = *(const bf16x8_t*)(ZG + (size_t)(mB + fr) * 128 + ks * 32 + fq * 8);
#pragma unroll
            for (int n = 0; n < 4; ++n) acc[n] = __builtin_amdgcn_mfma_f32_16x16x32_bf16(a_, bg[ks][n], acc[n], 0, 0, 0);
        }
#pragma unroll
        for (int r = 0; r < 4; ++r) {
            const int m = mB + 4 * fq + r;
            f32x4 y; y[0] = bflo(yw[r].x); y[1] = bfhi(yw[r].x); y[2] = bflo(yw[r].y); y[3] = bfhi(yw[r].y);
            const float mean = red16((y[0] + y[1]) + (y[2] + y[3])) * (1.0f / 64.0f);
            const f32x4 d = y - mean;
            const float var = red16((d[0] * d[0] + d[1] * d[1]) + (d[2] * d[2] + d[3] * d[3])) * (1.0f / 64.0f);
            const float rs = rsqrtf(var + 64e-5f);
            f32x4 o;
#pragma unroll
            for (int n = 0; n < 4; ++n) o[n] = (d[n] * rs * lg[n] + lb[n] + bon[r] * (float)vv[r][n]) * acc[n][r];
            u32x2 w; w.x = pk_bf(o[0], o[1]); w.y = pk_bf(o[2], o[3]);
            *(u32x2*)(MIX + (size_t)m * DM + j0) = w;
        }
    }
}
__device__ __forceinline__ void post_gd(u16* __restrict__ MIX, const u16* __restrict__ Z2, const float* __restrict__ ng) {
    const int tid_ = otid(); const int lane = tid_ & 63, wid = tid_ >> 6; const int bidx = obid(), gdim = ogrid();
    for (int task = bidx * 8 + wid; task < 6 * (MT / 32); task += gdim * 8) {
        const int hh = task % 6, chunk = task / 6, m0 = chunk * 32;
        const float n0 = ng[2 * lane], n1 = ng[2 * lane + 1];
        for (int s8 = 0; s8 < 32; s8 += 8) {
          unsigned lo[8], lg[8];
#pragma unroll
          for (int k = 0; k < 8; ++k) { const int m = m0 + s8 + k; lo[k] = *(const unsigned*)(MIX + (size_t)m * DM + 768 + hh * 128 + 2 * lane); lg[k] = *(const unsigned*)(Z2 + (size_t)m * Z2_LD + Z2_GATE + hh * 128 + 2 * lane); }
#pragma unroll
          for (int k = 0; k < 8; ++k) {
            const int m = m0 + s8 + k;
            unsigned* op = (unsigned*)(MIX + (size_t)m * DM + 768 + hh * 128 + 2 * lane);
            const unsigned ow = lo[k];
            const float o0 = bflo(ow), o1 = bfhi(ow);
            const float ss = wave_sum(o0 * o0 + o1 * o1);
            const float rs = rsqrtf(ss * (1.0f / 128.0f) + 1e-6f);
            const unsigned gw = lg[k];
            const float g0 = bflo(gw), g1 = bfhi(gw);
            *op = pk_bf(o0 * rs * n0 * (g0 * sigm(g0)), o1 * rs * n1 * (g1 * sigm(g1)));
          }
        }
    }
}

#define XB_TMO      128
#define XB_XCNT(j)  (256  + 64 * (j))
#define XB_XSUB(j)  (1280 + 64 * (j))
#define XB_XGEN(j)  (2304 + 64 * (j))
#define XB_TOP      3328
#define XB_TOPGEN   3392
#define XCD_BAR_WORDS 3456
#define XB_SPIN_CAP (1u << 18)

__device__ __forceinline__ unsigned xb_ld(unsigned* p)              { return __hip_atomic_load(p, __ATOMIC_RELAXED, __HIP_MEMORY_SCOPE_AGENT); }
__device__ __forceinline__ unsigned xb_add(unsigned* p, unsigned v) { return __hip_atomic_fetch_add(p, v, __ATOMIC_RELAXED, __HIP_MEMORY_SCOPE_AGENT); }
__device__ __forceinline__ unsigned xb_xcc_id() { return (unsigned)__builtin_amdgcn_s_getreg((3 << 11) | 20) & 0xFu; }
#define XB_SPIN(cond, bar) do { unsigned _sp = 0; while (cond) { __builtin_amdgcn_s_sleep(1); \
    if ((++_sp & 255u) == 0u) { if (xb_ld(&(bar)[XB_TMO])) break; if (_sp > XB_SPIN_CAP) { atomicAdd(&(bar)[XB_TMO], 1u); break; } } } } while (0)

struct XcdBarrier {
    unsigned* bar; unsigned x;
    volatile LAS unsigned* st;
};

__device__ __forceinline__ XcdBarrier xcd_barrier_post(unsigned* bar, volatile LAS unsigned* st) {
    XcdBarrier b; b.bar = bar; b.x = xb_xcc_id(); b.st = st;
    if (threadIdx.x == 0) (void)xb_add(&bar[XB_XCNT(b.x)], 1u);
    return b;
}
__device__ __forceinline__ void xcd_barrier_complete(unsigned* bar, unsigned x, unsigned& nloc, unsigned& nx) {
    const unsigned G = gridDim.x * gridDim.y * gridDim.z;
    unsigned sum, cnt, mine, sp = 0u;
    for (;;) {
        sum = 0u; cnt = 0u; mine = 0u;
#pragma unroll
        for (unsigned j = 0; j < 16; ++j) { const unsigned c = xb_ld(&bar[XB_XCNT(j)]); sum += c; cnt += (c > 0u) ? 1u : 0u; mine = (j == x) ? c : mine; }
        if (sum == G) break;
        __builtin_amdgcn_s_sleep(1);
        if ((++sp & 255u) == 0u) { if (xb_ld(&bar[XB_TMO])) break; if (sp > XB_SPIN_CAP) { atomicAdd(&bar[XB_TMO], 1u); break; } }
    }
    nloc = mine > 0u ? mine : 1u; nx = cnt > 0u ? cnt : 1u;
}

__device__ __forceinline__ void xcd_barrier(const XcdBarrier& b) {
    asm volatile("s_waitcnt vmcnt(0)" ::: "memory");
    __syncthreads();
    if (threadIdx.x == 0) {
        unsigned* bar = b.bar;
        __builtin_amdgcn_s_waitcnt(0);
        unsigned nloc = b.st[0], nx = b.st[1];
        if (nloc == 0u) { xcd_barrier_complete(bar, b.x, nloc, nx); b.st[0] = nloc; b.st[1] = nx; }
        const unsigned old = xb_add(&bar[XB_XSUB(b.x)], 1u);
        const unsigned gen = old / nloc;
        if (old + 1u == (gen + 1u) * nloc) {
            __builtin_amdgcn_fence(__ATOMIC_RELEASE, "agent");
            asm volatile("s_waitcnt vmcnt(0)" ::: "memory");
            const unsigned og = xb_add(&bar[XB_TOP], 1u);
            const unsigned tg = og / nx;
            if (og + 1u == (tg + 1u) * nx) xb_add(&bar[XB_TOPGEN], 1u);
            else XB_SPIN(xb_ld(&bar[XB_TOPGEN]) == tg, bar);
            __builtin_amdgcn_fence(__ATOMIC_ACQUIRE, "agent");
            xb_add(&bar[XB_XGEN(b.x)], 1u);
            asm volatile("s_waitcnt vmcnt(0)" ::: "memory");
        } else {
            XB_SPIN(xb_ld(&bar[XB_XGEN(b.x)]) == gen, bar);
            __builtin_amdgcn_fence(__ATOMIC_ACQUIRE, "agent");
            asm volatile("s_waitcnt vmcnt(0)" ::: "memory");
        }
    }
    __syncthreads();
}
__device__ __forceinline__ const float* getp(const LAS unsigned* TAB, int k) {
    const unsigned lo = __builtin_amdgcn_readfirstlane(TAB[2 * k]), hi = __builtin_amdgcn_readfirstlane(TAB[2 * k + 1]);
    return (const float*)(((unsigned long long)hi << 32) | lo);
}
__global__ void __launch_bounds__(512, 2) fwd_mega(Params p) {
    extern __shared__ __attribute__((aligned(16))) unsigned char lds_raw[];
    LAS unsigned char* lds = (LAS unsigned char*)lds_raw;
    cg::grid_group grid = cg::this_grid();
#if REP & 256
#define GSYNC() do { xcd_barrier(xbar); xcd_barrier(xbar); } while (0)
#else
#define GSYNC() xcd_barrier(xbar)
#endif
    unsigned char* ws = p.ws;
    u16* HBUF = (u16*)(ws + WS_HBUF); u16* WGU = (u16*)(ws + WS_WGU); u16* WD = (u16*)(ws + WS_WD); u16* WIN = (u16*)(ws + WS_WIN); u16* WOUT = (u16*)(ws + WS_WOUT);
    u16* ACT = (u16*)(ws + WS_ACT); u16* Z = (u16*)(ws + WS_Z); h16* RWPp = (h16*)(ws + WS_RWP); float* RWSp = (float*)(ws + WS_RWS); u16* ZG = (u16*)(ws + WS_ZG);
    h16* GDPp = (h16*)(ws + WS_GDP); float* GDSp = (float*)(ws + WS_GDS); u16* LRA = (u16*)(ws + WS_LRA); u16* LRUb = (u16*)(ws + WS_LRU); u16* WGU2 = (u16*)(ws + WS_WGU2); u16* WD2 = (u16*)(ws + WS_WD2);
    const bool pre2 = gridDim.x > 208;     float* HIN = (float*)(ws + WS_HIN); float* BONp = (float*)(ws + WS_BON);
    float* X = p.out;
    const int G = gridDim.x, bid = blockIdx.x;
    LAS unsigned* TAB = (LAS unsigned*)(lds + 131072 + 1024);
    if (threadIdx.x == 0) {
#pragma unroll
        for (int i = 0; i < 35; ++i) { const unsigned long long a = (unsigned long long)p.in[i]; TAB[2 * i] = (unsigned)a; TAB[2 * i + 1] = (unsigned)(a >> 32); }
    }
    volatile LAS unsigned* xst = (volatile LAS unsigned*)(lds + 131072 + 512);
    if (threadIdx.x < 2) xst[threadIdx.x] = 0u;
    __syncthreads();
    const XcdBarrier xbar = xcd_barrier_post((unsigned*)(ws + WS_BAR), xst);
    grid.sync();
#define INP(k) getp(TAB, (k))

    for (int l = 0; l < 2; ++l) {
        for (int half = 0; half < 2; ++half) {
            const float* ng = INP(half ? 30 : 1) + (size_t)l * DM;
            const float* wg = INP(half ? 31 : 2) + (size_t)l * DM * DFF;
            const float* wu = INP(half ? 32 : 3) + (size_t)l * DM * DFF;
            const float* wd = INP(half ? 33 : 4) + (size_t)l * DM * DFF;
#if PH & 1
            u16* const WGUc = (half && pre2) ? WGU2 : WGU; u16* const WDc = (half && pre2) ? WD2 : WD;
            if (!(half && pre2)) {
            conv_w<1>(wg, WGUc, DM, DFF, (LAS float*)lds);
            conv_w<2>(wu, WGUc, DM, DFF, (LAS float*)lds);
            conv_w<0>(wd, WDc, DFF, DM, (LAS float*)lds);
            }
#endif
#if PH & 2
            if (l == 0 && half == 0) norm_rows<false>(INP(0), ng, HBUF, nullptr); else norm_rows<false>(X, ng, HBUF, nullptr);
#endif
#if REP & 32
            conv_w<1>(wg, WGU, DM, DFF, (LAS float*)lds);
            conv_w<2>(wu, WGU, DM, DFF, (LAS float*)lds);
            conv_w<0>(wd, WD, DFF, DM, (LAS float*)lds);
#endif
#if REP & 64
            if (l == 0 && half == 0) norm_rows<false>(INP(0), ng, HBUF, X); else norm_rows<false>(X, ng, HBUF, nullptr);
#endif
            GSYNC();
#if PH & 4
            { pg8::Gemm g{HBUF, WGUc, MT, 2 * DFF, DM}; pg8::StaticOrder S; S.init(MT, 2 * DFF, G, bid); pg8::EpiGU E{ACT, DFF};
              pg8::gemm_phase<pg8::EpiGU, pg8::StaticOrder>(lds, g, S, E);
#if REP & 1
              GSYNC(); pg8::gemm_phase<pg8::EpiGU, pg8::StaticOrder>(lds, g, S, E);
#endif
            }
#endif
            GSYNC();
#if PH & 8
            { pg8::Gemm g{ACT, WDc, MT, DM, DFF}; pg8::StaticOrder S; S.init(MT, DM, G, bid); pg8::EpiResid E{(l == 0 && half == 0) ? INP(0) : (const float*)X, X, DM, (REP & 2) ? 0.25f : 0.5f};
              pg8::gemm_phase<pg8::EpiResid, pg8::StaticOrder, true>(lds, g, S, E);
#if REP & 2
              GSYNC(); pg8::gemm_phase<pg8::EpiResid, pg8::StaticOrder, true>(lds, g, S, E);
#endif
            }
#endif
            GSYNC();
            if (half == 1) continue;
#if PH & 16
            conv_w<3>(INP(6) + (size_t)l * DM * 6668, WIN, DM, 6668, (LAS float*)lds);
            conv_w<0>(INP(29) + (size_t)l * DM * DM, WOUT, DM, DM, (LAS float*)lds);
            tr_small(INP(9) + l * 64 * 768, (u16*)(ws + WS_W2T), 64); tr_small(INP(11) + l * 64 * 768, (u16*)(ws + WS_A2T), 64); tr_small(INP(12) + l * 128 * 768, (u16*)(ws + WS_G2T), 128);
            tr_blocks(INP(24) + l * 8 * 64 * 64, (u16*)(ws + WS_WAT)); tr_blocks(INP(26) + l * 8 * 64 * 64, (u16*)(ws + WS_WXT));
            norm_rows<false>(X, INP(5) + (size_t)l * DM, HBUF, nullptr);
#endif
            GSYNC();
#if PH & 32
            { pg8::Gemm g{HBUF, WIN, MT, 2560, DM}; pg8::StaticOrder S; S.init(MT, 2560, G, bid); pg8::EpiZ E{Z, Z1_LD};
              pg8::gemm_phase<pg8::EpiZ, pg8::StaticOrder>(lds, g, S, E); }
#endif
            GSYNC();
#if PH & 64
            { RwP P{INP(7) + l * 2560, INP(8) + l * 768, INP(9) + l * 64 * 768, INP(10) + l * 768, INP(11) + l * 64 * 768, INP(13) + l * 768, INP(14) + l * 768, INP(15) + l * 768};
              prep_rw2(Z, P, (const u16*)(ws + WS_W2T), (const u16*)(ws + WS_A2T), RWPp, RWSp, BONp, ZG, lds);
#if REP & 8
              prep_rw2(Z, P, (const u16*)(ws + WS_W2T), (const u16*)(ws + WS_A2T), RWPp, RWSp, BONp, ZG, lds);
#endif
            }
#endif
            GSYNC();
#if PH & 128
            { pg8::Gemm g{HBUF, WIN + (size_t)2560 * DM, MT, 4352, DM}; pg8::StaticOrder S; S.init(MT, 4352, G, bid); pg8::EpiZ E{Z, Z2_LD};
              pg8::gemm_phase<pg8::EpiZ, pg8::StaticOrder>(lds, g, S, E); }
#endif
            GSYNC();
#if PH & 256
            prep_gd(Z, INP(18) + l * 4 * 2304, INP(19) + l * 6, INP(20) + l * 6, GDPp, GDSp);
#endif
#if PH & 512
            { LrP P{INP(22) + l * 4 * 512, INP(23) + l * 512, INP(24) + l * 8 * 64 * 64, INP(25) + l * 512, INP(26) + l * 8 * 64 * 64, INP(27) + l * 512, INP(28) + l * 512};
              prep_lr2(Z, P, (const u16*)(ws + WS_WAT), (const u16*)(ws + WS_WXT), LRA, LRUb, lds);
            }
#endif
            GSYNC();
#if PH & 1024
            for (int rep_ = 0; rep_ < ((REP & 4) ? 2 : 1); ++rep_)
            for (int task = bid; task < 208; task += G) {
                if (task < 96) { const int bh = task >> 2, q4 = task & 3, b = bh / 12, hh = bh % 12;
                    rec_block<0>((const unsigned char*)RWPp + (size_t)bh * TS * 768, (const unsigned char*)RWSp + (size_t)bh * TS * 16,
                                 HBUF + (size_t)b * TS * DM + hh * 64 + q4 * 16, q4 * 16, lds);
                    __threadfence();
                    __syncthreads();
                    if (threadIdx.x == 0) {
                        unsigned* cnt = (unsigned*)(ws + WS_BAR + 14336) + bh;
                        __hip_atomic_fetch_add(cnt, 1u, __ATOMIC_RELAXED, __HIP_MEMORY_SCOPE_AGENT);
                        const unsigned want = 4u * (unsigned)(l + 1); unsigned spins = 0;
                        while (__hip_atomic_load(cnt, __ATOMIC_RELAXED, __HIP_MEMORY_SCOPE_AGENT) < want) { __builtin_amdgcn_s_sleep(8); if (++spins > (1u << 22)) break; }
                        __builtin_amdgcn_fence(__ATOMIC_ACQUIRE, "agent");
                        asm volatile("s_waitcnt vmcnt(0)" ::: "memory");
                    }
                    __syncthreads();
                    post_rw_head(HBUF, RWPp, BONp, ZG, (const u16*)(ws + WS_G2T), INP(16) + l * 768, INP(17) + l * 768, b, hh, q4 * (TS / 64), TS / 64); }
                else if (task < 192) { const int gb = task - 96, bh = gb >> 3, o8 = gb & 7, b = bh / 6, hh = bh % 6;
                    rec_block<1>((const unsigned char*)GDPp + (size_t)bh * TS * 768, (const unsigned char*)GDSp + (size_t)bh * TS * 16,
                                 HBUF + (size_t)b * TS * DM + 768 + hh * 128 + o8 * 16, o8 * 16, lds); }
                else if (threadIdx.x < 64) { lru_carry(task - 192, LRA, LRUb, HIN);
                    __threadfence();
                    if (threadIdx.x == 0) __hip_atomic_fetch_add((unsigned*)(ws + WS_BAR + 14336) + 32, 1u, __ATOMIC_RELAXED, __HIP_MEMORY_SCOPE_AGENT); }
            }
            if (pre2 && bid >= 208) {
                conv_w<1>(INP(31) + (size_t)l * DM * DFF, WGU2, DM, DFF, (LAS float*)lds, bid - 208, G - 208);
                conv_w<2>(INP(32) + (size_t)l * DM * DFF, WGU2, DM, DFF, (LAS float*)lds, bid - 208, G - 208);
                conv_w<0>(INP(33) + (size_t)l * DM * DFF, WD2, DFF, DM, (LAS float*)lds, bid - 208, G - 208);
                if (threadIdx.x == 0) {
                    unsigned* cnt = (unsigned*)(ws + WS_BAR + 14336) + 32; const unsigned want = 16u * (unsigned)(l + 1); unsigned spins = 0;
                    while (__hip_atomic_load(cnt, __ATOMIC_RELAXED, __HIP_MEMORY_SCOPE_AGENT) < want) { __builtin_amdgcn_s_sleep(8); if (++spins > (1u << 22)) break; }
                    __builtin_amdgcn_fence(__ATOMIC_ACQUIRE, "agent");
                    asm volatile("s_waitcnt vmcnt(0)" ::: "memory");
                }
                __syncthreads();
                post_lr(HBUF, Z, LRA, LRUb, HIN, bid - 208, G - 208);
            }
#endif
            GSYNC();
#if PH & 2048
#endif
#if PH & 4096
            post_gd(HBUF, Z, INP(21) + l * 128);
            if (!pre2) post_lr(HBUF, Z, LRA, LRUb, HIN);
#endif
            GSYNC();
#if PH & 8192
            { pg8::Gemm g{HBUF, WOUT, MT, DM, DM}; pg8::StaticOrder S; S.init(MT, DM, G, bid); pg8::EpiResid E{X, X, DM, 1.0f};
              pg8::gemm_phase<pg8::EpiResid, pg8::StaticOrder>(lds, g, S, E); }
#endif
            GSYNC();
        }
    }
    norm_rows<true>(X, INP(34), nullptr, X);
}

extern "C" void kernel_launch(void* const* d_in, const int* in_sizes, int n_in, void* d_out, int out_size, void* d_ws, size_t ws_size, hipStream_t stream) {
    static int grid_blocks = 0;
    if (!grid_blocks) {
        int dev = 0, cus = 0, per_cu = 0;
        (void)hipGetDevice(&dev);
        (void)hipDeviceGetAttribute(&cus, hipDeviceAttributeMultiprocessorCount, dev);
        (void)hipFuncSetAttribute((const void*)fwd_mega, hipFuncAttributeMaxDynamicSharedMemorySize, LDS_BYTES);
        (void)hipOccupancyMaxActiveBlocksPerMultiprocessor(&per_cu, (const void*)fwd_mega, 512, LDS_BYTES);
        grid_blocks = cus > 0 ? cus : 256;
        if (ws_size < WS_END) fprintf(stderr, "kernel_launch: workspace too small: %zu < %zu\n", ws_size, (size_t)WS_END);
        fprintf(stderr, "kernel_launch: cus %d occupancy %d ws %zu n_in %d\n", cus, per_cu, ws_size, n_in);
    }
    Params p{};
    for (int i = 0; i < 35; ++i) p.in[i] = (const float*)d_in[i];
    p.out = (float*)d_out; p.ws = (unsigned char*)d_ws;
    (void)hipMemsetAsync((unsigned char*)d_ws + WS_BAR, 0, 16384, stream);
    void* args[] = {&p};
    hipError_t e = hipLaunchCooperativeKernel((const void*)fwd_mega, dim3(grid_blocks), dim3(512), args, LDS_BYTES, stream);
    if (e != hipSuccess) fprintf(stderr, "cooperative launch failed: %s (grid %d)\n", hipGetErrorString(e), grid_blocks);
}
```

```cpp
#include <hip/hip_runtime.h>
#include <hip/hip_cooperative_groups.h>
#include <cstdio>
namespace cg = cooperative_groups;
#include <hip/hip_runtime.h>
namespace pg8 {
#define PG8_LAS __attribute__((address_space(3)))
typedef unsigned short bf16_t;
typedef short bf16x8 __attribute__((ext_vector_type(8)));
typedef float f32x4 __attribute__((ext_vector_type(4)));
typedef unsigned u32x4 __attribute__((ext_vector_type(4)));
constexpr int BM = 256, BK = 64, HALF = 128, HTB = HALF * BK * 2  , STAGE_BYTES = 8 * HTB, NXCD = 8, WGM = 8;

__host__ __device__ __forceinline__ int lds_byte(int r, int c) { const int st = (r >> 4) * 2 + (c >> 5), rr = r & 15, cc = c & 31, ob = rr * 64 + cc * 2; return st * 1024 + (ob ^ (((ob >> 9) & 1) << 5)); }
__host__ __device__ __forceinline__ void stage_rc(int b, int& R, int& C) { const int st = b / 1024, sb = b % 1024, swz = sb ^ (((sb >> 9) & 1) << 5); R = (st >> 1) * 16 + swz / 64; C = (st & 1) * 32 + (swz % 64) / 2; }
__host__ __device__ __forceinline__ int perm32(int rho) { const int n = rho >> 4, i = rho & 15; return 8 * (i >> 2) + 4 * n + (i & 3); }

struct Unit { int pm, pn; };
struct Gemm { const bf16_t* A; const bf16_t* Bt; int M, N, K; };

struct StaticOrder {
    int nM, nN, nwg, G, c;
    __host__ __device__ void init(int M, int N, int G_, int c_) { nM = M / BM; nN = N / BM; nwg = nM * nN; G = G_; c = c_; }
    __host__ __device__ bool next(int i, Unit& u) const {
        const long L = (long)i * G + c; if (L >= nwg) return false;
        int wgid = (int)L; { const int q = nwg / NXCD, r = nwg % NXCD, xcd = wgid % NXCD, off = wgid / NXCD; wgid = (xcd < r ? xcd * (q + 1) : r * (q + 1) + (xcd - r) * q) + off; }
        const int nig = WGM * nN, gid = wgid / nig, fm = gid * WGM, gsz = (nM - fm) < WGM ? (nM - fm) : WGM;
        u.pm = fm + ((wgid % nig) % gsz); u.pn = (wgid % nig) / gsz; return true;
    }
    __device__ __forceinline__ void a_ready(const Unit&) const {}
    __device__ __forceinline__ void done(const Unit&) const {}
};
__device__ __forceinline__ unsigned cvt_pk_bf16(float lo, float hi) { unsigned r; asm volatile("v_cvt_pk_bf16_f32 %0, %1, %2" : "=v"(r) : "v"(lo), "v"(hi)); return r; }
typedef float f32x2 __attribute__((ext_vector_type(2)));
typedef unsigned u32x2 __attribute__((ext_vector_type(2)));
__device__ __forceinline__ float fast_silu(float g) { return g * __builtin_amdgcn_rcpf(1.0f + __expf(-g)); }
struct EpiGU {
    static constexpr bool PERM = true, AFTER_DRAIN = false;
    bf16_t* O; int ldc;
    __device__ __forceinline__ void operator()(const f32x4 (&acc)[2][2][4][2], const Unit& u, int wr, int wc, int fr, int fq) const {
        const int rl0 = wr * 64 + fr, col0 = u.pn * HALF + wc * 32 + 8 * fq;
        bf16_t* const blk = O + ((size_t)u.pm * (ldc >> 6) + (col0 >> 6)) * (BM * 64) + (col0 & 63);
#pragma unroll
        for (int ai = 0; ai < 2; ++ai)
#pragma unroll
            for (int m = 0; m < 4; ++m) { bf16_t* rowp = blk + (size_t)(rl0 + ai * HALF + m * 16) * 64;
                const f32x4 g0 = acc[ai][0][m][0], g1 = acc[ai][0][m][1], u0 = acc[ai][1][m][0], u1 = acc[ai][1][m][1];
                f32x4 h0, h1;
#pragma unroll
                for (int j = 0; j < 4; ++j) { h0[j] = fast_silu(g0[j]) * u0[j]; h1[j] = fast_silu(g1[j]) * u1[j]; }
                u32x4 w; w.x = cvt_pk_bf16(h0[0], h0[1]); w.y = cvt_pk_bf16(h0[2], h0[3]); w.z = cvt_pk_bf16(h1[0], h1[1]); w.w = cvt_pk_bf16(h1[2], h1[3]);
                *(u32x4*)rowp = w; }
    }
};
struct EpiZ {
    static constexpr bool PERM = true, AFTER_DRAIN = false;
    bf16_t* O; int ldc;
    __device__ __forceinline__ void operator()(const f32x4 (&acc)[2][2][4][2], const Unit& u, int wr, int wc, int fr, int fq) const {
        const int row0 = u.pm * BM + wr * 64 + fr, col0 = u.pn * BM + wc * 32 + 8 * fq;
#pragma unroll
        for (int ai = 0; ai < 2; ++ai)
#pragma unroll
            for (int m = 0; m < 4; ++m) { bf16_t* rowp = O + (size_t)(row0 + ai * HALF + m * 16) * ldc + col0;
#pragma unroll
                for (int bj = 0; bj < 2; ++bj) { const f32x4 v0 = acc[ai][bj][m][0], v1 = acc[ai][bj][m][1];
                    u32x4 w; w.x = cvt_pk_bf16(v0[0], v0[1]); w.y = cvt_pk_bf16(v0[2], v0[3]); w.z = cvt_pk_bf16(v1[0], v1[1]); w.w = cvt_pk_bf16(v1[2], v1[3]);
                    *(u32x4*)(rowp + bj * HALF) = w; } }
    }
};
struct EpiResid {
    static constexpr bool PERM = true, AFTER_DRAIN = false;
    const float* Xs; float* X; int ldc; float scale;
    __device__ __forceinline__ void operator()(const f32x4 (&acc)[2][2][4][2], const Unit& u, int wr, int wc, int fr, int fq) const {
        const int row0 = u.pm * BM + wr * 64 + fr, col0 = u.pn * BM + wc * 32 + 8 * fq;
#pragma unroll
        for (int ai = 0; ai < 2; ++ai)
#pragma unroll
            for (int m = 0; m < 4; ++m) { const size_t off = (size_t)(row0 + ai * HALF + m * 16) * ldc + col0;
#pragma unroll
                for (int bj = 0; bj < 2; ++bj) { const size_t o2 = off + bj * HALF;
                    const f32x4 x0 = *(const f32x4*)(Xs + o2) + acc[ai][bj][m][0] * scale, x1 = *(const f32x4*)(Xs + o2 + 4) + acc[ai][bj][m][1] * scale;
                    *(f32x4*)(X + o2) = x0; *(f32x4*)(X + o2 + 4) = x1; } }
    }
};
template <class Epi, class Sched, bool ABLK = false>
__device__ __forceinline__ void gemm_phase(PG8_LAS unsigned char* lds, const Gemm g, const Sched& S, const Epi& E) {
    int tid_o = threadIdx.x; asm volatile("" : "+v"(tid_o));
    const int tid = tid_o, wid = __builtin_amdgcn_readfirstlane(tid >> 6), lane = tid & 63, wr = wid >> 2, wc = wid & 3, fr = lane & 15, fq = lane >> 4;
    const int K = g.K, nt = K / BK;
    unsigned voffA[2], voffB[2];
#pragma unroll
    for (int i = 0; i < 2; ++i) { int R, C; stage_rc(tid * 16 + i * 8192, R, C); const int Rb = Epi::PERM ? ((R & ~31) + perm32(R & 31)) : R;
        voffA[i] = ABLK ? (unsigned)(R * BK + C) * 2u : (unsigned)(R * K + C) * 2u; voffB[i] = (unsigned)(Rb * K + C) * 2u; }
    const size_t kstep = (size_t)(BK * 2);
    const size_t hstep = (size_t)HALF * K * 2;
    const size_t tstep = 2 * hstep;
    const size_t kstepA = ABLK ? (size_t)(BM * BK * 2) : kstep, hstepA = ABLK ? (size_t)(HALF * BK * 2) : hstep, tstepA = tstep;
    const unsigned ldsw = (unsigned)wid * 1024u;
    const int aoff = lds_byte(wr * 64 + fr, fq * 8), boff = lds_byte(wc * 32 + fr, fq * 8);
#define PG8_SA(b, h) (((b) * 2 + (h)) * HTB)
#define PG8_SB(b, h) ((4 + (b) * 2 + (h)) * HTB)
#define PG8_STAGE(bufoff, gbase, voff) do { _Pragma("unroll") for (int _i = 0; _i < 2; ++_i) \
        __builtin_amdgcn_global_load_lds((const unsigned*)((const char*)(gbase) + (voff)[_i]), (PG8_LAS unsigned*)(lds + (bufoff) + ldsw + _i * 8192), 16, 0, 0); } while (0)
#define PG8_LDA(dst, b, h) do { _Pragma("unroll") for (int m = 0; m < 4; ++m) _Pragma("unroll") for (int k = 0; k < 2; ++k) dst[m][k] = *(const PG8_LAS bf16x8*)(lds + PG8_SA(b, h) + aoff + m * 2048 + k * 1024); } while (0)
#define PG8_LDB(dst, b, h) do { _Pragma("unroll") for (int n = 0; n < 2; ++n) _Pragma("unroll") for (int k = 0; k < 2; ++k) dst[n][k] = *(const PG8_LAS bf16x8*)(lds + PG8_SB(b, h) + boff + n * 2048 + k * 1024); } while (0)
#define PG8_MMA(ai, bj, At, Bt) do { __builtin_amdgcn_s_setprio(1); _Pragma("unroll") for (int m = 0; m < 4; ++m) _Pragma("unroll") for (int n = 0; n < 2; ++n) _Pragma("unroll") for (int k = 0; k < 2; ++k) \
        acc[ai][bj][m][n] = __builtin_amdgcn_mfma_f32_16x16x32_bf16(Bt[n][k], At[m][k], acc[ai][bj][m][n], 0, 0, 0); __builtin_amdgcn_s_setprio(0); } while (0)
#define PG8_WAIT_V(n) asm volatile("s_waitcnt vmcnt(" #n ")" ::: "memory")
#define PG8_WAIT_L(n) asm volatile("s_waitcnt lgkmcnt(" #n ")" ::: "memory")
#define PG8_BAR __builtin_amdgcn_s_barrier()
#define PG8_SCHED __builtin_amdgcn_sched_barrier(0)
    Unit cur, nxt; int ui = 0;
    if (!S.next(0, cur)) return;
    f32x4 acc[2][2][4][2];
#pragma unroll
    for (int a = 0; a < 2; ++a)
#pragma unroll
        for (int b = 0; b < 2; ++b)
#pragma unroll
            for (int m = 0; m < 4; ++m)
#pragma unroll
                for (int n = 0; n < 2; ++n) acc[a][b][m][n] = (f32x4){0.f, 0.f, 0.f, 0.f};
    bf16x8 At[4][2], B0[2][2], B1[2][2];
    const char* cA = (const char*)g.A + (size_t)cur.pm * tstepA; const char* cB = (const char*)g.Bt + (size_t)cur.pn * tstep;
    S.a_ready(cur);
    PG8_STAGE(PG8_SB(0, 0), cB, voffB); PG8_STAGE(PG8_SA(0, 0), cA, voffA); PG8_STAGE(PG8_SB(0, 1), cB + hstep, voffB); PG8_STAGE(PG8_SA(0, 1), cA + hstepA, voffA);
    if (wr == 1) PG8_BAR;
    PG8_WAIT_V(4); PG8_BAR;
    PG8_STAGE(PG8_SB(1, 0), cB + kstep, voffB); PG8_STAGE(PG8_SA(1, 0), cA + kstepA, voffA); PG8_STAGE(PG8_SB(1, 1), cB + hstep + kstep, voffB);
    PG8_WAIT_V(6); PG8_BAR;
    for (;;) {
        const bool has_next = S.next(ui + 1, nxt);
        const char* nA = has_next ? (const char*)g.A + (size_t)nxt.pm * tstepA : cA; const char* nB = has_next ? (const char*)g.Bt + (size_t)nxt.pn * tstep : cB;
        for (int t = 0; t < nt; t += 2) {
            const bool last = (t == nt - 2);
            const char* a1 = cA + (size_t)(t + 1) * kstepA;
            const char* a2 = last ? nA : cA + (size_t)(t + 2) * kstepA; const char* b2 = last ? nB : cB + (size_t)(t + 2) * kstep;
            const char* a3 = a2 + kstepA; const char* b3 = b2 + kstep;
            if (last && has_next) S.a_ready(nxt);
            PG8_LDB(B0, 0, 0); PG8_SCHED; PG8_LDA(At, 0, 0); PG8_STAGE(PG8_SA(1, 1), a1 + hstepA, voffA);
            PG8_WAIT_L(8); PG8_BAR; PG8_WAIT_L(0); PG8_MMA(0, 0, At, B0); PG8_BAR; PG8_SCHED;
            PG8_LDB(B1, 0, 1); PG8_STAGE(PG8_SB(0, 0), b2, voffB);
            PG8_BAR; PG8_WAIT_L(0); PG8_MMA(0, 1, At, B1); PG8_BAR;
            PG8_LDA(At, 0, 1); PG8_STAGE(PG8_SA(0, 0), a2, voffA);
            PG8_BAR; PG8_WAIT_L(0); PG8_MMA(1, 0, At, B0); PG8_BAR; PG8_SCHED;
            PG8_STAGE(PG8_SB(0, 1), b2 + hstep, voffB);
            PG8_WAIT_V(6); PG8_BAR; PG8_MMA(1, 1, At, B1); PG8_BAR;
            PG8_LDB(B0, 1, 0); PG8_SCHED; PG8_LDA(At, 1, 0); PG8_STAGE(PG8_SA(0, 1), a2 + hstepA, voffA);
            PG8_WAIT_L(8); PG8_BAR; PG8_WAIT_L(0); PG8_MMA(0, 0, At, B0); PG8_BAR; PG8_SCHED;
            PG8_LDB(B1, 1, 1); PG8_STAGE(PG8_SB(1, 0), b3, voffB);
            PG8_BAR; PG8_WAIT_L(0); PG8_MMA(0, 1, At, B1); PG8_BAR;
            PG8_LDA(At, 1, 1); PG8_STAGE(PG8_SA(1, 0), a3, voffA);
            PG8_BAR; PG8_WAIT_L(0); PG8_MMA(1, 0, At, B0); PG8_BAR; PG8_SCHED;
            PG8_STAGE(PG8_SB(1, 1), b3 + hstep, voffB);
            PG8_WAIT_V(6); PG8_BAR; PG8_MMA(1, 1, At, B1); PG8_BAR;
        }
        if constexpr (!Epi::AFTER_DRAIN) { E(acc, cur, wr, wc, fr, fq); S.done(cur); }
        if (!has_next) break;
#pragma unroll
        for (int a = 0; a < 2; ++a)
#pragma unroll
            for (int b = 0; b < 2; ++b)
#pragma unroll
                for (int m = 0; m < 4; ++m)
#pragma unroll
                    for (int n = 0; n < 2; ++n) acc[a][b][m][n] = (f32x4){0.f, 0.f, 0.f, 0.f};
        cur = nxt; cA = nA; cB = nB; ++ui;
    }
    PG8_WAIT_V(0);
    if (wr == 0) PG8_BAR;
    PG8_BAR;
    if constexpr (Epi::AFTER_DRAIN) { E.fused(acc, cur, wr, wc, fr, fq, lds, wid, lane); S.done(cur); }
#undef PG8_SA
#undef PG8_SB
#undef PG8_STAGE
#undef PG8_LDA
#undef PG8_LDB
#undef PG8_MMA
#undef PG8_WAIT_V
#undef PG8_WAIT_L
#undef PG8_BAR
#undef PG8_SCHED
}
}
#ifndef PH
#define PH 0xFFFF
#endif
#ifndef REP
#define REP 0
#endif
typedef unsigned short u16;
typedef float f32x4 __attribute__((ext_vector_type(4)));
typedef float f32x2 __attribute__((ext_vector_type(2)));
typedef unsigned u32x4 __attribute__((ext_vector_type(4)));
typedef unsigned u32x2 __attribute__((ext_vector_type(2)));
typedef _Float16 h16;
typedef _Float16 h16x4 __attribute__((ext_vector_type(4)));
typedef _Float16 h16x8 __attribute__((ext_vector_type(8)));
typedef _Float16 h16x2 __attribute__((ext_vector_type(2)));
#define LAS __attribute__((address_space(3)))

constexpr int MT = 32768, TS = 16384, DM = 2048, DFF = 5632;
constexpr int LDS_BYTES = 144 * 1024;
constexpr size_t WS_HBUF = 0;
constexpr size_t WS_WBUF = 134217728;
constexpr size_t WS_WGU = WS_WBUF, WS_WD = WS_WBUF + 46137344;
constexpr size_t WS_WIN = WS_WBUF, WS_WOUT = WS_WBUF + 28311552;
constexpr size_t WS_ACT = WS_WBUF + 69206016;
constexpr size_t WS_Z = WS_WBUF + 36700160;
constexpr size_t WS_RWP = WS_Z + 285212672;
constexpr size_t WS_RWS = WS_RWP + 301989888;
constexpr size_t WS_ZG = WS_RWS + 6291456;
constexpr size_t WS_GDP = WS_ZG + 8388608;
constexpr size_t WS_GDS = WS_GDP + 150994944;
constexpr size_t WS_LRA = WS_GDS + 3145728;
constexpr size_t WS_LRU = WS_LRA + 33554432;
constexpr size_t WS_WGU2 = WS_LRU + 33554432;
constexpr size_t WS_WD2 = WS_WGU2 + 46137344;
constexpr size_t WS_HIN = WS_WD2 + 23068672;
constexpr size_t WS_BON = WS_HIN + 1048576;
constexpr size_t WS_BAR = WS_BON + 1572864;
constexpr size_t WS_W2T = WS_BAR + 16384;
constexpr size_t WS_A2T = WS_W2T + 98304;
constexpr size_t WS_G2T = WS_A2T + 98304;
constexpr size_t WS_WAT = WS_G2T + 196608;
constexpr size_t WS_WXT = WS_WAT + 65536;
constexpr size_t WS_END = WS_WXT + 65536;
static_assert(WS_END <= 1073741824ull, "workspace");
constexpr int Z1_LD = 2560, Z2_LD = 4352;
constexpr int Z2_GATE = 2304, Z2_XL = 3072, Z2_YL = 3584, Z2_ZB = 4096, Z2_ZA = 4102;

struct Params { const float* in[35]; float* out; unsigned char* ws; };

__device__ __forceinline__ int otid() { int t = threadIdx.x; asm volatile("" : "+v"(t)); return t; }
__device__ __forceinline__ int obid() { int t = blockIdx.x; asm volatile("" : "+s"(t)); return t; }
__device__ __forceinline__ int ogrid() { int t = gridDim.x; asm volatile("" : "+s"(t)); return t; }
__device__ __forceinline__ float bf2f(u16 h) { return __uint_as_float((unsigned)h << 16); }
__device__ __forceinline__ float bflo(unsigned w) { return __uint_as_float(w << 16); }
__device__ __forceinline__ float bfhi(unsigned w) { return __uint_as_float(w & 0xffff0000u); }
__device__ __forceinline__ u16 f2bf(float f) { unsigned u = __float_as_uint(f); u += 0x7FFFu + ((u >> 16) & 1u); return (u16)(u >> 16); }
__device__ __forceinline__ unsigned pk_bf(float lo, float hi) { return pg8::cvt_pk_bf16(lo, hi); }
template <int C> __device__ __forceinline__ float dppf(float v) { return __int_as_float(__builtin_amdgcn_update_dpp(0, __float_as_int(v), C, 0xF, 0xF, true)); }
template <int H> __device__ __forceinline__ float fmix(float a, unsigned hp, float c) { float d;
    if (H == 0) asm("v_fma_mix_f32 %0, %1, %2, %3 op_sel_hi:[0,1,0]" : "=v"(d) : "v"(a), "v"(hp), "v"(c));
    else        asm("v_fma_mix_f32 %0, %1, %2, %3 op_sel:[0,1,0] op_sel_hi:[0,1,0]" : "=v"(d) : "v"(a), "v"(hp), "v"(c));
    return d; }
template <int H> __device__ __forceinline__ float fmixn(float a, unsigned hp, float c) { float d;
    if (H == 0) asm("v_fma_mix_f32 %0, -%1, %2, %3 op_sel_hi:[0,1,0]" : "=v"(d) : "v"(a), "v"(hp), "v"(c));
    else        asm("v_fma_mix_f32 %0, -%1, %2, %3 op_sel:[0,1,0] op_sel_hi:[0,1,0]" : "=v"(d) : "v"(a), "v"(hp), "v"(c));
    return d; }
__device__ __forceinline__ float red16(float v) { v += dppf<0xB1>(v); v += dppf<0x4E>(v); v += dppf<0x141>(v); v += dppf<0x140>(v); return v; }
__device__ __forceinline__ float rlane(float v, int l) { return __int_as_float(__builtin_amdgcn_readlane(__float_as_int(v), l)); }
__device__ __forceinline__ float wave_sum(float v) { v = red16(v);
    v += __int_as_float(__builtin_amdgcn_update_dpp(0, __float_as_int(v), 0x142, 0xA, 0xF, false));
    v += __int_as_float(__builtin_amdgcn_update_dpp(0, __float_as_int(v), 0x143, 0xC, 0xF, false));
    return rlane(v, 63); }
__device__ __forceinline__ float sigm(float x) { return __builtin_amdgcn_rcpf(1.0f + __expf(-x)); }
__device__ __forceinline__ float softplus_(float x) { return fmaxf(x, 0.0f) + __logf(1.0f + __expf(-fabsf(x))); }
__device__ __forceinline__ float tanh_(float x) { const float e = __expf(-2.0f * fabsf(x)); const float t = (1.0f - e) * __builtin_amdgcn_rcpf(1.0f + e); return x < 0.f ? -t : t; }
__device__ __forceinline__ float gelu_tanh(float x) { return 0.5f * x * (1.0f + tanh_(0.7978845608028654f * (x + 0.044715f * x * x * x))); }

template <int MAP> __device__ __forceinline__ int rowmap(int n) {
    if (MAP == 0) return n;
    if (MAP == 1) return (n >> 7) * 256 + (n & 127);
    if (MAP == 2) return (n >> 7) * 256 + 128 + (n & 127);
    if (n < 2560 + 3072) return n;
    const int q = n - 2560;
    if (q < 3084) return 2560 + Z2_ZB + (q - 3072);
    return 2560 + Z2_XL + (q - 3084);
}
template <int MAP> __device__ __forceinline__ void conv_w(const float* __restrict__ src, u16* __restrict__ dst, int K, int N, LAS float* tile, int bsub = 0, int gsub = 0) {
    const int tid = otid(), NT = (N + 63) >> 6, KT = K >> 6; const int bidx = gsub ? bsub : obid(), gdim = gsub ? gsub : ogrid();
    for (int t = bidx; t < NT * KT; t += gdim) {
        const int nt = t % NT, kt = t / NT;
        const int c = tid & 63, r0 = tid >> 6, n = nt * 64 + c;
#pragma unroll
        for (int i = 0; i < 8; ++i) { const int r = r0 + 8 * i; tile[r * 65 + c] = (n < N) ? src[(size_t)(kt * 64 + r) * N + n] : 0.f; }
        __syncthreads();
        const int nl = tid >> 3, kq = tid & 7, n2 = nt * 64 + nl;
        if (n2 < N) {
            float v[8];
#pragma unroll
            for (int j = 0; j < 8; ++j) v[j] = tile[(kq * 8 + j) * 65 + nl];
            u32x4 w; w.x = pk_bf(v[0], v[1]); w.y = pk_bf(v[2], v[3]); w.z = pk_bf(v[4], v[5]); w.w = pk_bf(v[6], v[7]);
            *(u32x4*)(dst + (size_t)rowmap<MAP>(n2) * K + kt * 64 + kq * 8) = w;
        }
        __syncthreads();
    }
}

template <bool FINAL> __device__ __forceinline__ void norm_rows(const float* src, const float* __restrict__ gamma, u16* dst, float* copy) {
    const int tid_ = otid(); const int lane = tid_ & 63, wid = tid_ >> 6; const int bidx = obid(), gdim = ogrid();
    f32x4 g[8];
#pragma unroll
    for (int i = 0; i < 8; ++i) g[i] = *(const f32x4*)(gamma + i * 256 + lane * 4);
    for (int row = bidx * 8 + wid; row < MT; row += gdim * 8) {
        const float* p = src + (size_t)row * DM; f32x4 v[8]; float ss = 0.f;
#pragma unroll
        for (int i = 0; i < 8; ++i) { v[i] = *(const f32x4*)(p + i * 256 + lane * 4); ss += v[i][0] * v[i][0] + v[i][1] * v[i][1] + v[i][2] * v[i][2] + v[i][3] * v[i][3]; }
        ss = wave_sum(ss);
        const float rs = rsqrtf(ss * (1.0f / 2048.0f) + 1e-6f);
#pragma unroll
        for (int i = 0; i < 8; ++i) {
            const f32x4 o = v[i] * rs * g[i];
            if (FINAL) { *(f32x4*)(copy + (size_t)row * DM + i * 256 + lane * 4) = o; }
            else { u32x2 w; w.x = pk_bf(o[0], o[1]); w.y = pk_bf(o[2], o[3]); *(u32x2*)(dst + (size_t)row * DM + i * 256 + lane * 4) = w;
                   if (copy) *(f32x4*)(copy + (size_t)row * DM + i * 256 + lane * 4) = v[i]; }
        }
    }
}

struct RwP { const float *mu, *w0, *w2, *a0, *a2, *kk, *ka, *rk; };
__device__ __forceinline__ void prep_rw(const u16* __restrict__ Z1, const RwP P, h16* __restrict__ RWP, float* __restrict__ RWS, float* __restrict__ BON, u16* __restrict__ ZG, LAS float* L) {
    const int tid = otid(), lane = tid & 63; const int bidx = obid(), gdim = ogrid();
    constexpr int TT = 32, TH = 16;
    for (int tile = bidx; tile < MT / TT; tile += gdim) {
        const int m0 = tile * TT;
#pragma unroll
        for (int i = 0; i < 16; ++i) {
            const int idx = tid + 512 * i, tok = idx >> 8, cc = idx & 255, m = m0 + tok, c = 2304 + cc;
            const float zc = bf2f(Z1[(size_t)m * Z1_LD + c]);
            const float zp = ((m & (TS - 1)) == 0) ? 0.f : bf2f(Z1[(size_t)(m - 1) * Z1_LD + c]);
            const float zf = zc + P.mu[c] * (zp - zc);
            if (cc < 64) L[cc * TT + tok] = tanh_(zf);
            else if (cc < 128) L[cc * TT + tok] = zf;
            else ZG[(size_t)m * 128 + (cc - 128)] = f2bf(sigm(zf));
        }
        __syncthreads();
        const int jj = tid & 255, th = tid >> 8;
        for (int cgi = 0; cgi < 3; ++cgi) {
            const int j = jj + 256 * cgi;
            const int mA = m0 + th * TH;
            u16 lr[TH], lk[TH], lv[TH]; u16 l0r = 0, l0k = 0, l0v = 0;
            if ((mA & (TS - 1)) != 0) { const u16* zp = Z1 + (size_t)(mA - 1) * Z1_LD; l0r = zp[j]; l0k = zp[768 + j]; l0v = zp[1536 + j]; }
#pragma unroll
            for (int tk = 0; tk < TH; ++tk) { const u16* zc = Z1 + (size_t)(mA + tk) * Z1_LD; lr[tk] = zc[j]; lk[tk] = zc[768 + j]; lv[tk] = zc[1536 + j]; }
            float aw[TH], aa[TH];
            { const float w0v = P.w0[j], a0v = P.a0[j];
#pragma unroll
              for (int k = 0; k < TH; ++k) { aw[k] = w0v; aa[k] = a0v; } }
#pragma unroll 4
            for (int i = 0; i < 64; ++i) {
                const float w2v = P.w2[i * 768 + j], a2v = P.a2[i * 768 + j];
#pragma unroll
                for (int q = 0; q < 4; ++q) {
                    const f32x4 t = *(const LAS f32x4*)(L + i * TT + th * TH + 4 * q), y = *(const LAS f32x4*)(L + (64 + i) * TT + th * TH + 4 * q);
#pragma unroll
                    for (int k = 0; k < 4; ++k) { aw[4 * q + k] += t[k] * w2v; aa[4 * q + k] += y[k] * a2v; }
                }
            }
            const float mur = P.mu[j], muk = P.mu[768 + j], muv = P.mu[1536 + j];
            const float kkc = P.kk[j], kac = P.ka[j], rkc = P.rk[j];
            const int hh = j >> 6;
            float pr = bf2f(l0r), pk = bf2f(l0k), pv = bf2f(l0v);
            float w1 = 0.f, dl1 = 0.f, bb1 = 0.f, kp1 = 0.f, br1 = 0.f, kr1 = 0.f;
#pragma unroll
            for (int tk = 0; tk < TH; ++tk) {
                const int m = mA + tk, b = m >> 14, t = m & (TS - 1);
                const float cr = bf2f(lr[tk]), ck = bf2f(lk[tk]), cv = bf2f(lv[tk]);
                const float r = cr + mur * (pr - cr), k = ck + muk * (pk - ck), v = cv + muv * (pv - cv);
                pr = cr; pk = ck; pv = cv;
                const float e = 0.6065306597f * sigm(aw[tk]);
                const float dl = 1.0f - __expf(-e);
                const float w = 1.0f - dl;
                const float a = sigm(aa[tk]);
                const float kq = k * kkc;
                const float ss = wave_sum(kq * kq);
                const float kkn = kq * rsqrtf(ss + 1e-12f);
                const float kp = k * (1.0f + (a - 1.0f) * kac);
                const float bb = kkn * a;
                const float wr = w * r;
                const float br = wave_sum(bb * r), kr = wave_sum(kp * r), bonus = wave_sum(r * kp * rkc);
                const size_t rec = (size_t)(b * 12 + hh) * TS + t;
                h16* o = RWP + (rec >> 1) * 768 + lane;
                if (lane == 0) BON[rec] = bonus;
                if ((tk & 1) == 0) {
                    o[0] = (h16)kkn; o[64] = (h16)wr; o[9 * 64] = (h16)v;
                    w1 = w; dl1 = dl; bb1 = bb; kp1 = kp; br1 = br; kr1 = kr;
                } else {
                    o[2 * 64] = (h16)(w1 * kkn); o[3 * 64] = (h16)(w1 * wr); o[4 * 64] = (h16)(dl1 + dl - dl1 * dl);
                    o[5 * 64] = (h16)(bb1 * w); o[6 * 64] = (h16)(kp1 * w); o[7 * 64] = (h16)bb; o[8 * 64] = (h16)kp; o[10 * 64] = (h16)v;
                    const float bk12 = wave_sum(bb1 * kkn), kk12 = wave_sum(kp1 * kkn), bz = wave_sum(bb1 * wr), kz = wave_sum(kp1 * wr);
                    if (lane == 0) { f32x4 sA, sB; sA[0] = br1; sA[1] = kr1; sA[2] = bk12; sA[3] = kk12; sB[0] = br; sB[1] = kr; sB[2] = bz; sB[3] = kz;
                        *(f32x4*)(RWS + (rec >> 1) * 8) = sA; *(f32x4*)(RWS + (rec >> 1) * 8 + 4) = sB; }
                }
            }
        }
        __syncthreads();
    }
}

__device__ __forceinline__ void tr_small(const float* __restrict__ src, u16* __restrict__ dst, int K) {
    const int tid = otid(); const int bidx = obid(), gdim = ogrid();
    for (int idx = bidx * 512 + tid; idx < 768 * K; idx += gdim * 512) { const int col = idx / K, k = idx - col * K; dst[idx] = f2bf(src[k * 768 + col]); }
}
typedef short bf16x8_t __attribute__((ext_vector_type(8)));
__device__ __forceinline__ void prep_rw2(const u16* __restrict__ Z1, const RwP P, const u16* __restrict__ W2T, const u16* __restrict__ A2T,
                                         h16* __restrict__ RWP, float* __restrict__ RWS, float* __restrict__ BON, u16* __restrict__ ZG, LAS unsigned char* lds) {
    const int tid = otid(), lane = tid & 63, wid = tid >> 6, fr = lane & 15, fq = lane >> 4; const int bidx = obid(), gdim = ogrid();
    constexpr int TT = 32, LST = 272;
    for (int tile = bidx; tile < MT / TT; tile += gdim) {
        const int m0 = tile * TT;
#pragma unroll
        for (int i = 0; i < 16; ++i) {
            const int idx = tid + 512 * i, tok = idx >> 8, cc = idx & 255, m = m0 + tok, c = 2304 + cc;
            const float zc = bf2f(Z1[(size_t)m * Z1_LD + c]);
            const float zp = ((m & (TS - 1)) == 0) ? 0.f : bf2f(Z1[(size_t)(m - 1) * Z1_LD + c]);
            const float zf = zc + P.mu[c] * (zp - zc);
            if (cc < 128) *(LAS u16*)(lds + tok * LST + cc * 2) = f2bf(cc < 64 ? tanh_(zf) : zf);
            else ZG[(size_t)m * 128 + (cc - 128)] = f2bf(sigm(zf));
        }
        __syncthreads();
        for (int wt = wid; wt < 24; wt += 8) {
            const int hh = wt % 12, half = wt / 12;
            const int mB = m0 + half * 16, b = mB >> 14, tB = mB & (TS - 1);
            const int j0 = hh * 64 + 4 * fr;
            f32x4 accW[4], accA[4];
#pragma unroll
            for (int n = 0; n < 4; ++n) { accW[n] = (f32x4){0.f, 0.f, 0.f, 0.f}; accA[n] = (f32x4){0.f, 0.f, 0.f, 0.f}; }
#pragma unroll
            for (int ks = 0; ks < 2; ++ks) {
                const bf16x8_t aw_ = *(const LAS bf16x8_t*)(lds + (half * 16 + fr) * LST + (ks * 32 + fq * 8) * 2);
                const bf16x8_t aa_ = *(const LAS bf16x8_t*)(lds + (half * 16 + fr) * LST + (64 + ks * 32 + fq * 8) * 2);
#pragma unroll
                for (int n = 0; n < 4; ++n) {
                    const bf16x8_t bw = *(const bf16x8_t*)(W2T + (size_t)(j0 + n) * 64 + ks * 32 + fq * 8);
                    const bf16x8_t ba = *(const bf16x8_t*)(A2T + (size_t)(j0 + n) * 64 + ks * 32 + fq * 8);
                    accW[n] = __builtin_amdgcn_mfma_f32_16x16x32_bf16(aw_, bw, accW[n], 0, 0, 0);
                    accA[n] = __builtin_amdgcn_mfma_f32_16x16x32_bf16(aa_, ba, accA[n], 0, 0, 0);
                }
            }
            const f32x4 w0v = *(const f32x4*)(P.w0 + j0), a0v = *(const f32x4*)(P.a0 + j0), mur = *(const f32x4*)(P.mu + j0), muk = *(const f32x4*)(P.mu + 768 + j0), muv = *(const f32x4*)(P.mu + 1536 + j0);
            const f32x4 kkc = *(const f32x4*)(P.kk + j0), kac = *(const f32x4*)(P.ka + j0), rkc = *(const f32x4*)(P.rk + j0);
            u32x2 zr[5], zk[5], zv[5];
#pragma unroll
            for (int q = 0; q < 5; ++q) {
                const int m = mB + 4 * fq + q - 1;
                if (q == 0 && ((m + 1) & (TS - 1)) == 0) { zr[0] = (u32x2){0u, 0u}; zk[0] = zr[0]; zv[0] = zr[0]; }
                else { const u16* zc = Z1 + (size_t)m * Z1_LD + j0; zr[q] = *(const u32x2*)zc; zk[q] = *(const u32x2*)(zc + 768); zv[q] = *(const u32x2*)(zc + 1536); }
            }
            f32x4 w1, dl1, bb1, kp1; float br1 = 0.f, kr1 = 0.f;
#pragma unroll
            for (int r = 0; r < 4; ++r) {
                const int t = tB + 4 * fq + r;
                const size_t rec = (size_t)(b * 12 + hh) * TS + t;
                f32x4 pr, pk, pv, cr, ck, cv;
                pr[0] = bflo(zr[r].x); pr[1] = bfhi(zr[r].x); pr[2] = bflo(zr[r].y); pr[3] = bfhi(zr[r].y);
                pk[0] = bflo(zk[r].x); pk[1] = bfhi(zk[r].x); pk[2] = bflo(zk[r].y); pk[3] = bfhi(zk[r].y);
                pv[0] = bflo(zv[r].x); pv[1] = bfhi(zv[r].x); pv[2] = bflo(zv[r].y); pv[3] = bfhi(zv[r].y);
                cr[0] = bflo(zr[r + 1].x); cr[1] = bfhi(zr[r + 1].x); cr[2] = bflo(zr[r + 1].y); cr[3] = bfhi(zr[r + 1].y);
                ck[0] = bflo(zk[r + 1].x); ck[1] = bfhi(zk[r + 1].x); ck[2] = bflo(zk[r + 1].y); ck[3] = bfhi(zk[r + 1].y);
                cv[0] = bflo(zv[r + 1].x); cv[1] = bfhi(zv[r + 1].x); cv[2] = bflo(zv[r + 1].y); cv[3] = bfhi(zv[r + 1].y);
                const f32x4 rr = cr + mur * (pr - cr), k = ck + muk * (pk - ck), v = cv + muv * (pv - cv);
                f32x4 w, dl, a, kq, kp;
                float ss = 0.f;
#pragma unroll
                for (int n = 0; n < 4; ++n) {
                    const float e = 0.6065306597f * sigm(accW[n][r] + w0v[n]);
                    w[n] = __expf(-e); dl[n] = 1.0f - w[n];
                    a[n] = sigm(accA[n][r] + a0v[n]);
                    kq[n] = k[n] * kkc[n]; ss += kq[n] * kq[n];
                    kp[n] = k[n] * (1.0f + (a[n] - 1.0f) * kac[n]);
                }
                ss = red16(ss);
                const float rn = rsqrtf(ss + 1e-12f);
                const f32x4 kkn = kq * rn, bb = kkn * a, wr = w * rr;
                float br = 0.f, kr = 0.f, bonus = 0.f;
#pragma unroll
                for (int n = 0; n < 4; ++n) { br += bb[n] * rr[n]; kr += kp[n] * rr[n]; bonus += rr[n] * kp[n] * rkc[n]; }
                br = red16(br); kr = red16(kr); bonus = red16(bonus);
                h16* o = RWP + (rec >> 1) * 768 + 4 * fr;
                if (fr == 0) BON[rec] = bonus;
#define ST4(slot, vec) do { h16x4 hv_; hv_[0] = (h16)(vec)[0]; hv_[1] = (h16)(vec)[1]; hv_[2] = (h16)(vec)[2]; hv_[3] = (h16)(vec)[3]; *(h16x4*)(o + (slot) * 64) = hv_; } while (0)
                if ((r & 1) == 0) {
                    ST4(0, kkn); ST4(1, wr); ST4(9, v);
                    w1 = w; dl1 = dl; bb1 = bb; kp1 = kp; br1 = br; kr1 = kr;
                } else {
                    const f32x4 x2 = w1 * kkn, z2 = w1 * wr, d12 = dl1 + dl - dl1 * dl, B1 = bb1 * w, K1 = kp1 * w;
                    ST4(2, x2); ST4(3, z2); ST4(4, d12); ST4(5, B1); ST4(6, K1); ST4(7, bb); ST4(8, kp); ST4(10, v);
                    float bk12 = 0.f, kk12 = 0.f, bz = 0.f, kz = 0.f;
#pragma unroll
                    for (int n = 0; n < 4; ++n) { bk12 += bb1[n] * kkn[n]; kk12 += kp1[n] * kkn[n]; bz += bb1[n] * wr[n]; kz += kp1[n] * wr[n]; }
                    bk12 = red16(bk12); kk12 = red16(kk12); bz = red16(bz); kz = red16(kz);
                    if (fr == 0) { f32x4 sA, sB; sA[0] = br1; sA[1] = kr1; sA[2] = bk12; sA[3] = kk12; sB[0] = br; sB[1] = kr; sB[2] = bz; sB[3] = kz;
                        *(f32x4*)(RWS + (rec >> 1) * 8) = sA; *(f32x4*)(RWS + (rec >> 1) * 8 + 4) = sB; }
                }
#undef ST4
            }
        }
        __syncthreads();
    }
}

__device__ __forceinline__ void prep_gd(const u16* __restrict__ Z2, const float* __restrict__ cw, const float* __restrict__ alog, const float* __restrict__ dtb,
                                        h16* __restrict__ GDP, float* __restrict__ GDS) {
    const int tid_ = otid(); const int lane = tid_ & 63, wid = tid_ >> 6; const int bidx = obid(), gdim = ogrid();
    for (int task = bidx * 8 + wid; task < 6 * (MT / 32); task += gdim * 8) {
        const int hh = task % 6, chunk = task / 6, m0 = chunk * 32, b = m0 >> 14, t0 = m0 & (TS - 1);
        const int cq = hh * 128 + 2 * lane;
        float w[3][4][2];
#pragma unroll
        for (int a = 0; a < 3; ++a)
#pragma unroll
            for (int i = 0; i < 4; ++i) { const f32x2 q = *(const f32x2*)(cw + i * 2304 + a * 768 + cq); w[a][i][0] = q[0]; w[a][i][1] = q[1]; }
        float x[3][3][2];
#pragma unroll
        for (int a = 0; a < 3; ++a)
#pragma unroll
            for (int d = 0; d < 3; ++d) {
                unsigned wv = 0u;
                if (t0 != 0) wv = *(const unsigned*)(Z2 + (size_t)(m0 - 3 + d) * Z2_LD + a * 768 + cq);
                x[a][d][0] = bflo(wv); x[a][d][1] = bfhi(wv);
            }
        const float An = -__expf(alog[hh]), dtbv = dtb[hh];
        float kprev0 = 0.f, kprev1 = 0.f, al1 = 0.f, be1 = 0.f, qk1 = 0.f;
        for (int s8 = 0; s8 < 32; s8 += 8) {
          unsigned ld[8][3]; u16 ldb[8], lda[8];
#pragma unroll
          for (int k = 0; k < 8; ++k) { const u16* zr = Z2 + (size_t)(m0 + s8 + k) * Z2_LD;
#pragma unroll
              for (int a = 0; a < 3; ++a) ld[k][a] = *(const unsigned*)(zr + a * 768 + cq);
              ldb[k] = zr[Z2_ZB + hh]; lda[k] = zr[Z2_ZA + hh]; }
#pragma unroll
          for (int k = 0; k < 8; ++k) {
            const int s = s8 + k;
            float y[3][2];
#pragma unroll
            for (int a = 0; a < 3; ++a) {
                const unsigned wv = ld[k][a];
                const float c0 = bflo(wv), c1 = bfhi(wv);
                const float s0 = x[a][0][0] * w[a][0][0] + x[a][1][0] * w[a][1][0] + x[a][2][0] * w[a][2][0] + c0 * w[a][3][0];
                const float s1 = x[a][0][1] * w[a][0][1] + x[a][1][1] * w[a][1][1] + x[a][2][1] * w[a][2][1] + c1 * w[a][3][1];
                x[a][0][0] = x[a][1][0]; x[a][1][0] = x[a][2][0]; x[a][2][0] = c0;
                x[a][0][1] = x[a][1][1]; x[a][1][1] = x[a][2][1]; x[a][2][1] = c1;
                y[a][0] = s0 * sigm(s0); y[a][1] = s1 * sigm(s1);
            }
            const float sq = wave_sum(y[0][0] * y[0][0] + y[0][1] * y[0][1]);
            const float sk = wave_sum(y[1][0] * y[1][0] + y[1][1] * y[1][1]);
            const float rq = rsqrtf(sq + 1e-12f) * 0.08838834764831845f, rk = rsqrtf(sk + 1e-12f);
            const float q0 = y[0][0] * rq, q1 = y[0][1] * rq, k0 = y[1][0] * rk, k1 = y[1][1] * rk;
            const float qk = wave_sum(q0 * k0 + q1 * k1);
            const size_t rec = (size_t)(b * 6 + hh) * TS + (t0 + s);
            h16* o = GDP + rec * 384 + 2 * lane;
            h16x2 kv; kv[0] = (h16)k0; kv[1] = (h16)k1; *(h16x2*)(o) = kv;
            h16x2 qv; qv[0] = (h16)q0; qv[1] = (h16)q1; *(h16x2*)(o + 128) = qv;
            h16x2 vv; vv[0] = (h16)y[2][0]; vv[1] = (h16)y[2][1]; *(h16x2*)(o + 256) = vv;
            const float beta = sigm(bf2f(ldb[k]));
            const float alpha = __expf(An * softplus_(bf2f(lda[k]) + dtbv));
            if ((k & 1) == 0) { kprev0 = k0; kprev1 = k1; al1 = alpha; be1 = beta; qk1 = qk; }
            else {
                const float k12 = wave_sum(kprev0 * k0 + kprev1 * k1), kq12 = wave_sum(kprev0 * q0 + kprev1 * q1);
                if (lane == 0) { f32x4 sA, sB; sA[0] = al1; sA[1] = be1; sA[2] = qk1; sA[3] = k12; sB[0] = alpha; sB[1] = beta; sB[2] = qk; sB[3] = kq12;
                    *(f32x4*)(GDS + (rec - 1) * 4) = sA; *(f32x4*)(GDS + rec * 4) = sB; }
            }
          }
        }
    }
}

struct LrP { const float *cw, *cb, *wa, *ba, *wx, *bx, *lam; };
__device__ __forceinline__ void tr_blocks(const float* __restrict__ src, u16* __restrict__ dst) {
    const int tid = otid(); const int bidx = obid(), gdim = ogrid();
    for (int idx = bidx * 512 + tid; idx < 8 * 64 * 64; idx += gdim * 512) { const int n = idx >> 12, d = (idx >> 6) & 63, c = idx & 63; dst[idx] = f2bf(src[(n * 64 + c) * 64 + d]); }
}
__device__ __forceinline__ void prep_lr2(const u16* __restrict__ Z2, const LrP P, const u16* __restrict__ WAT, const u16* __restrict__ WXT, u16* __restrict__ LRA, u16* __restrict__ LRUb, LAS unsigned char* lds, int bsub = 0, int gsub = 0) {
    const int tid_ = otid(); const int lane = tid_ & 63, wid = tid_ >> 6, fr = lane & 15, fq = lane >> 4; const int bidx = gsub ? bsub : obid(), gdim = gsub ? gsub : ogrid();
    LAS unsigned char* Lx = lds + wid * 10240;
    LAS float* La = (LAS float*)(Lx + 2048);
    LAS float* Lb = La + 1024;
    for (int task = bidx * 8 + wid; task < 8 * (MT / 64); task += gdim * 8) {
        const int n = task & 7, chunk = task >> 3, m0 = chunk * 64, t0 = m0 & (TS - 1);
        const int ch = n * 64 + lane;
        bf16x8_t bwa[4][2], bwx[4][2];
#pragma unroll
        for (int nt = 0; nt < 4; ++nt)
#pragma unroll
            for (int ks = 0; ks < 2; ++ks) { const size_t o = (size_t)(n * 64 + nt * 16 + fr) * 64 + ks * 32 + fq * 8; bwa[nt][ks] = *(const bf16x8_t*)(WAT + o); bwx[nt][ks] = *(const bf16x8_t*)(WXT + o); }
        const float c0 = P.cw[ch], c1 = P.cw[512 + ch], c2 = P.cw[1024 + ch], c3 = P.cw[1536 + ch], cb = P.cb[ch];
        const float ba = P.ba[ch], bx = P.bx[ch];
        const float spl = -8.0f * softplus_(-P.lam[ch]);
        float x0 = 0.f, x1 = 0.f, x2 = 0.f, hl = 0.f, pc = 1.f;
        if (t0 != 0) { x0 = bf2f(Z2[(size_t)(m0 - 3) * Z2_LD + Z2_XL + ch]); x1 = bf2f(Z2[(size_t)(m0 - 2) * Z2_LD + Z2_XL + ch]); x2 = bf2f(Z2[(size_t)(m0 - 1) * Z2_LD + Z2_XL + ch]); }
        for (int s16 = 0; s16 < 64; s16 += 16) {
            u16 ldx[16];
#pragma unroll
            for (int k = 0; k < 16; ++k) ldx[k] = Z2[(size_t)(m0 + s16 + k) * Z2_LD + Z2_XL + ch];
            float xc[16];
#pragma unroll
            for (int k = 0; k < 16; ++k) {
                const float xin = bf2f(ldx[k]);
                xc[k] = x0 * c0 + x1 * c1 + x2 * c2 + xin * c3 + cb;
                x0 = x1; x1 = x2; x2 = xin;
                *(LAS u16*)(Lx + (k * 64 + lane) * 2) = f2bf(xc[k]);
            }
            f32x4 aA[4], aX[4];
#pragma unroll
            for (int nt = 0; nt < 4; ++nt) { aA[nt] = (f32x4){0.f, 0.f, 0.f, 0.f}; aX[nt] = (f32x4){0.f, 0.f, 0.f, 0.f}; }
#pragma unroll
            for (int ks = 0; ks < 2; ++ks) {
                const bf16x8_t af = *(const LAS bf16x8_t*)(Lx + (fr * 64 + ks * 32 + fq * 8) * 2);
#pragma unroll
                for (int nt = 0; nt < 4; ++nt) { aA[nt] = __builtin_amdgcn_mfma_f32_16x16x32_bf16(af, bwa[nt][ks], aA[nt], 0, 0, 0); aX[nt] = __builtin_amdgcn_mfma_f32_16x16x32_bf16(af, bwx[nt][ks], aX[nt], 0, 0, 0); }
            }
#pragma unroll
            for (int nt = 0; nt < 4; ++nt)
#pragma unroll
                for (int r = 0; r < 4; ++r) { La[(4 * fq + r) * 64 + nt * 16 + fr] = aA[nt][r]; Lb[(4 * fq + r) * 64 + nt * 16 + fr] = aX[nt][r]; }
#pragma unroll
            for (int k = 0; k < 16; ++k) {
                const int m = m0 + s16 + k;
                const float r = sigm(La[k * 64 + lane] + ba), ig = sigm(Lb[k * 64 + lane] + bx);
                const float la = spl * r;
                const float a = __expf(la);
                const float u = __builtin_amdgcn_sqrtf(1.0f - __expf(2.0f * la)) * (ig * xc[k]);
                hl = a * hl + u; pc *= a;
                LRA[(size_t)m * 512 + ch] = f2bf(pc); LRUb[(size_t)m * 512 + ch] = f2bf(hl);
            }
        }
    }
}

constexpr int RC = 32;
constexpr int RPB = 3072;
constexpr int RBUF = (RC / 2) * RPB + (RC / 2) * 32;
__device__ __forceinline__ f32x2 lo2(f32x4 v) { f32x2 r; r[0] = v[0]; r[1] = v[1]; return r; }
__device__ __forceinline__ f32x2 hi2(f32x4 v) { f32x2 r; r[0] = v[2]; r[1] = v[3]; return r; }
__device__ __forceinline__ float dot4(f32x2 sa, f32x2 sb, f32x4 v) { f32x2 t = sa * lo2(v); t = sb * hi2(v) + t; return t[0] + t[1]; }
__device__ __forceinline__ float dot8(const f32x2 (&S)[4], f32x4 va, f32x4 vb) { f32x2 t = S[0] * lo2(va); t = S[1] * hi2(va) + t; t = S[2] * lo2(vb) + t; t = S[3] * hi2(vb) + t; return t[0] + t[1]; }
template <int KIND> __device__ __forceinline__ void rec_block(const unsigned char* __restrict__ gp, const unsigned char* __restrict__ gs, u16* __restrict__ outp  ,
                                                             int rowl0  , LAS unsigned char* lds) {
    const int tid = otid(), lane = tid & 63, wid = tid >> 6, g = lane >> 4, j = lane & 15;
    const int cw = wid & 3; const bool is_ld = wid >= 4;
    const int rowl = rowl0 + cw * 4 + g;
    const int lt = cw * 64 + lane;
    constexpr int NCH = TS / RC;
    constexpr int CB = (RC / 2) * 1536;
    u32x4 st[6]; u32x4 ss0, ss1;
#define LD_ISSUE(c) do { const unsigned char* np = gp + (size_t)(c) * CB; const unsigned char* ns = gs + (size_t)(c) * (RC * 16); \
        _Pragma("unroll") for (int i = 0; i < 6; ++i) st[i] = *(const u32x4*)(np + (size_t)(lt + 256 * i) * 16); \
        if (lt < 32) ss0 = *(const u32x4*)(ns + lt * 16); } while (0)
#define LD_COMMIT(buf) do { LAS unsigned char* Bn = lds + 4096 + (buf) * RBUF; \
        _Pragma("unroll") for (int i = 0; i < 6; ++i) { const int q = lt + 256 * i, slot = (q % 96) >> 3; \
            const u32x4 w = st[i]; f32x4 a, b; \
            { const unsigned w0 = w[0], w1 = w[1], w2 = w[2], w3 = w[3]; const h16x2 h0 = __builtin_bit_cast(h16x2, w0), h1 = __builtin_bit_cast(h16x2, w1), h2 = __builtin_bit_cast(h16x2, w2), h3 = __builtin_bit_cast(h16x2, w3); \
              a[0] = (float)h0[0]; a[1] = (float)h0[1]; a[2] = (float)h1[0]; a[3] = (float)h1[1]; b[0] = (float)h2[0]; b[1] = (float)h2[1]; b[2] = (float)h3[0]; b[3] = (float)h3[1]; } \
            if (KIND == 0 && slot == 4) { a = 1.0f - a; b = 1.0f - b; } \
            *(LAS f32x4*)(Bn + q * 32) = a; *(LAS f32x4*)(Bn + q * 32 + 16) = b; } \
        if (lt < 32) *(LAS u32x4*)(Bn + (RC / 2) * RPB + lt * 16) = ss0; } while (0)
#define Y_OUT(c) do { const LAS float* yb = (const LAS float*)(lds + ((c) & 1) * 2048); const int stp = lt >> 3, rp = (lt & 7) * 2; \
        const f32x2 yv = *(const LAS f32x2*)(yb + stp * 16 + rp); *(unsigned*)(outp + ((size_t)(c) * RC + stp) * DM + rp) = pk_bf(yv[0], yv[1]); } while (0)
    if (is_ld) { LD_ISSUE(0); LD_COMMIT(0); LD_ISSUE(1); }
    __syncthreads();
    f32x2 Sv[4];
#pragma unroll
    for (int i = 0; i < 4; ++i) { Sv[i][0] = 0.f; Sv[i][1] = 0.f; }
    for (int c = 0; c < NCH; ++c) {
        if (is_ld) {
            if (c + 1 < NCH) { LD_COMMIT((c + 1) & 1); if (c + 2 < NCH) LD_ISSUE(c + 2); }
            if (c > 0) Y_OUT(c - 1);
        } else {
            const LAS unsigned char* B = lds + 4096 + (c & 1) * RBUF;
            const LAS unsigned char* Sc = B + (RC / 2) * RPB;
            LAS float* yw = (LAS float*)(lds + (c & 1) * 2048) + (cw * 4 + g);
            if (KIND == 0) {
                f32x4 n_kk, n_wr, n_x2, n_z2, n_W, n_B1, n_K1, n_b2, n_kp2, n_sA, n_sB; float n_v1, n_v2;
#define RW_LD(p) do { const LAS unsigned char* Pp = B + (p) * RPB + j * 16; \
                    n_kk = *(const LAS f32x4*)(Pp); n_wr = *(const LAS f32x4*)(Pp + 256); n_x2 = *(const LAS f32x4*)(Pp + 512); n_z2 = *(const LAS f32x4*)(Pp + 768); \
                    n_W = *(const LAS f32x4*)(Pp + 1024); n_B1 = *(const LAS f32x4*)(Pp + 1280); n_K1 = *(const LAS f32x4*)(Pp + 1536); n_b2 = *(const LAS f32x4*)(Pp + 1792); n_kp2 = *(const LAS f32x4*)(Pp + 2048); \
                    n_v1 = *(const LAS float*)(B + (p) * RPB + 2304 + rowl * 4); n_v2 = *(const LAS float*)(B + (p) * RPB + 2560 + rowl * 4); \
                    n_sA = *(const LAS f32x4*)(Sc + (p) * 32); n_sB = *(const LAS f32x4*)(Sc + (p) * 32 + 16); } while (0)
                RW_LD(0);
#pragma unroll 16
                for (int p = 0; p < RC / 2; ++p) {
                    const f32x4 kk = n_kk, wr = n_wr, x2 = n_x2, z2 = n_z2, W = n_W, B1 = n_B1, K1 = n_K1, b2 = n_b2, kp2 = n_kp2, sA = n_sA, sB = n_sB; const float v1 = n_v1, v2 = n_v2;
                    { const int pn = (p + 1 < RC / 2) ? p + 1 : p; RW_LD(pn); }
                    float d0 = dot4(Sv[0], Sv[1], kk), d1 = dot4(Sv[0], Sv[1], wr), d2 = dot4(Sv[0], Sv[1], x2), d3 = dot4(Sv[0], Sv[1], z2);
                    d0 = red16(d0); d1 = red16(d1); d2 = red16(d2); d3 = red16(d3);
                    const float sa1 = d0;
                    const float y1 = d1 - sa1 * sA[0] + v1 * sA[1];
                    const float sa2 = d2 - sa1 * sA[2] + v1 * sA[3];
                    const float y2 = (d3 - sa1 * sB[2] + v1 * sB[3]) - sa2 * sB[0] + v2 * sB[1];
                    yw[(2 * p) * 16] = y1; yw[(2 * p + 1) * 16] = y2;
                    const float n1 = -sa1, n2 = -sa2;
                    Sv[0] = lo2(b2) * n2 + (lo2(kp2) * v2 + (lo2(B1) * n1 + (lo2(K1) * v1 + Sv[0] * lo2(W))));
                    Sv[1] = hi2(b2) * n2 + (hi2(kp2) * v2 + (hi2(B1) * n1 + (hi2(K1) * v1 + Sv[1] * hi2(W))));
                }
            } else {
                f32x4 n_k1a, n_k1b, n_q1a, n_q1b, n_k2a, n_k2b, n_q2a, n_q2b, n_sA, n_sB; float n_v1, n_v2;
#define GD_LD(p) do { const LAS unsigned char* Pp = B + (p) * RPB + j * 32; \
                    n_k1a = *(const LAS f32x4*)(Pp); n_k1b = *(const LAS f32x4*)(Pp + 16); n_q1a = *(const LAS f32x4*)(Pp + 512); n_q1b = *(const LAS f32x4*)(Pp + 528); \
                    n_k2a = *(const LAS f32x4*)(Pp + 1536); n_k2b = *(const LAS f32x4*)(Pp + 1552); n_q2a = *(const LAS f32x4*)(Pp + 2048); n_q2b = *(const LAS f32x4*)(Pp + 2064); \
                    n_v1 = *(const LAS float*)(B + (p) * RPB + 1024 + rowl * 4); n_v2 = *(const LAS float*)(B + (p) * RPB + 2560 + rowl * 4); \
                    n_sA = *(const LAS f32x4*)(Sc + (p) * 32); n_sB = *(const LAS f32x4*)(Sc + (p) * 32 + 16); } while (0)
                GD_LD(0);
#pragma unroll 16
                for (int p = 0; p < RC / 2; ++p) {
                    const f32x4 k1a = n_k1a, k1b = n_k1b, q1a = n_q1a, q1b = n_q1b, k2a = n_k2a, k2b = n_k2b, q2a = n_q2a, q2b = n_q2b, sA = n_sA, sB = n_sB; const float v1 = n_v1, v2 = n_v2;
                    { const int pn = (p + 1 < RC / 2) ? p + 1 : p; GD_LD(pn); }
                    float a1 = dot8(Sv, k1a, k1b), c1 = dot8(Sv, q1a, q1b), a2 = dot8(Sv, k2a, k2b), c2 = dot8(Sv, q2a, q2b);
                    a1 = red16(a1); c1 = red16(c1); a2 = red16(a2); c2 = red16(c2);
                    const float al1 = sA[0], al2 = sB[0];
                    const float vn1 = sA[1] * (v1 - al1 * a1);
                    const float o1 = al1 * c1 + sA[2] * vn1;
                    const float vn2 = sB[1] * (v2 - al2 * (al1 * a2 + sA[3] * vn1));
                    const float o2 = al2 * (al1 * c2 + sB[3] * vn1) + sB[2] * vn2;
                    yw[(2 * p) * 16] = o1; yw[(2 * p + 1) * 16] = o2;
                    const float cS = al1 * al2, w1 = al2 * vn1;
                    Sv[0] = lo2(k2a) * vn2 + (lo2(k1a) * w1 + Sv[0] * cS);
                    Sv[1] = hi2(k2a) * vn2 + (hi2(k1a) * w1 + Sv[1] * cS);
                    Sv[2] = lo2(k2b) * vn2 + (lo2(k1b) * w1 + Sv[2] * cS);
                    Sv[3] = hi2(k2b) * vn2 + (hi2(k1b) * w1 + Sv[3] * cS);
                }
            }
        }
        __syncthreads();
    }
    if (is_ld) Y_OUT(NCH - 1);
#undef LD_ISSUE
#undef LD_COMMIT
#undef Y_OUT
}
__device__ __forceinline__ void lru_carry(int grp  , const u16* __restrict__ LRA, const u16* __restrict__ LRUb, float* __restrict__ HIN) {
    const int lane = otid() & 63;
    const int b = grp >> 3, ch = (grp & 7) * 64 + lane;
    float h = 0.f;
    for (int c = 0; c < TS / 64; c += 8) {
        float a[8], u[8];
#pragma unroll
        for (int k = 0; k < 8; ++k) { const size_t m = (size_t)b * TS + (c + k) * 64 + 63; a[k] = bf2f(LRA[m * 512 + ch]); u[k] = bf2f(LRUb[m * 512 + ch]); }
#pragma unroll
        for (int k = 0; k < 8; ++k) { HIN[((size_t)b * 256 + c + k) * 512 + ch] = h; h = a[k] * h + u[k]; }
    }
}
__device__ __forceinline__ void post_lr(u16* __restrict__ MIX, const u16* __restrict__ Z2, const u16* __restrict__ LRA, const u16* __restrict__ LRUb, const float* __restrict__ HIN, int bsub = 0, int gsub = 0) {
    const int tid = otid(); const int bidx = gsub ? bsub : obid(), gdim = gsub ? gsub : ogrid();
    for (int it = bidx * 512 + tid; it < MT * 128; it += gdim * 512) {
        const int m = it >> 7, c4 = (it & 127) * 4, b = m >> 14, chunk = (m & (TS - 1)) >> 6;
        const u32x2 pw = *(const u32x2*)(LRA + (size_t)m * 512 + c4), hw = *(const u32x2*)(LRUb + (size_t)m * 512 + c4); const f32x4 hin = *(const f32x4*)(HIN + ((size_t)b * 256 + chunk) * 512 + c4);
        f32x4 pc, hl; pc[0] = bflo(pw.x); pc[1] = bfhi(pw.x); pc[2] = bflo(pw.y); pc[3] = bfhi(pw.y); hl[0] = bflo(hw.x); hl[1] = bfhi(hw.x); hl[2] = bflo(hw.y); hl[3] = bfhi(hw.y);
        const u32x2 yw = *(const u32x2*)(Z2 + (size_t)m * Z2_LD + Z2_YL + c4);
        const f32x4 h = hl + pc * hin;
        u32x2 o; o.x = pk_bf(h[0] * gelu_tanh(bflo(yw.x)), h[1] * gelu_tanh(bfhi(yw.x))); o.y = pk_bf(h[2] * gelu_tanh(bflo(yw.y)), h[3] * gelu_tanh(bfhi(yw.y)));
        *(u32x2*)(MIX + (size_t)m * DM + 1536 + c4) = o;
    }
}

__device__ __forceinline__ void post_rw(u16* __restrict__ MIX, const h16* __restrict__ RWP, const float* __restrict__ BON, const u16* __restrict__ ZG,
                                        const float* __restrict__ g2, const float* __restrict__ lng, const float* __restrict__ lnb) {
    const int tid_ = otid(); const int lane = tid_ & 63, wid = tid_ >> 6; const int bidx = obid(), gdim = ogrid();
    for (int task = bidx * 8 + wid; task < 12 * (MT / 64); task += gdim * 8) {
        const int hh = task % 12, chunk = task / 12, m0 = chunk * 64, b = m0 >> 14, t0 = m0 & (TS - 1);
        const int col = hh * 64 + lane;
        float gc[128];
#pragma unroll
        for (int i = 0; i < 128; ++i) gc[i] = g2[i * 768 + col];
        const float lg = lng[col], lb = lnb[col];
        for (int s4 = 0; s4 < 64; s4 += 4) {
          u16 ly[4]; h16 lv[4]; float lbon[4]; unsigned lsw[4];
#pragma unroll
          for (int k = 0; k < 4; ++k) { const int m = m0 + s4 + k; const size_t rec = (size_t)(b * 12 + hh) * TS + (t0 + s4 + k);
              ly[k] = MIX[(size_t)m * DM + col]; lv[k] = RWP[(rec >> 1) * 768 + (9 + (int)(rec & 1)) * 64 + lane]; lbon[k] = BON[rec]; lsw[k] = *(const unsigned*)(ZG + (size_t)m * 128 + 2 * lane); }
#pragma unroll
          for (int k = 0; k < 4; ++k) {
            const int m = m0 + s4 + k;
            const float y = bf2f(ly[k]);
            const float mean = wave_sum(y) * (1.0f / 64.0f);
            const float d = y - mean;
            const float var = wave_sum(d * d) * (1.0f / 64.0f);
            const float yn = d * rsqrtf(var + 64e-5f) * lg + lb;
            const float v = (float)lv[k];
            const float bonus = lbon[k];
            const unsigned sw = lsw[k];
            const float s0 = bflo(sw), s1 = bfhi(sw);
            float ga = 0.f, gb = 0.f;
#pragma unroll
            for (int i = 0; i < 64; ++i) { ga += rlane(s0, i) * gc[2 * i]; gb += rlane(s1, i) * gc[2 * i + 1]; }
            MIX[(size_t)m * DM + col] = f2bf((yn + bonus * v) * (ga + gb));
          }
        }
    }
}
__device__ __forceinline__ void post_rw2(u16* __restrict__ MIX, const h16* __restrict__ RWP, const float* __restrict__ BON, const u16* __restrict__ ZG,
                                         const u16* __restrict__ G2T, const float* __restrict__ lng, const float* __restrict__ lnb) {
    const int tid_ = otid(); const int lane = tid_ & 63, wid = tid_ >> 6, fr = lane & 15, fq = lane >> 4; const int bidx = obid(), gdim = ogrid();
    for (int task = bidx * 8 + wid; task < 12 * (MT / 16); task += gdim * 8) {
        const int hh = task % 12, chunk = task / 12, mB = chunk * 16, b = mB >> 14, tB = mB & (TS - 1);
        const int j0 = hh * 64 + 4 * fr;
        u32x2 yw[4]; h16x4 vv[4]; float bon[4];
#pragma unroll
        for (int r = 0; r < 4; ++r) { const int m = mB + 4 * fq + r; const size_t rec = (size_t)(b * 12 + hh) * TS + (tB + 4 * fq + r);
            yw[r] = *(const u32x2*)(MIX + (size_t)m * DM + j0); vv[r] = *(const h16x4*)(RWP + (rec >> 1) * 768 + (9 + (int)(rec & 1)) * 64 + 4 * fr); bon[r] = BON[rec]; }
        const f32x4 lg = *(const f32x4*)(lng + j0), lb = *(const f32x4*)(lnb + j0);
        f32x4 acc[4];
#pragma unroll
        for (int n = 0; n < 4; ++n) acc[n] = (f32x4){0.f, 0.f, 0.f, 0.f};
#pragma unroll
        for (int ks = 0; ks < 4; ++ks) {
            const bf16x8_t a_ = *(const bf16x8_t*)(ZG + (size_t)(mB + fr) * 128 + ks * 32 + fq * 8);
#pragma unroll
            for (int n = 0; n < 4; ++n) { const bf16x8_t b_ = *(const bf16x8_t*)(G2T + (size_t)(j0 + n) * 128 + ks * 32 + fq * 8);
                acc[n] = __builtin_amdgcn_mfma_f32_16x16x32_bf16(a_, b_, acc[n], 0, 0, 0); }
        }
#pragma unroll
        for (int r = 0; r < 4; ++r) {
            const int m = mB + 4 * fq + r;
            f32x4 y; y[0] = bflo(yw[r].x); y[1] = bfhi(yw[r].x); y[2] = bflo(yw[r].y); y[3] = bfhi(yw[r].y);
            const float mean = red16((y[0] + y[1]) + (y[2] + y[3])) * (1.0f / 64.0f);
            const f32x4 d = y - mean;
            const float var = red16((d[0] * d[0] + d[1] * d[1]) + (d[2] * d[2] + d[3] * d[3])) * (1.0f / 64.0f);
            const float rs = rsqrtf(var + 64e-5f);
            f32x4 o;
#pragma unroll
            for (int n = 0; n < 4; ++n) o[n] = (d[n] * rs * lg[n] + lb[n] + bon[r] * (float)vv[r][n]) * acc[n][r];
            u32x2 w; w.x = pk_bf(o[0], o[1]); w.y = pk_bf(o[2], o[3]);
            *(u32x2*)(MIX + (size_t)m * DM + j0) = w;
        }
    }
}
__device__ __forceinline__ void post_rw_head(u16* __restrict__ MIX, const h16* __restrict__ RWP, const float* __restrict__ BON, const u16* __restrict__ ZG,
                                             const u16* __restrict__ G2T, const float* __restrict__ lng, const float* __restrict__ lnb, int b, int hh, int chunk0, int nchunk) {
    const int tid_ = otid(); const int lane = tid_ & 63, wid = tid_ >> 6, fr = lane & 15, fq = lane >> 4;
    const int j0 = hh * 64 + 4 * fr;
    bf16x8_t bg[4][4];
#pragma unroll
    for (int ks = 0; ks < 4; ++ks)
#pragma unroll
        for (int n = 0; n < 4; ++n) bg[ks][n] = *(const bf16x8_t*)(G2T + (size_t)(j0 + n) * 128 + ks * 32 + fq * 8);
    const f32x4 lg = *(const f32x4*)(lng + j0), lb = *(const f32x4*)(lnb + j0);
    for (int ci = wid; ci < nchunk; ci += 8) {
        const int tB = (chunk0 + ci) * 16, mB = b * TS + tB;
        u32x2 yw[4]; h16x4 vv[4]; float bon[4];
#pragma unroll
        for (int r = 0; r < 4; ++r) { const int m = mB + 4 * fq + r; const size_t rec = (size_t)(b * 12 + hh) * TS + (tB + 4 * fq + r);
            yw[r] = *(const u32x2*)(MIX + (size_t)m * DM + j0); vv[r] = *(const h16x4*)(RWP + (rec >> 1) * 768 + (9 + (int)(rec & 1)) * 64 + 4 * fr); bon[r] = BON[rec]; }
        f32x4 acc[4];
#pragma unroll
        for (int n = 0; n < 4; ++n) acc[n] = (f32x4){0.f, 0.f, 0.f, 0.f};
#pragma unroll
        for (int ks = 0; ks < 4; ++ks) {
            const bf16x8_t a_ = *(const bf16x8_t*)(ZG + (size_t)(mB + fr) * 128 + ks * 32 + fq * 8);
#pragma unroll
            for (int n = 0; n < 4; ++n) acc[n] = __builtin_amdgcn_mfma_f32_16x16x32_bf16(a_, bg[ks][n], acc[n], 0, 0, 0);
        }
#pragma unroll
        for (int r = 0; r < 4; ++r) {
            const int m = mB + 4 * fq + r;
            f32x4 y; y[0] = bflo(yw[r].x); y[1] = bfhi(yw[r].x); y[2] = bflo(yw[r].y); y[3] = bfhi(yw[r].y);
            const float mean = red16((y[0] + y[1]) + (y[2] + y[3])) * (1.0f / 64.0f);
            const f32x4 d = y - mean;
            const float var = red16((d[0] * d[0] + d[1] * d[1]) + (d[2] * d[2] + d[3] * d[3])) * (1.0f / 64.0f);
            const float rs = rsqrtf(var + 64e-5f);
            f32x4 o;
#pragma unroll
            for (int n = 0; n < 4; ++n) o[n] = (d[n] * rs * lg[n] + lb[n] + bon[r] * (float)vv[r][n]) * acc[n][r];
            u32x2 w; w.x = pk_bf(o[0], o[1]); w.y = pk_bf(o[2], o[3]);
            *(u32x2*)(MIX + (size_t)m * DM + j0) = w;
        }
    }
}
__device__ __forceinline__ void post_gd(u16* __restrict__ MIX, const u16* __restrict__ Z2, const float* __restrict__ ng) {
    const int tid_ = otid(); const int lane = tid_ & 63, wid = tid_ >> 6; const int bidx = obid(), gdim = ogrid();
    for (int task = bidx * 8 + wid; task < 6 * (MT / 32); task += gdim * 8) {
        const int hh = task % 6, chunk = task / 6, m0 = chunk * 32;
        const float n0 = ng[2 * lane], n1 = ng[2 * lane + 1];
        for (int s8 = 0; s8 < 32; s8 += 8) {
          unsigned lo[8], lg[8];
#pragma unroll
          for (int k = 0; k < 8; ++k) { const int m = m0 + s8 + k; lo[k] = *(const unsigned*)(MIX + (size_t)m * DM + 768 + hh * 128 + 2 * lane); lg[k] = *(const unsigned*)(Z2 + (size_t)m * Z2_LD + Z2_GATE + hh * 128 + 2 * lane); }
#pragma unroll
          for (int k = 0; k < 8; ++k) {
            const int m = m0 + s8 + k;
            unsigned* op = (unsigned*)(MIX + (size_t)m * DM + 768 + hh * 128 + 2 * lane);
            const unsigned ow = lo[k];
            const float o0 = bflo(ow), o1 = bfhi(ow);
            const float ss = wave_sum(o0 * o0 + o1 * o1);
            const float rs = rsqrtf(ss * (1.0f / 128.0f) + 1e-6f);
            const unsigned gw = lg[k];
            const float g0 = bflo(gw), g1 = bfhi(gw);
            *op = pk_bf(o0 * rs * n0 * (g0 * sigm(g0)), o1 * rs * n1 * (g1 * sigm(g1)));
          }
        }
    }
}

#define XB_TMO      128
#define XB_XCNT(j)  (256  + 64 * (j))
#define XB_XSUB(j)  (1280 + 64 * (j))
#define XB_XGEN(j)  (2304 + 64 * (j))
#define XB_TOP      3328
#define XB_TOPGEN   3392
#define XCD_BAR_WORDS 3456
#define XB_SPIN_CAP (1u << 18)

__device__ __forceinline__ unsigned xb_ld(unsigned* p)              { return __hip_atomic_load(p, __ATOMIC_RELAXED, __HIP_MEMORY_SCOPE_AGENT); }
__device__ __forceinline__ unsigned xb_add(unsigned* p, unsigned v) { return __hip_atomic_fetch_add(p, v, __ATOMIC_RELAXED, __HIP_MEMORY_SCOPE_AGENT); }
__device__ __forceinline__ unsigned xb_xcc_id() { return (unsigned)__builtin_amdgcn_s_getreg((3 << 11) | 20) & 0xFu; }
#define XB_SPIN(cond, bar) do { unsigned _sp = 0; while (cond) { __builtin_amdgcn_s_sleep(1); \
    if ((++_sp & 255u) == 0u) { if (xb_ld(&(bar)[XB_TMO])) break; if (_sp > XB_SPIN_CAP) { atomicAdd(&(bar)[XB_TMO], 1u); break; } } } } while (0)

struct XcdBarrier {
    unsigned* bar; unsigned x;
    volatile LAS unsigned* st;
};

__device__ __forceinline__ XcdBarrier xcd_barrier_post(unsigned* bar, volatile LAS unsigned* st) {
    XcdBarrier b; b.bar = bar; b.x = xb_xcc_id(); b.st = st;
    if (threadIdx.x == 0) (void)xb_add(&bar[XB_XCNT(b.x)], 1u);
    return b;
}
__device__ __forceinline__ void xcd_barrier_complete(unsigned* bar, unsigned x, unsigned& nloc, unsigned& nx) {
    const unsigned G = gridDim.x * gridDim.y * gridDim.z;
    unsigned sum, cnt, mine, sp = 0u;
    for (;;) {
        sum = 0u; cnt = 0u; mine = 0u;
#pragma unroll
        for (unsigned j = 0; j < 16; ++j) { const unsigned c = xb_ld(&bar[XB_XCNT(j)]); sum += c; cnt += (c > 0u) ? 1u : 0u; mine = (j == x) ? c : mine; }
        if (sum == G) break;
        __builtin_amdgcn_s_sleep(1);
        if ((++sp & 255u) == 0u) { if (xb_ld(&bar[XB_TMO])) break; if (sp > XB_SPIN_CAP) { atomicAdd(&bar[XB_TMO], 1u); break; } }
    }
    nloc = mine > 0u ? mine : 1u; nx = cnt > 0u ? cnt : 1u;
}

__device__ __forceinline__ void xcd_barrier(const XcdBarrier& b) {
    asm volatile("s_waitcnt vmcnt(0)" ::: "memory");
    __syncthreads();
    if (threadIdx.x == 0) {
        unsigned* bar = b.bar;
        __builtin_amdgcn_s_waitcnt(0);
        unsigned nloc = b.st[0], nx = b.st[1];
        if (nloc == 0u) { xcd_barrier_complete(bar, b.x, nloc, nx); b.st[0] = nloc; b.st[1] = nx; }
        const unsigned old = xb_add(&bar[XB_XSUB(b.x)], 1u);
        const unsigned gen = old / nloc;
        if (old + 1u == (gen + 1u) * nloc) {
            __builtin_amdgcn_fence(__ATOMIC_RELEASE, "agent");
            asm volatile("s_waitcnt vmcnt(0)" ::: "memory");
            const unsigned og = xb_add(&bar[XB_TOP], 1u);
            const unsigned tg = og / nx;
            if (og + 1u == (tg + 1u) * nx) xb_add(&bar[XB_TOPGEN], 1u);
            else XB_SPIN(xb_ld(&bar[XB_TOPGEN]) == tg, bar);
            __builtin_amdgcn_fence(__ATOMIC_ACQUIRE, "agent");
            xb_add(&bar[XB_XGEN(b.x)], 1u);
            asm volatile("s_waitcnt vmcnt(0)" ::: "memory");
        } else {
            XB_SPIN(xb_ld(&bar[XB_XGEN(b.x)]) == gen, bar);
            __builtin_amdgcn_fence(__ATOMIC_ACQUIRE, "agent");
            asm volatile("s_waitcnt vmcnt(0)" ::: "memory");
        }
    }
    __syncthreads();
}
__device__ __forceinline__ const float* getp(const LAS unsigned* TAB, int k) {
    const unsigned lo = __builtin_amdgcn_readfirstlane(TAB[2 * k]), hi = __builtin_amdgcn_readfirstlane(TAB[2 * k + 1]);
    return (const float*)(((unsigned long long)hi << 32) | lo);
}
__global__ void __launch_bounds__(512, 2) fwd_mega(Params p) {
    extern __shared__ __attribute__((aligned(16))) unsigned char lds_raw[];
    LAS unsigned char* lds = (LAS unsigned char*)lds_raw;
    cg::grid_group grid = cg::this_grid();
#if REP & 256
#define GSYNC() do { xcd_barrier(xbar); xcd_barrier(xbar); } while (0)
#else
#define GSYNC() xcd_barrier(xbar)
#endif
    unsigned char* ws = p.ws;
    u16* HBUF = (u16*)(ws + WS_HBUF); u16* WGU = (u16*)(ws + WS_WGU); u16* WD = (u16*)(ws + WS_WD); u16* WIN = (u16*)(ws + WS_WIN); u16* WOUT = (u16*)(ws + WS_WOUT);
    u16* ACT = (u16*)(ws + WS_ACT); u16* Z = (u16*)(ws + WS_Z); h16* RWPp = (h16*)(ws + WS_RWP); float* RWSp = (float*)(ws + WS_RWS); u16* ZG = (u16*)(ws + WS_ZG);
    h16* GDPp = (h16*)(ws + WS_GDP); float* GDSp = (float*)(ws + WS_GDS); u16* LRA = (u16*)(ws + WS_LRA); u16* LRUb = (u16*)(ws + WS_LRU); u16* WGU2 = (u16*)(ws + WS_WGU2); u16* WD2 = (u16*)(ws + WS_WD2);
    const bool pre2 = gridDim.x > 208;     float* HIN = (float*)(ws + WS_HIN); float* BONp = (float*)(ws + WS_BON);
    float* X = p.out;
    const int G = gridDim.x, bid = blockIdx.x;
    LAS unsigned* TAB = (LAS unsigned*)(lds + 131072 + 1024);
    if (threadIdx.x == 0) {
#pragma unroll
        for (int i = 0; i < 35; ++i) { const unsigned long long a = (unsigned long long)p.in[i]; TAB[2 * i] = (unsigned)a; TAB[2 * i + 1] = (unsigned)(a >> 32); }
    }
    volatile LAS unsigned* xst = (volatile LAS unsigned*)(lds + 131072 + 512);
    if (threadIdx.x < 2) xst[threadIdx.x] = 0u;
    __syncthreads();
    const XcdBarrier xbar = xcd_barrier_post((unsigned*)(ws + WS_BAR), xst);
    grid.sync();
#define INP(k) getp(TAB, (k))

    for (int l = 0; l < 2; ++l) {
        for (int half = 0; half < 2; ++half) {
            const float* ng = INP(half ? 30 : 1) + (size_t)l * DM;
            const float* wg = INP(half ? 31 : 2) + (size_t)l * DM * DFF;
            const float* wu = INP(half ? 32 : 3) + (size_t)l * DM * DFF;
            const float* wd = INP(half ? 33 : 4) + (size_t)l * DM * DFF;
#if PH & 1
            u16* const WGUc = (half && pre2) ? WGU2 : WGU; u16* const WDc = (half && pre2) ? WD2 : WD;
            if (!(half && pre2)) {
            conv_w<1>(wg, WGUc, DM, DFF, (LAS float*)lds);
            conv_w<2>(wu, WGUc, DM, DFF, (LAS float*)lds);
            conv_w<0>(wd, WDc, DFF, DM, (LAS float*)lds);
            }
#endif
#if PH & 2
            if (l == 0 && half == 0) norm_rows<false>(INP(0), ng, HBUF, nullptr); else norm_rows<false>(X, ng, HBUF, nullptr);
#endif
#if REP & 32
            conv_w<1>(wg, WGU, DM, DFF, (LAS float*)lds);
            conv_w<2>(wu, WGU, DM, DFF, (LAS float*)lds);
            conv_w<0>(wd, WD, DFF, DM, (LAS float*)lds);
#endif
#if REP & 64
            if (l == 0 && half == 0) norm_rows<false>(INP(0), ng, HBUF, X); else norm_rows<false>(X, ng, HBUF, nullptr);
#endif
            GSYNC();
#if PH & 4
            { pg8::Gemm g{HBUF, WGUc, MT, 2 * DFF, DM}; pg8::StaticOrder S; S.init(MT, 2 * DFF, G, bid); pg8::EpiGU E{ACT, DFF};
              pg8::gemm_phase<pg8::EpiGU, pg8::StaticOrder>(lds, g, S, E);
#if REP & 1
              GSYNC(); pg8::gemm_phase<pg8::EpiGU, pg8::StaticOrder>(lds, g, S, E);
#endif
            }
#endif
            GSYNC();
#if PH & 8
            { pg8::Gemm g{ACT, WDc, MT, DM, DFF}; pg8::StaticOrder S; S.init(MT, DM, G, bid); pg8::EpiResid E{(l == 0 && half == 0) ? INP(0) : (const float*)X, X, DM, (REP & 2) ? 0.25f : 0.5f};
              pg8::gemm_phase<pg8::EpiResid, pg8::StaticOrder, true>(lds, g, S, E);
#if REP & 2
              GSYNC(); pg8::gemm_phase<pg8::EpiResid, pg8::StaticOrder, true>(lds, g, S, E);
#endif
            }
#endif
            GSYNC();
            if (half == 1) continue;
#if PH & 16
            conv_w<3>(INP(6) + (size_t)l * DM * 6668, WIN, DM, 6668, (LAS float*)lds);
            conv_w<0>(INP(29) + (size_t)l * DM * DM, WOUT, DM, DM, (LAS float*)lds);
            tr_small(INP(9) + l * 64 * 768, (u16*)(ws + WS_W2T), 64); tr_small(INP(11) + l * 64 * 768, (u16*)(ws + WS_A2T), 64); tr_small(INP(12) + l * 128 * 768, (u16*)(ws + WS_G2T), 128);
            tr_blocks(INP(24) + l * 8 * 64 * 64, (u16*)(ws + WS_WAT)); tr_blocks(INP(26) + l * 8 * 64 * 64, (u16*)(ws + WS_WXT));
            norm_rows<false>(X, INP(5) + (size_t)l * DM, HBUF, nullptr);
#endif
            GSYNC();
#if PH & 32
            { pg8::Gemm g{HBUF, WIN, MT, 2560, DM}; pg8::StaticOrder S; S.init(MT, 2560, G, bid); pg8::EpiZ E{Z, Z1_LD};
              pg8::gemm_phase<pg8::EpiZ, pg8::StaticOrder>(lds, g, S, E); }
#endif
            GSYNC();
#if PH & 64
            { RwP P{INP(7) + l * 2560, INP(8) + l * 768, INP(9) + l * 64 * 768, INP(10) + l * 768, INP(11) + l * 64 * 768, INP(13) + l * 768, INP(14) + l * 768, INP(15) + l * 768};
              prep_rw2(Z, P, (const u16*)(ws + WS_W2T), (const u16*)(ws + WS_A2T), RWPp, RWSp, BONp, ZG, lds);
#if REP & 8
              prep_rw2(Z, P, (const u16*)(ws + WS_W2T), (const u16*)(ws + WS_A2T), RWPp, RWSp, BONp, ZG, lds);
#endif
            }
#endif
            GSYNC();
#if PH & 128
            { pg8::Gemm g{HBUF, WIN + (size_t)2560 * DM, MT, 4352, DM}; pg8::StaticOrder S; S.init(MT, 4352, G, bid); pg8::EpiZ E{Z, Z2_LD};
              pg8::gemm_phase<pg8::EpiZ, pg8::StaticOrder>(lds, g, S, E); }
#endif
            GSYNC();
#if PH & 256
            prep_gd(Z, INP(18) + l * 4 * 2304, INP(19) + l * 6, INP(20) + l * 6, GDPp, GDSp);
#endif
#if PH & 512
            { LrP P{INP(22) + l * 4 * 512, INP(23) + l * 512, INP(24) + l * 8 * 64 * 64, INP(25) + l * 512, INP(26) + l * 8 * 64 * 64, INP(27) + l * 512, INP(28) + l * 512};
              if (!pre2) prep_lr2(Z, P, (const u16*)(ws + WS_WAT), (const u16*)(ws + WS_WXT), LRA, LRUb, lds);
            }
#endif
            GSYNC();
#if PH & 1024
            for (int rep_ = 0; rep_ < ((REP & 4) ? 2 : 1); ++rep_)
            for (int task = bid; task < 208; task += G) {
                if (task < 96) { const int bh = task >> 2, q4 = task & 3, b = bh / 12, hh = bh % 12;
                    rec_block<0>((const unsigned char*)RWPp + (size_t)bh * TS * 768, (const unsigned char*)RWSp + (size_t)bh * TS * 16,
                                 HBUF + (size_t)b * TS * DM + hh * 64 + q4 * 16, q4 * 16, lds);
                    __threadfence();
                    __syncthreads();
                    if (threadIdx.x == 0) {
                        unsigned* cnt = (unsigned*)(ws + WS_BAR + 14336) + bh;
                        __hip_atomic_fetch_add(cnt, 1u, __ATOMIC_RELAXED, __HIP_MEMORY_SCOPE_AGENT);
                        const unsigned want = 4u * (unsigned)(l + 1); unsigned spins = 0;
                        while (__hip_atomic_load(cnt, __ATOMIC_RELAXED, __HIP_MEMORY_SCOPE_AGENT) < want) { __builtin_amdgcn_s_sleep(8); if (++spins > (1u << 22)) break; }
                        __builtin_amdgcn_fence(__ATOMIC_ACQUIRE, "agent");
                        asm volatile("s_waitcnt vmcnt(0)" ::: "memory");
                    }
                    __syncthreads();
                    post_rw_head(HBUF, RWPp, BONp, ZG, (const u16*)(ws + WS_G2T), INP(16) + l * 768, INP(17) + l * 768, b, hh, q4 * (TS / 64), TS / 64); }
                else if (task < 192) { const int gb = task - 96, bh = gb >> 3, o8 = gb & 7, b = bh / 6, hh = bh % 6;
                    rec_block<1>((const unsigned char*)GDPp + (size_t)bh * TS * 768, (const unsigned char*)GDSp + (size_t)bh * TS * 16,
                                 HBUF + (size_t)b * TS * DM + 768 + hh * 128 + o8 * 16, o8 * 16, lds); }
                else if (threadIdx.x < 64) {
                    if (pre2) { unsigned* c3 = (unsigned*)(ws + WS_BAR + 14336) + 48; const unsigned want3 = (unsigned)(G - 208) * (unsigned)(l + 1); unsigned spins = 0;
                        while (__hip_atomic_load(c3, __ATOMIC_RELAXED, __HIP_MEMORY_SCOPE_AGENT) < want3) { __builtin_amdgcn_s_sleep(8); if (++spins > (1u << 22)) break; }
                        __builtin_amdgcn_fence(__ATOMIC_ACQUIRE, "agent"); asm volatile("s_waitcnt vmcnt(0)" ::: "memory"); }
                    lru_carry(task - 192, LRA, LRUb, HIN);
                    __threadfence();
                    if (threadIdx.x == 0) __hip_atomic_fetch_add((unsigned*)(ws + WS_BAR + 14336) + 32, 1u, __ATOMIC_RELAXED, __HIP_MEMORY_SCOPE_AGENT); }
            }
            if (pre2 && bid >= 208) {
                { LrP P{INP(22) + l * 4 * 512, INP(23) + l * 512, INP(24) + l * 8 * 64 * 64, INP(25) + l * 512, INP(26) + l * 8 * 64 * 64, INP(27) + l * 512, INP(28) + l * 512};
                  prep_lr2(Z, P, (const u16*)(ws + WS_WAT), (const u16*)(ws + WS_WXT), LRA, LRUb, lds, bid - 208, G - 208); }
                __threadfence();
                __syncthreads();
                if (threadIdx.x == 0) __hip_atomic_fetch_add((unsigned*)(ws + WS_BAR + 14336) + 48, 1u, __ATOMIC_RELAXED, __HIP_MEMORY_SCOPE_AGENT);
                conv_w<1>(INP(31) + (size_t)l * DM * DFF, WGU2, DM, DFF, (LAS float*)lds, bid - 208, G - 208);
                conv_w<2>(INP(32) + (size_t)l * DM * DFF, WGU2, DM, DFF, (LAS float*)lds, bid - 208, G - 208);
                conv_w<0>(INP(33) + (size_t)l * DM * DFF, WD2, DFF, DM, (LAS float*)lds, bid - 208, G - 208);
                if (threadIdx.x == 0) {
                    unsigned* cnt = (unsigned*)(ws + WS_BAR + 14336) + 32; const unsigned want = 16u * (unsigned)(l + 1); unsigned spins = 0;
                    while (__hip_atomic_load(cnt, __ATOMIC_RELAXED, __HIP_MEMORY_SCOPE_AGENT) < want) { __builtin_amdgcn_s_sleep(8); if (++spins > (1u << 22)) break; }
                    __builtin_amdgcn_fence(__ATOMIC_ACQUIRE, "agent");
                    asm volatile("s_waitcnt vmcnt(0)" ::: "memory");
                }
                __syncthreads();
                post_lr(HBUF, Z, LRA, LRUb, HIN, bid - 208, G - 208);
            }
#endif
            GSYNC();
#if PH & 2048
#endif
#if PH & 4096
            post_gd(HBUF, Z, INP(21) + l * 128);
            if (!pre2) post_lr(HBUF, Z, LRA, LRUb, HIN);
#endif
            GSYNC();
#if PH & 8192
            { pg8::Gemm g{HBUF, WOUT, MT, DM, DM}; pg8::StaticOrder S; S.init(MT, DM, G, bid); pg8::EpiResid E{X, X, DM, 1.0f};
              pg8::gemm_phase<pg8::EpiResid, pg8::StaticOrder>(lds, g, S, E); }
#endif
            GSYNC();
        }
    }
    norm_rows<true>(X, INP(34), nullptr, X);
}

extern "C" void kernel_launch(void* const* d_in, const int* in_sizes, int n_in, void* d_out, int out_size, void* d_ws, size_t ws_size, hipStream_t stream) {
    static int grid_blocks = 0;
    if (!grid_blocks) {
        int dev = 0, cus = 0, per_cu = 0;
        (void)hipGetDevice(&dev);
        (void)hipDeviceGetAttribute(&cus, hipDeviceAttributeMultiprocessorCount, dev);
        (void)hipFuncSetAttribute((const void*)fwd_mega, hipFuncAttributeMaxDynamicSharedMemorySize, LDS_BYTES);
        (void)hipOccupancyMaxActiveBlocksPerMultiprocessor(&per_cu, (const void*)fwd_mega, 512, LDS_BYTES);
        grid_blocks = cus > 0 ? cus : 256;
        if (ws_size < WS_END) fprintf(stderr, "kernel_launch: workspace too small: %zu < %zu\n", ws_size, (size_t)WS_END);
        fprintf(stderr, "kernel_launch: cus %d occupancy %d ws %zu n_in %d\n", cus, per_cu, ws_size, n_in);
    }
    Params p{};
    for (int i = 0; i < 35; ++i) p.in[i] = (const float*)d_in[i];
    p.out = (float*)d_out; p.ws = (unsigned char*)d_ws;
    (void)hipMemsetAsync((unsigned char*)d_ws + WS_BAR, 0, 16384, stream);
    void* args[] = {&p};
    hipError_t e = hipLaunchCooperativeKernel((const void*)fwd_mega, dim3(grid_blocks), dim3(512), args, LDS_BYTES, stream);
    if (e != hipSuccess) fprintf(stderr, "cooperative launch failed: %s (grid %d)\n", hipGetErrorString(e), grid_blocks);
}
```

```cpp
#include <hip/hip_runtime.h>
#include <hip/hip_cooperative_groups.h>
#include <cstdio>
namespace cg = cooperative_groups;
#include <hip/hip_runtime.h>
namespace pg8 {
#define PG8_LAS __attribute__((address_space(3)))
typedef unsigned short bf16_t;
typedef short bf16x8 __attribute__((ext_vector_type(8)));
typedef float f32x4 __attribute__((ext_vector_type(4)));
typedef unsigned u32x4 __attribute__((ext_vector_type(4)));
constexpr int BM = 256, BK = 64, HALF = 128, HTB = HALF * BK * 2  , STAGE_BYTES = 8 * HTB, NXCD = 8, WGM = 8;

__host__ __device__ __forceinline__ int lds_byte(int r, int c) { const int st = (r >> 4) * 2 + (c >> 5), rr = r & 15, cc = c & 31, ob = rr * 64 + cc * 2; return st * 1024 + (ob ^ (((ob >> 9) & 1) << 5)); }
__host__ __device__ __forceinline__ void stage_rc(int b, int& R, int& C) { const int st = b / 1024, sb = b % 1024, swz = sb ^ (((sb >> 9) & 1) << 5); R = (st >> 1) * 16 + swz / 64; C = (st & 1) * 32 + (swz % 64) / 2; }
__host__ __device__ __forceinline__ int perm32(int rho) { const int n = rho >> 4, i = rho & 15; return 8 * (i >> 2) + 4 * n + (i & 3); }

struct Unit { int pm, pn; };
struct Gemm { const bf16_t* A; const bf16_t* Bt; int M, N, K; };

struct StaticOrder {
    int nM, nN, nwg, G, c;
    __host__ __device__ void init(int M, int N, int G_, int c_) { nM = M / BM; nN = N / BM; nwg = nM * nN; G = G_; c = c_; }
    __host__ __device__ bool next(int i, Unit& u) const {
        const long L = (long)i * G + c; if (L >= nwg) return false;
        int wgid = (int)L; { const int q = nwg / NXCD, r = nwg % NXCD, xcd = wgid % NXCD, off = wgid / NXCD; wgid = (xcd < r ? xcd * (q + 1) : r * (q + 1) + (xcd - r) * q) + off; }
        const int nig = WGM * nN, gid = wgid / nig, fm = gid * WGM, gsz = (nM - fm) < WGM ? (nM - fm) : WGM;
        u.pm = fm + ((wgid % nig) % gsz); u.pn = (wgid % nig) / gsz; return true;
    }
    __device__ __forceinline__ void a_ready(const Unit&) const {}
    __device__ __forceinline__ void done(const Unit&) const {}
};
__device__ __forceinline__ unsigned cvt_pk_bf16(float lo, float hi) { unsigned r; asm volatile("v_cvt_pk_bf16_f32 %0, %1, %2" : "=v"(r) : "v"(lo), "v"(hi)); return r; }
typedef float f32x2 __attribute__((ext_vector_type(2)));
typedef unsigned u32x2 __attribute__((ext_vector_type(2)));
__device__ __forceinline__ float fast_silu(float g) { return g * __builtin_amdgcn_rcpf(1.0f + __expf(-g)); }
struct EpiGU {
    static constexpr bool PERM = true, AFTER_DRAIN = false;
    bf16_t* O; int ldc;
    __device__ __forceinline__ void operator()(const f32x4 (&acc)[2][2][4][2], const Unit& u, int wr, int wc, int fr, int fq) const {
        const int rl0 = wr * 64 + fr, col0 = u.pn * HALF + wc * 32 + 8 * fq;
        bf16_t* const blk = O + ((size_t)u.pm * (ldc >> 6) + (col0 >> 6)) * (BM * 64) + (col0 & 63);
#pragma unroll
        for (int ai = 0; ai < 2; ++ai)
#pragma unroll
            for (int m = 0; m < 4; ++m) { bf16_t* rowp = blk + (size_t)(rl0 + ai * HALF + m * 16) * 64;
                const f32x4 g0 = acc[ai][0][m][0], g1 = acc[ai][0][m][1], u0 = acc[ai][1][m][0], u1 = acc[ai][1][m][1];
                f32x4 h0, h1;
#pragma unroll
                for (int j = 0; j < 4; ++j) { h0[j] = fast_silu(g0[j]) * u0[j]; h1[j] = fast_silu(g1[j]) * u1[j]; }
                u32x4 w; w.x = cvt_pk_bf16(h0[0], h0[1]); w.y = cvt_pk_bf16(h0[2], h0[3]); w.z = cvt_pk_bf16(h1[0], h1[1]); w.w = cvt_pk_bf16(h1[2], h1[3]);
                *(u32x4*)rowp = w; }
    }
};
struct EpiZ {
    static constexpr bool PERM = true, AFTER_DRAIN = false;
    bf16_t* O; int ldc;
    __device__ __forceinline__ void operator()(const f32x4 (&acc)[2][2][4][2], const Unit& u, int wr, int wc, int fr, int fq) const {
        const int row0 = u.pm * BM + wr * 64 + fr, col0 = u.pn * BM + wc * 32 + 8 * fq;
#pragma unroll
        for (int ai = 0; ai < 2; ++ai)
#pragma unroll
            for (int m = 0; m < 4; ++m) { bf16_t* rowp = O + (size_t)(row0 + ai * HALF + m * 16) * ldc + col0;
#pragma unroll
                for (int bj = 0; bj < 2; ++bj) { const f32x4 v0 = acc[ai][bj][m][0], v1 = acc[ai][bj][m][1];
                    u32x4 w; w.x = cvt_pk_bf16(v0[0], v0[1]); w.y = cvt_pk_bf16(v0[2], v0[3]); w.z = cvt_pk_bf16(v1[0], v1[1]); w.w = cvt_pk_bf16(v1[2], v1[3]);
                    *(u32x4*)(rowp + bj * HALF) = w; } }
    }
};
struct EpiResid {
    static constexpr bool PERM = true, AFTER_DRAIN = false;
    const float* Xs; float* X; int ldc; float scale;
    __device__ __forceinline__ void operator()(const f32x4 (&acc)[2][2][4][2], const Unit& u, int wr, int wc, int fr, int fq) const {
        const int row0 = u.pm * BM + wr * 64 + fr, col0 = u.pn * BM + wc * 32 + 8 * fq;
#pragma unroll
        for (int ai = 0; ai < 2; ++ai)
#pragma unroll
            for (int m = 0; m < 4; ++m) { const size_t off = (size_t)(row0 + ai * HALF + m * 16) * ldc + col0;
#pragma unroll
                for (int bj = 0; bj < 2; ++bj) { const size_t o2 = off + bj * HALF;
                    const f32x4 x0 = *(const f32x4*)(Xs + o2) + acc[ai][bj][m][0] * scale, x1 = *(const f32x4*)(Xs + o2 + 4) + acc[ai][bj][m][1] * scale;
                    *(f32x4*)(X + o2) = x0; *(f32x4*)(X + o2 + 4) = x1; } }
    }
};
template <class Epi, class Sched, bool ABLK = false>
__device__ __forceinline__ void gemm_phase(PG8_LAS unsigned char* lds, const Gemm g, const Sched& S, const Epi& E) {
    int tid_o = threadIdx.x; asm volatile("" : "+v"(tid_o));
    const int tid = tid_o, wid = __builtin_amdgcn_readfirstlane(tid >> 6), lane = tid & 63, wr = wid >> 2, wc = wid & 3, fr = lane & 15, fq = lane >> 4;
    const int K = g.K, nt = K / BK;
    unsigned voffA[2], voffB[2];
#pragma unroll
    for (int i = 0; i < 2; ++i) { int R, C; stage_rc(tid * 16 + i * 8192, R, C); const int Rb = Epi::PERM ? ((R & ~31) + perm32(R & 31)) : R;
        voffA[i] = ABLK ? (unsigned)(R * BK + C) * 2u : (unsigned)(R * K + C) * 2u; voffB[i] = (unsigned)(Rb * K + C) * 2u; }
    const size_t kstep = (size_t)(BK * 2);
    const size_t hstep = (size_t)HALF * K * 2;
    const size_t tstep = 2 * hstep;
    const size_t kstepA = ABLK ? (size_t)(BM * BK * 2) : kstep, hstepA = ABLK ? (size_t)(HALF * BK * 2) : hstep, tstepA = tstep;
    const unsigned ldsw = (unsigned)wid * 1024u;
    const int aoff = lds_byte(wr * 64 + fr, fq * 8), boff = lds_byte(wc * 32 + fr, fq * 8);
#define PG8_SA(b, h) (((b) * 2 + (h)) * HTB)
#define PG8_SB(b, h) ((4 + (b) * 2 + (h)) * HTB)
#define PG8_STAGE(bufoff, gbase, voff) do { _Pragma("unroll") for (int _i = 0; _i < 2; ++_i) \
        __builtin_amdgcn_global_load_lds((const unsigned*)((const char*)(gbase) + (voff)[_i]), (PG8_LAS unsigned*)(lds + (bufoff) + ldsw + _i * 8192), 16, 0, 0); } while (0)
#define PG8_LDA(dst, b, h) do { _Pragma("unroll") for (int m = 0; m < 4; ++m) _Pragma("unroll") for (int k = 0; k < 2; ++k) dst[m][k] = *(const PG8_LAS bf16x8*)(lds + PG8_SA(b, h) + aoff + m * 2048 + k * 1024); } while (0)
#define PG8_LDB(dst, b, h) do { _Pragma("unroll") for (int n = 0; n < 2; ++n) _Pragma("unroll") for (int k = 0; k < 2; ++k) dst[n][k] = *(const PG8_LAS bf16x8*)(lds + PG8_SB(b, h) + boff + n * 2048 + k * 1024); } while (0)
#define PG8_MMA(ai, bj, At, Bt) do { __builtin_amdgcn_s_setprio(1); _Pragma("unroll") for (int m = 0; m < 4; ++m) _Pragma("unroll") for (int n = 0; n < 2; ++n) _Pragma("unroll") for (int k = 0; k < 2; ++k) \
        acc[ai][bj][m][n] = __builtin_amdgcn_mfma_f32_16x16x32_bf16(Bt[n][k], At[m][k], acc[ai][bj][m][n], 0, 0, 0); __builtin_amdgcn_s_setprio(0); } while (0)
#define PG8_WAIT_V(n) asm volatile("s_waitcnt vmcnt(" #n ")" ::: "memory")
#define PG8_WAIT_L(n) asm volatile("s_waitcnt lgkmcnt(" #n ")" ::: "memory")
#define PG8_BAR __builtin_amdgcn_s_barrier()
#define PG8_SCHED __builtin_amdgcn_sched_barrier(0)
    Unit cur, nxt; int ui = 0;
    if (!S.next(0, cur)) return;
    f32x4 acc[2][2][4][2];
#pragma unroll
    for (int a = 0; a < 2; ++a)
#pragma unroll
        for (int b = 0; b < 2; ++b)
#pragma unroll
            for (int m = 0; m < 4; ++m)
#pragma unroll
                for (int n = 0; n < 2; ++n) acc[a][b][m][n] = (f32x4){0.f, 0.f, 0.f, 0.f};
    bf16x8 At[4][2], B0[2][2], B1[2][2];
    const char* cA = (const char*)g.A + (size_t)cur.pm * tstepA; const char* cB = (const char*)g.Bt + (size_t)cur.pn * tstep;
    S.a_ready(cur);
    PG8_STAGE(PG8_SB(0, 0), cB, voffB); PG8_STAGE(PG8_SA(0, 0), cA, voffA); PG8_STAGE(PG8_SB(0, 1), cB + hstep, voffB); PG8_STAGE(PG8_SA(0, 1), cA + hstepA, voffA);
    if (wr == 1) PG8_BAR;
    PG8_WAIT_V(4); PG8_BAR;
    PG8_STAGE(PG8_SB(1, 0), cB + kstep, voffB); PG8_STAGE(PG8_SA(1, 0), cA + kstepA, voffA); PG8_STAGE(PG8_SB(1, 1), cB + hstep + kstep, voffB);
    PG8_WAIT_V(6); PG8_BAR;
    for (;;) {
        const bool has_next = S.next(ui + 1, nxt);
        const char* nA = has_next ? (const char*)g.A + (size_t)nxt.pm * tstepA : cA; const char* nB = has_next ? (const char*)g.Bt + (size_t)nxt.pn * tstep : cB;
        for (int t = 0; t < nt; t += 2) {
            const bool last = (t == nt - 2);
            const char* a1 = cA + (size_t)(t + 1) * kstepA;
            const char* a2 = last ? nA : cA + (size_t)(t + 2) * kstepA; const char* b2 = last ? nB : cB + (size_t)(t + 2) * kstep;
            const char* a3 = a2 + kstepA; const char* b3 = b2 + kstep;
            if (last && has_next) S.a_ready(nxt);
            PG8_LDB(B0, 0, 0); PG8_SCHED; PG8_LDA(At, 0, 0); PG8_STAGE(PG8_SA(1, 1), a1 + hstepA, voffA);
            PG8_WAIT_L(8); PG8_BAR; PG8_WAIT_L(0); PG8_MMA(0, 0, At, B0); PG8_BAR; PG8_SCHED;
            PG8_LDB(B1, 0, 1); PG8_STAGE(PG8_SB(0, 0), b2, voffB);
            PG8_BAR; PG8_WAIT_L(0); PG8_MMA(0, 1, At, B1); PG8_BAR;
            PG8_LDA(At, 0, 1); PG8_STAGE(PG8_SA(0, 0), a2, voffA);
            PG8_BAR; PG8_WAIT_L(0); PG8_MMA(1, 0, At, B0); PG8_BAR; PG8_SCHED;
            PG8_STAGE(PG8_SB(0, 1), b2 + hstep, voffB);
            PG8_WAIT_V(6); PG8_BAR; PG8_MMA(1, 1, At, B1); PG8_BAR;
            PG8_LDB(B0, 1, 0); PG8_SCHED; PG8_LDA(At, 1, 0); PG8_STAGE(PG8_SA(0, 1), a2 + hstepA, voffA);
            PG8_WAIT_L(8); PG8_BAR; PG8_WAIT_L(0); PG8_MMA(0, 0, At, B0); PG8_BAR; PG8_SCHED;
            PG8_LDB(B1, 1, 1); PG8_STAGE(PG8_SB(1, 0), b3, voffB);
            PG8_BAR; PG8_WAIT_L(0); PG8_MMA(0, 1, At, B1); PG8_BAR;
            PG8_LDA(At, 1, 1); PG8_STAGE(PG8_SA(1, 0), a3, voffA);
            PG8_BAR; PG8_WAIT_L(0); PG8_MMA(1, 0, At, B0); PG8_BAR; PG8_SCHED;
            PG8_STAGE(PG8_SB(1, 1), b3 + hstep, voffB);
            PG8_WAIT_V(6); PG8_BAR; PG8_MMA(1, 1, At, B1); PG8_BAR;
        }
        if constexpr (!Epi::AFTER_DRAIN) { E(acc, cur, wr, wc, fr, fq); S.done(cur); }
        if (!has_next) break;
#pragma unroll
        for (int a = 0; a < 2; ++a)
#pragma unroll
            for (int b = 0; b < 2; ++b)
#pragma unroll
                for (int m = 0; m < 4; ++m)
#pragma unroll
                    for (int n = 0; n < 2; ++n) acc[a][b][m][n] = (f32x4){0.f, 0.f, 0.f, 0.f};
        cur = nxt; cA = nA; cB = nB; ++ui;
    }
    PG8_WAIT_V(0);
    if (wr == 0) PG8_BAR;
    PG8_BAR;
    if constexpr (Epi::AFTER_DRAIN) { E.fused(acc, cur, wr, wc, fr, fq, lds, wid, lane); S.done(cur); }
#undef PG8_SA
#undef PG8_SB
#undef PG8_STAGE
#undef PG8_LDA
#undef PG8_LDB
#undef PG8_MMA
#undef PG8_WAIT_V
#undef PG8_WAIT_L
#undef PG8_BAR
#undef PG8_SCHED
}
}
#ifndef PH
#define PH 0xFFFF
#endif
#ifndef REP
#define REP 0
#endif
typedef unsigned short u16;
typedef float f32x4 __attribute__((ext_vector_type(4)));
typedef float f32x2 __attribute__((ext_vector_type(2)));
typedef unsigned u32x4 __attribute__((ext_vector_type(4)));
typedef unsigned u32x2 __attribute__((ext_vector_type(2)));
typedef _Float16 h16;
typedef _Float16 h16x4 __attribute__((ext_vector_type(4)));
typedef _Float16 h16x8 __attribute__((ext_vector_type(8)));
typedef _Float16 h16x2 __attribute__((ext_vector_type(2)));
#define LAS __attribute__((address_space(3)))

constexpr int MT = 32768, TS = 16384, DM = 2048, DFF = 5632;
constexpr int LDS_BYTES = 144 * 1024;
constexpr size_t WS_HBUF = 0;
constexpr size_t WS_WBUF = 134217728;
constexpr size_t WS_WGU = WS_WBUF, WS_WD = WS_WBUF + 46137344;
constexpr size_t WS_WIN = WS_WBUF, WS_WOUT = WS_WBUF + 28311552;
constexpr size_t WS_ACT = WS_WBUF + 69206016;
constexpr size_t WS_Z = WS_WBUF + 36700160;
constexpr size_t WS_RWP = WS_Z + 285212672;
constexpr size_t WS_RWS = WS_RWP + 301989888;
constexpr size_t WS_ZG = WS_RWS + 6291456;
constexpr size_t WS_GDP = WS_ZG + 8388608;
constexpr size_t WS_GDS = WS_GDP + 150994944;
constexpr size_t WS_LRA = WS_GDS + 3145728;
constexpr size_t WS_LRU = WS_LRA + 33554432;
constexpr size_t WS_WGU2 = WS_LRU + 33554432;
constexpr size_t WS_WD2 = WS_WGU2 + 46137344;
constexpr size_t WS_HIN = WS_WD2 + 23068672;
constexpr size_t WS_BON = WS_HIN + 1048576;
constexpr size_t WS_BAR = WS_BON + 1572864;
constexpr size_t WS_W2T = WS_BAR + 16384;
constexpr size_t WS_A2T = WS_W2T + 98304;
constexpr size_t WS_G2T = WS_A2T + 98304;
constexpr size_t WS_WAT = WS_G2T + 196608;
constexpr size_t WS_WXT = WS_WAT + 65536;
constexpr size_t WS_END = WS_WXT + 65536;
static_assert(WS_END <= 1073741824ull, "workspace");
constexpr int Z1_LD = 2560, Z2_LD = 4352;
constexpr int Z2_GATE = 2304, Z2_XL = 3072, Z2_YL = 3584, Z2_ZB = 4096, Z2_ZA = 4102;

struct Params { const float* in[35]; float* out; unsigned char* ws; };

__device__ __forceinline__ int otid() { int t = threadIdx.x; asm volatile("" : "+v"(t)); return t; }
__device__ __forceinline__ int obid() { int t = blockIdx.x; asm volatile("" : "+s"(t)); return t; }
__device__ __forceinline__ int ogrid() { int t = gridDim.x; asm volatile("" : "+s"(t)); return t; }
__device__ __forceinline__ float bf2f(u16 h) { return __uint_as_float((unsigned)h << 16); }
__device__ __forceinline__ float bflo(unsigned w) { return __uint_as_float(w << 16); }
__device__ __forceinline__ float bfhi(unsigned w) { return __uint_as_float(w & 0xffff0000u); }
__device__ __forceinline__ u16 f2bf(float f) { unsigned u = __float_as_uint(f); u += 0x7FFFu + ((u >> 16) & 1u); return (u16)(u >> 16); }
__device__ __forceinline__ unsigned pk_bf(float lo, float hi) { return pg8::cvt_pk_bf16(lo, hi); }
template <int C> __device__ __forceinline__ float dppf(float v) { return __int_as_float(__builtin_amdgcn_update_dpp(0, __float_as_int(v), C, 0xF, 0xF, true)); }
template <int H> __device__ __forceinline__ float fmix(float a, unsigned hp, float c) { float d;
    if (H == 0) asm("v_fma_mix_f32 %0, %1, %2, %3 op_sel_hi:[0,1,0]" : "=v"(d) : "v"(a), "v"(hp), "v"(c));
    else        asm("v_fma_mix_f32 %0, %1, %2, %3 op_sel:[0,1,0] op_sel_hi:[0,1,0]" : "=v"(d) : "v"(a), "v"(hp), "v"(c));
    return d; }
template <int H> __device__ __forceinline__ float fmixn(float a, unsigned hp, float c) { float d;
    if (H == 0) asm("v_fma_mix_f32 %0, -%1, %2, %3 op_sel_hi:[0,1,0]" : "=v"(d) : "v"(a), "v"(hp), "v"(c));
    else        asm("v_fma_mix_f32 %0, -%1, %2, %3 op_sel:[0,1,0] op_sel_hi:[0,1,0]" : "=v"(d) : "v"(a), "v"(hp), "v"(c));
    return d; }
__device__ __forceinline__ float red16(float v) { v += dppf<0xB1>(v); v += dppf<0x4E>(v); v += dppf<0x141>(v); v += dppf<0x140>(v); return v; }
__device__ __forceinline__ float rlane(float v, int l) { return __int_as_float(__builtin_amdgcn_readlane(__float_as_int(v), l)); }
__device__ __forceinline__ float wave_sum(float v) { v = red16(v);
    v += __int_as_float(__builtin_amdgcn_update_dpp(0, __float_as_int(v), 0x142, 0xA, 0xF, false));
    v += __int_as_float(__builtin_amdgcn_update_dpp(0, __float_as_int(v), 0x143, 0xC, 0xF, false));
    return rlane(v, 63); }
__device__ __forceinline__ float sigm(float x) { return __builtin_amdgcn_rcpf(1.0f + __expf(-x)); }
__device__ __forceinline__ float softplus_(float x) { return fmaxf(x, 0.0f) + __logf(1.0f + __expf(-fabsf(x))); }
__device__ __forceinline__ float tanh_(float x) { const float e = __expf(-2.0f * fabsf(x)); const float t = (1.0f - e) * __builtin_amdgcn_rcpf(1.0f + e); return x < 0.f ? -t : t; }
__device__ __forceinline__ float gelu_tanh(float x) { return 0.5f * x * (1.0f + tanh_(0.7978845608028654f * (x + 0.044715f * x * x * x))); }

template <int MAP> __device__ __forceinline__ int rowmap(int n) {
    if (MAP == 0) return n;
    if (MAP == 1) return (n >> 7) * 256 + (n & 127);
    if (MAP == 2) return (n >> 7) * 256 + 128 + (n & 127);
    if (n < 2560 + 3072) return n;
    const int q = n - 2560;
    if (q < 3084) return 2560 + Z2_ZB + (q - 3072);
    return 2560 + Z2_XL + (q - 3084);
}
template <int MAP> __device__ __forceinline__ void conv_w(const float* __restrict__ src, u16* __restrict__ dst, int K, int N, LAS float* tile, int bsub = 0, int gsub = 0) {
    const int tid = otid(), NT = (N + 63) >> 6, KT = K >> 6; const int bidx = gsub ? bsub : obid(), gdim = gsub ? gsub : ogrid();
    for (int t = bidx; t < NT * KT; t += gdim) {
        const int nt = t % NT, kt = t / NT;
        const int c = tid & 63, r0 = tid >> 6, n = nt * 64 + c;
#pragma unroll
        for (int i = 0; i < 8; ++i) { const int r = r0 + 8 * i; tile[r * 65 + c] = (n < N) ? src[(size_t)(kt * 64 + r) * N + n] : 0.f; }
        __syncthreads();
        const int nl = tid >> 3, kq = tid & 7, n2 = nt * 64 + nl;
        if (n2 < N) {
            float v[8];
#pragma unroll
            for (int j = 0; j < 8; ++j) v[j] = tile[(kq * 8 + j) * 65 + nl];
            u32x4 w; w.x = pk_bf(v[0], v[1]); w.y = pk_bf(v[2], v[3]); w.z = pk_bf(v[4], v[5]); w.w = pk_bf(v[6], v[7]);
            *(u32x4*)(dst + (size_t)rowmap<MAP>(n2) * K + kt * 64 + kq * 8) = w;
        }
        __syncthreads();
    }
}

template <bool FINAL> __device__ __forceinline__ void norm_rows(const float* src, const float* __restrict__ gamma, u16* dst, float* copy) {
    const int tid_ = otid(); const int lane = tid_ & 63, wid = tid_ >> 6; const int bidx = obid(), gdim = ogrid();
    f32x4 g[8];
#pragma unroll
    for (int i = 0; i < 8; ++i) g[i] = *(const f32x4*)(gamma + i * 256 + lane * 4);
    for (int row = bidx * 8 + wid; row < MT; row += gdim * 8) {
        const float* p = src + (size_t)row * DM; f32x4 v[8]; float ss = 0.f;
#pragma unroll
        for (int i = 0; i < 8; ++i) { v[i] = *(const f32x4*)(p + i * 256 + lane * 4); ss += v[i][0] * v[i][0] + v[i][1] * v[i][1] + v[i][2] * v[i][2] + v[i][3] * v[i][3]; }
        ss = wave_sum(ss);
        const float rs = rsqrtf(ss * (1.0f / 2048.0f) + 1e-6f);
#pragma unroll
        for (int i = 0; i < 8; ++i) {
            const f32x4 o = v[i] * rs * g[i];
            if (FINAL) { *(f32x4*)(copy + (size_t)row * DM + i * 256 + lane * 4) = o; }
            else { u32x2 w; w.x = pk_bf(o[0], o[1]); w.y = pk_bf(o[2], o[3]); *(u32x2*)(dst + (size_t)row * DM + i * 256 + lane * 4) = w;
                   if (copy) *(f32x4*)(copy + (size_t)row * DM + i * 256 + lane * 4) = v[i]; }
        }
    }
}

struct RwP { const float *mu, *w0, *w2, *a0, *a2, *kk, *ka, *rk; };
__device__ __forceinline__ void prep_rw(const u16* __restrict__ Z1, const RwP P, h16* __restrict__ RWP, float* __restrict__ RWS, float* __restrict__ BON, u16* __restrict__ ZG, LAS float* L) {
    const int tid = otid(), lane = tid & 63; const int bidx = obid(), gdim = ogrid();
    constexpr int TT = 32, TH = 16;
    for (int tile = bidx; tile < MT / TT; tile += gdim) {
        const int m0 = tile * TT;
#pragma unroll
        for (int i = 0; i < 16; ++i) {
            const int idx = tid + 512 * i, tok = idx >> 8, cc = idx & 255, m = m0 + tok, c = 2304 + cc;
            const float zc = bf2f(Z1[(size_t)m * Z1_LD + c]);
            const float zp = ((m & (TS - 1)) == 0) ? 0.f : bf2f(Z1[(size_t)(m - 1) * Z1_LD + c]);
            const float zf = zc + P.mu[c] * (zp - zc);
            if (cc < 64) L[cc * TT + tok] = tanh_(zf);
            else if (cc < 128) L[cc * TT + tok] = zf;
            else ZG[(size_t)m * 128 + (cc - 128)] = f2bf(sigm(zf));
        }
        __syncthreads();
        const int jj = tid & 255, th = tid >> 8;
        for (int cgi = 0; cgi < 3; ++cgi) {
            const int j = jj + 256 * cgi;
            const int mA = m0 + th * TH;
            u16 lr[TH], lk[TH], lv[TH]; u16 l0r = 0, l0k = 0, l0v = 0;
            if ((mA & (TS - 1)) != 0) { const u16* zp = Z1 + (size_t)(mA - 1) * Z1_LD; l0r = zp[j]; l0k = zp[768 + j]; l0v = zp[1536 + j]; }
#pragma unroll
            for (int tk = 0; tk < TH; ++tk) { const u16* zc = Z1 + (size_t)(mA + tk) * Z1_LD; lr[tk] = zc[j]; lk[tk] = zc[768 + j]; lv[tk] = zc[1536 + j]; }
            float aw[TH], aa[TH];
            { const float w0v = P.w0[j], a0v = P.a0[j];
#pragma unroll
              for (int k = 0; k < TH; ++k) { aw[k] = w0v; aa[k] = a0v; } }
#pragma unroll 4
            for (int i = 0; i < 64; ++i) {
                const float w2v = P.w2[i * 768 + j], a2v = P.a2[i * 768 + j];
#pragma unroll
                for (int q = 0; q < 4; ++q) {
                    const f32x4 t = *(const LAS f32x4*)(L + i * TT + th * TH + 4 * q), y = *(const LAS f32x4*)(L + (64 + i) * TT + th * TH + 4 * q);
#pragma unroll
                    for (int k = 0; k < 4; ++k) { aw[4 * q + k] += t[k] * w2v; aa[4 * q + k] += y[k] * a2v; }
                }
            }
            const float mur = P.mu[j], muk = P.mu[768 + j], muv = P.mu[1536 + j];
            const float kkc = P.kk[j], kac = P.ka[j], rkc = P.rk[j];
            const int hh = j >> 6;
            float pr = bf2f(l0r), pk = bf2f(l0k), pv = bf2f(l0v);
            float w1 = 0.f, dl1 = 0.f, bb1 = 0.f, kp1 = 0.f, br1 = 0.f, kr1 = 0.f;
#pragma unroll
            for (int tk = 0; tk < TH; ++tk) {
                const int m = mA + tk, b = m >> 14, t = m & (TS - 1);
                const float cr = bf2f(lr[tk]), ck = bf2f(lk[tk]), cv = bf2f(lv[tk]);
                const float r = cr + mur * (pr - cr), k = ck + muk * (pk - ck), v = cv + muv * (pv - cv);
                pr = cr; pk = ck; pv = cv;
                const float e = 0.6065306597f * sigm(aw[tk]);
                const float dl = 1.0f - __expf(-e);
                const float w = 1.0f - dl;
                const float a = sigm(aa[tk]);
                const float kq = k * kkc;
                const float ss = wave_sum(kq * kq);
                const float kkn = kq * rsqrtf(ss + 1e-12f);
                const float kp = k * (1.0f + (a - 1.0f) * kac);
                const float bb = kkn * a;
                const float wr = w * r;
                const float br = wave_sum(bb * r), kr = wave_sum(kp * r), bonus = wave_sum(r * kp * rkc);
                const size_t rec = (size_t)(b * 12 + hh) * TS + t;
                h16* o = RWP + (rec >> 1) * 768 + lane;
                if (lane == 0) BON[rec] = bonus;
                if ((tk & 1) == 0) {
                    o[0] = (h16)kkn; o[64] = (h16)wr; o[9 * 64] = (h16)v;
                    w1 = w; dl1 = dl; bb1 = bb; kp1 = kp; br1 = br; kr1 = kr;
                } else {
                    o[2 * 64] = (h16)(w1 * kkn); o[3 * 64] = (h16)(w1 * wr); o[4 * 64] = (h16)(dl1 + dl - dl1 * dl);
                    o[5 * 64] = (h16)(bb1 * w); o[6 * 64] = (h16)(kp1 * w); o[7 * 64] = (h16)bb; o[8 * 64] = (h16)kp; o[10 * 64] = (h16)v;
                    const float bk12 = wave_sum(bb1 * kkn), kk12 = wave_sum(kp1 * kkn), bz = wave_sum(bb1 * wr), kz = wave_sum(kp1 * wr);
                    if (lane == 0) { f32x4 sA, sB; sA[0] = br1; sA[1] = kr1; sA[2] = bk12; sA[3] = kk12; sB[0] = br; sB[1] = kr; sB[2] = bz; sB[3] = kz;
                        *(f32x4*)(RWS + (rec >> 1) * 8) = sA; *(f32x4*)(RWS + (rec >> 1) * 8 + 4) = sB; }
                }
            }
        }
        __syncthreads();
    }
}

__device__ __forceinline__ void tr_small(const float* __restrict__ src, u16* __restrict__ dst, int K) {
    const int tid = otid(); const int bidx = obid(), gdim = ogrid();
    for (int idx = bidx * 512 + tid; idx < 768 * K; idx += gdim * 512) { const int col = idx / K, k = idx - col * K; dst[idx] = f2bf(src[k * 768 + col]); }
}
typedef short bf16x8_t __attribute__((ext_vector_type(8)));
__device__ __forceinline__ void prep_rw2(const u16* __restrict__ Z1, const RwP P, const u16* __restrict__ W2T, const u16* __restrict__ A2T,
                                         h16* __restrict__ RWP, float* __restrict__ RWS, float* __restrict__ BON, u16* __restrict__ ZG, LAS unsigned char* lds) {
    const int tid = otid(), lane = tid & 63, wid = tid >> 6, fr = lane & 15, fq = lane >> 4; const int bidx = obid(), gdim = ogrid();
    constexpr int TT = 32, LST = 272;
    for (int tile = bidx; tile < MT / TT; tile += gdim) {
        const int m0 = tile * TT;
#pragma unroll
        for (int i = 0; i < 16; ++i) {
            const int idx = tid + 512 * i, tok = idx >> 8, cc = idx & 255, m = m0 + tok, c = 2304 + cc;
            const float zc = bf2f(Z1[(size_t)m * Z1_LD + c]);
            const float zp = ((m & (TS - 1)) == 0) ? 0.f : bf2f(Z1[(size_t)(m - 1) * Z1_LD + c]);
            const float zf = zc + P.mu[c] * (zp - zc);
            if (cc < 128) *(LAS u16*)(lds + tok * LST + cc * 2) = f2bf(cc < 64 ? tanh_(zf) : zf);
            else ZG[(size_t)m * 128 + (cc - 128)] = f2bf(sigm(zf));
        }
        __syncthreads();
        for (int wt = wid; wt < 24; wt += 8) {
            const int hh = wt % 12, half = wt / 12;
            const int mB = m0 + half * 16, b = mB >> 14, tB = mB & (TS - 1);
            const int j0 = hh * 64 + 4 * fr;
            f32x4 accW[4], accA[4];
#pragma unroll
            for (int n = 0; n < 4; ++n) { accW[n] = (f32x4){0.f, 0.f, 0.f, 0.f}; accA[n] = (f32x4){0.f, 0.f, 0.f, 0.f}; }
#pragma unroll
            for (int ks = 0; ks < 2; ++ks) {
                const bf16x8_t aw_ = *(const LAS bf16x8_t*)(lds + (half * 16 + fr) * LST + (ks * 32 + fq * 8) * 2);
                const bf16x8_t aa_ = *(const LAS bf16x8_t*)(lds + (half * 16 + fr) * LST + (64 + ks * 32 + fq * 8) * 2);
#pragma unroll
                for (int n = 0; n < 4; ++n) {
                    const bf16x8_t bw = *(const bf16x8_t*)(W2T + (size_t)(j0 + n) * 64 + ks * 32 + fq * 8);
                    const bf16x8_t ba = *(const bf16x8_t*)(A2T + (size_t)(j0 + n) * 64 + ks * 32 + fq * 8);
                    accW[n] = __builtin_amdgcn_mfma_f32_16x16x32_bf16(aw_, bw, accW[n], 0, 0, 0);
                    accA[n] = __builtin_amdgcn_mfma_f32_16x16x32_bf16(aa_, ba, accA[n], 0, 0, 0);
                }
            }
            const f32x4 w0v = *(const f32x4*)(P.w0 + j0), a0v = *(const f32x4*)(P.a0 + j0), mur = *(const f32x4*)(P.mu + j0), muk = *(const f32x4*)(P.mu + 768 + j0), muv = *(const f32x4*)(P.mu + 1536 + j0);
            const f32x4 kkc = *(const f32x4*)(P.kk + j0), kac = *(const f32x4*)(P.ka + j0), rkc = *(const f32x4*)(P.rk + j0);
            u32x2 zr[5], zk[5], zv[5];
#pragma unroll
            for (int q = 0; q < 5; ++q) {
                const int m = mB + 4 * fq + q - 1;
                if (q == 0 && ((m + 1) & (TS - 1)) == 0) { zr[0] = (u32x2){0u, 0u}; zk[0] = zr[0]; zv[0] = zr[0]; }
                else { const u16* zc = Z1 + (size_t)m * Z1_LD + j0; zr[q] = *(const u32x2*)zc; zk[q] = *(const u32x2*)(zc + 768); zv[q] = *(const u32x2*)(zc + 1536); }
            }
            f32x4 w1, dl1, bb1, kp1; float br1 = 0.f, kr1 = 0.f;
#pragma unroll
            for (int r = 0; r < 4; ++r) {
                const int t = tB + 4 * fq + r;
                const size_t rec = (size_t)(b * 12 + hh) * TS + t;
                f32x4 pr, pk, pv, cr, ck, cv;
                pr[0] = bflo(zr[r].x); pr[1] = bfhi(zr[r].x); pr[2] = bflo(zr[r].y); pr[3] = bfhi(zr[r].y);
                pk[0] = bflo(zk[r].x); pk[1] = bfhi(zk[r].x); pk[2] = bflo(zk[r].y); pk[3] = bfhi(zk[r].y);
                pv[0] = bflo(zv[r].x); pv[1] = bfhi(zv[r].x); pv[2] = bflo(zv[r].y); pv[3] = bfhi(zv[r].y);
                cr[0] = bflo(zr[r + 1].x); cr[1] = bfhi(zr[r + 1].x); cr[2] = bflo(zr[r + 1].y); cr[3] = bfhi(zr[r + 1].y);
                ck[0] = bflo(zk[r + 1].x); ck[1] = bfhi(zk[r + 1].x); ck[2] = bflo(zk[r + 1].y); ck[3] = bfhi(zk[r + 1].y);
                cv[0] = bflo(zv[r + 1].x); cv[1] = bfhi(zv[r + 1].x); cv[2] = bflo(zv[r + 1].y); cv[3] = bfhi(zv[r + 1].y);
                const f32x4 rr = cr + mur * (pr - cr), k = ck + muk * (pk - ck), v = cv + muv * (pv - cv);
                f32x4 w, dl, a, kq, kp;
                float ss = 0.f;
#pragma unroll
                for (int n = 0; n < 4; ++n) {
                    const float e = 0.6065306597f * sigm(accW[n][r] + w0v[n]);
                    w[n] = __expf(-e); dl[n] = 1.0f - w[n];
                    a[n] = sigm(accA[n][r] + a0v[n]);
                    kq[n] = k[n] * kkc[n]; ss += kq[n] * kq[n];
                    kp[n] = k[n] * (1.0f + (a[n] - 1.0f) * kac[n]);
                }
                ss = red16(ss);
                const float rn = rsqrtf(ss + 1e-12f);
                const f32x4 kkn = kq * rn, bb = kkn * a, wr = w * rr;
                float br = 0.f, kr = 0.f, bonus = 0.f;
#pragma unroll
                for (int n = 0; n < 4; ++n) { br += bb[n] * rr[n]; kr += kp[n] * rr[n]; bonus += rr[n] * kp[n] * rkc[n]; }
                br = red16(br); kr = red16(kr); bonus = red16(bonus);
                h16* o = RWP + (rec >> 1) * 768 + 4 * fr;
                if (fr == 0) BON[rec] = bonus;
#define ST4(slot, vec) do { h16x4 hv_; hv_[0] = (h16)(vec)[0]; hv_[1] = (h16)(vec)[1]; hv_[2] = (h16)(vec)[2]; hv_[3] = (h16)(vec)[3]; *(h16x4*)(o + (slot) * 64) = hv_; } while (0)
                if ((r & 1) == 0) {
                    ST4(0, kkn); ST4(1, wr); ST4(9, v);
                    w1 = w; dl1 = dl; bb1 = bb; kp1 = kp; br1 = br; kr1 = kr;
                } else {
                    const f32x4 x2 = w1 * kkn, z2 = w1 * wr, d12 = dl1 + dl - dl1 * dl, B1 = bb1 * w, K1 = kp1 * w;
                    ST4(2, x2); ST4(3, z2); ST4(4, d12); ST4(5, B1); ST4(6, K1); ST4(7, bb); ST4(8, kp); ST4(10, v);
                    float bk12 = 0.f, kk12 = 0.f, bz = 0.f, kz = 0.f;
#pragma unroll
                    for (int n = 0; n < 4; ++n) { bk12 += bb1[n] * kkn[n]; kk12 += kp1[n] * kkn[n]; bz += bb1[n] * wr[n]; kz += kp1[n] * wr[n]; }
                    bk12 = red16(bk12); kk12 = red16(kk12); bz = red16(bz); kz = red16(kz);
                    if (fr == 0) { f32x4 sA, sB; sA[0] = br1; sA[1] = kr1; sA[2] = bk12; sA[3] = kk12; sB[0] = br; sB[1] = kr; sB[2] = bz; sB[3] = kz;
                        *(f32x4*)(RWS + (rec >> 1) * 8) = sA; *(f32x4*)(RWS + (rec >> 1) * 8 + 4) = sB; }
                }
#undef ST4
            }
        }
        __syncthreads();
    }
}

__device__ __forceinline__ void prep_gd(const u16* __restrict__ Z2, const float* __restrict__ cw, const float* __restrict__ alog, const float* __restrict__ dtb,
                                        h16* __restrict__ GDP, float* __restrict__ GDS) {
    const int tid_ = otid(); const int lane = tid_ & 63, wid = tid_ >> 6; const int bidx = obid(), gdim = ogrid();
    for (int task = bidx * 8 + wid; task < 6 * (MT / 32); task += gdim * 8) {
        const int hh = task % 6, chunk = task / 6, m0 = chunk * 32, b = m0 >> 14, t0 = m0 & (TS - 1);
        const int cq = hh * 128 + 2 * lane;
        float w[3][4][2];
#pragma unroll
        for (int a = 0; a < 3; ++a)
#pragma unroll
            for (int i = 0; i < 4; ++i) { const f32x2 q = *(const f32x2*)(cw + i * 2304 + a * 768 + cq); w[a][i][0] = q[0]; w[a][i][1] = q[1]; }
        float x[3][3][2];
#pragma unroll
        for (int a = 0; a < 3; ++a)
#pragma unroll
            for (int d = 0; d < 3; ++d) {
                unsigned wv = 0u;
                if (t0 != 0) wv = *(const unsigned*)(Z2 + (size_t)(m0 - 3 + d) * Z2_LD + a * 768 + cq);
                x[a][d][0] = bflo(wv); x[a][d][1] = bfhi(wv);
            }
        const float An = -__expf(alog[hh]), dtbv = dtb[hh];
        float kprev0 = 0.f, kprev1 = 0.f, al1 = 0.f, be1 = 0.f, qk1 = 0.f;
        for (int s8 = 0; s8 < 32; s8 += 8) {
          unsigned ld[8][3]; u16 ldb[8], lda[8];
#pragma unroll
          for (int k = 0; k < 8; ++k) { const u16* zr = Z2 + (size_t)(m0 + s8 + k) * Z2_LD;
#pragma unroll
              for (int a = 0; a < 3; ++a) ld[k][a] = *(const unsigned*)(zr + a * 768 + cq);
              ldb[k] = zr[Z2_ZB + hh]; lda[k] = zr[Z2_ZA + hh]; }
#pragma unroll
          for (int k = 0; k < 8; ++k) {
            const int s = s8 + k;
            float y[3][2];
#pragma unroll
            for (int a = 0; a < 3; ++a) {
                const unsigned wv = ld[k][a];
                const float c0 = bflo(wv), c1 = bfhi(wv);
                const float s0 = x[a][0][0] * w[a][0][0] + x[a][1][0] * w[a][1][0] + x[a][2][0] * w[a][2][0] + c0 * w[a][3][0];
                const float s1 = x[a][0][1] * w[a][0][1] + x[a][1][1] * w[a][1][1] + x[a][2][1] * w[a][2][1] + c1 * w[a][3][1];
                x[a][0][0] = x[a][1][0]; x[a][1][0] = x[a][2][0]; x[a][2][0] = c0;
                x[a][0][1] = x[a][1][1]; x[a][1][1] = x[a][2][1]; x[a][2][1] = c1;
                y[a][0] = s0 * sigm(s0); y[a][1] = s1 * sigm(s1);
            }
            const float sq = wave_sum(y[0][0] * y[0][0] + y[0][1] * y[0][1]);
            const float sk = wave_sum(y[1][0] * y[1][0] + y[1][1] * y[1][1]);
            const float rq = rsqrtf(sq + 1e-12f) * 0.08838834764831845f, rk = rsqrtf(sk + 1e-12f);
            const float q0 = y[0][0] * rq, q1 = y[0][1] * rq, k0 = y[1][0] * rk, k1 = y[1][1] * rk;
            const float qk = wave_sum(q0 * k0 + q1 * k1);
            const size_t rec = (size_t)(b * 6 + hh) * TS + (t0 + s);
            h16* o = GDP + rec * 384 + 2 * lane;
            h16x2 kv; kv[0] = (h16)k0; kv[1] = (h16)k1; *(h16x2*)(o) = kv;
            h16x2 qv; qv[0] = (h16)q0; qv[1] = (h16)q1; *(h16x2*)(o + 128) = qv;
            h16x2 vv; vv[0] = (h16)y[2][0]; vv[1] = (h16)y[2][1]; *(h16x2*)(o + 256) = vv;
            const float beta = sigm(bf2f(ldb[k]));
            const float alpha = __expf(An * softplus_(bf2f(lda[k]) + dtbv));
            if ((k & 1) == 0) { kprev0 = k0; kprev1 = k1; al1 = alpha; be1 = beta; qk1 = qk; }
            else {
                const float k12 = wave_sum(kprev0 * k0 + kprev1 * k1), kq12 = wave_sum(kprev0 * q0 + kprev1 * q1);
                if (lane == 0) { f32x4 sA, sB; sA[0] = al1; sA[1] = be1; sA[2] = qk1; sA[3] = k12; sB[0] = alpha; sB[1] = beta; sB[2] = qk; sB[3] = kq12;
                    *(f32x4*)(GDS + (rec - 1) * 4) = sA; *(f32x4*)(GDS + rec * 4) = sB; }
            }
          }
        }
    }
}

struct LrP { const float *cw, *cb, *wa, *ba, *wx, *bx, *lam; };
__device__ __forceinline__ void tr_blocks(const float* __restrict__ src, u16* __restrict__ dst) {
    const int tid = otid(); const int bidx = obid(), gdim = ogrid();
    for (int idx = bidx * 512 + tid; idx < 8 * 64 * 64; idx += gdim * 512) { const int n = idx >> 12, d = (idx >> 6) & 63, c = idx & 63; dst[idx] = f2bf(src[(n * 64 + c) * 64 + d]); }
}
__device__ __forceinline__ void prep_lr2(const u16* __restrict__ Z2, const LrP P, const u16* __restrict__ WAT, const u16* __restrict__ WXT, u16* __restrict__ LRA, u16* __restrict__ LRUb, LAS unsigned char* lds, int bsub = 0, int gsub = 0) {
    const int tid_ = otid(); const int lane = tid_ & 63, wid = tid_ >> 6, fr = lane & 15, fq = lane >> 4; const int bidx = gsub ? bsub : obid(), gdim = gsub ? gsub : ogrid();
    LAS unsigned char* Lx = lds + wid * 10240;
    LAS float* La = (LAS float*)(Lx + 2048);
    LAS float* Lb = La + 1024;
    for (int task = bidx * 8 + wid; task < 8 * (MT / 64); task += gdim * 8) {
        const int n = task & 7, chunk = task >> 3, m0 = chunk * 64, t0 = m0 & (TS - 1);
        const int ch = n * 64 + lane;
        bf16x8_t bwa[4][2], bwx[4][2];
#pragma unroll
        for (int nt = 0; nt < 4; ++nt)
#pragma unroll
            for (int ks = 0; ks < 2; ++ks) { const size_t o = (size_t)(n * 64 + nt * 16 + fr) * 64 + ks * 32 + fq * 8; bwa[nt][ks] = *(const bf16x8_t*)(WAT + o); bwx[nt][ks] = *(const bf16x8_t*)(WXT + o); }
        const float c0 = P.cw[ch], c1 = P.cw[512 + ch], c2 = P.cw[1024 + ch], c3 = P.cw[1536 + ch], cb = P.cb[ch];
        const float ba = P.ba[ch], bx = P.bx[ch];
        const float spl = -8.0f * softplus_(-P.lam[ch]);
        float x0 = 0.f, x1 = 0.f, x2 = 0.f, hl = 0.f, pc = 1.f;
        if (t0 != 0) { x0 = bf2f(Z2[(size_t)(m0 - 3) * Z2_LD + Z2_XL + ch]); x1 = bf2f(Z2[(size_t)(m0 - 2) * Z2_LD + Z2_XL + ch]); x2 = bf2f(Z2[(size_t)(m0 - 1) * Z2_LD + Z2_XL + ch]); }
        for (int s16 = 0; s16 < 64; s16 += 16) {
            u16 ldx[16];
#pragma unroll
            for (int k = 0; k < 16; ++k) ldx[k] = Z2[(size_t)(m0 + s16 + k) * Z2_LD + Z2_XL + ch];
            float xc[16];
#pragma unroll
            for (int k = 0; k < 16; ++k) {
                const float xin = bf2f(ldx[k]);
                xc[k] = x0 * c0 + x1 * c1 + x2 * c2 + xin * c3 + cb;
                x0 = x1; x1 = x2; x2 = xin;
                *(LAS u16*)(Lx + (k * 64 + lane) * 2) = f2bf(xc[k]);
            }
            f32x4 aA[4], aX[4];
#pragma unroll
            for (int nt = 0; nt < 4; ++nt) { aA[nt] = (f32x4){0.f, 0.f, 0.f, 0.f}; aX[nt] = (f32x4){0.f, 0.f, 0.f, 0.f}; }
#pragma unroll
            for (int ks = 0; ks < 2; ++ks) {
                const bf16x8_t af = *(const LAS bf16x8_t*)(Lx + (fr * 64 + ks * 32 + fq * 8) * 2);
#pragma unroll
                for (int nt = 0; nt < 4; ++nt) { aA[nt] = __builtin_amdgcn_mfma_f32_16x16x32_bf16(af, bwa[nt][ks], aA[nt], 0, 0, 0); aX[nt] = __builtin_amdgcn_mfma_f32_16x16x32_bf16(af, bwx[nt][ks], aX[nt], 0, 0, 0); }
            }
#pragma unroll
            for (int nt = 0; nt < 4; ++nt)
#pragma unroll
                for (int r = 0; r < 4; ++r) { La[(4 * fq + r) * 64 + nt * 16 + fr] = aA[nt][r]; Lb[(4 * fq + r) * 64 + nt * 16 + fr] = aX[nt][r]; }
#pragma unroll
            for (int k = 0; k < 16; ++k) {
                const int m = m0 + s16 + k;
                const float r = sigm(La[k * 64 + lane] + ba), ig = sigm(Lb[k * 64 + lane] + bx);
                const float la = spl * r;
                const float a = __expf(la);
                const float u = __builtin_amdgcn_sqrtf(1.0f - __expf(2.0f * la)) * (ig * xc[k]);
                hl = a * hl + u; pc *= a;
                LRA[(size_t)m * 512 + ch] = f2bf(pc); LRUb[(size_t)m * 512 + ch] = f2bf(hl);
            }
        }
    }
}

constexpr int RC = 32;
constexpr int RPB = 3072;
constexpr int RBUF = (RC / 2) * RPB + (RC / 2) * 32;
__device__ __forceinline__ f32x2 lo2(f32x4 v) { f32x2 r; r[0] = v[0]; r[1] = v[1]; return r; }
__device__ __forceinline__ f32x2 hi2(f32x4 v) { f32x2 r; r[0] = v[2]; r[1] = v[3]; return r; }
__device__ __forceinline__ float dot4(f32x2 sa, f32x2 sb, f32x4 v) { f32x2 t = sa * lo2(v); t = sb * hi2(v) + t; return t[0] + t[1]; }
__device__ __forceinline__ float dot8(const f32x2 (&S)[4], f32x4 va, f32x4 vb) { f32x2 t = S[0] * lo2(va); t = S[1] * hi2(va) + t; t = S[2] * lo2(vb) + t; t = S[3] * hi2(vb) + t; return t[0] + t[1]; }
template <int KIND> __device__ __forceinline__ void rec_block(const unsigned char* __restrict__ gp, const unsigned char* __restrict__ gs, u16* __restrict__ outp  ,
                                                             int rowl0  , LAS unsigned char* lds) {
    const int tid = otid(), lane = tid & 63, wid = tid >> 6, g = lane >> 4, j = lane & 15;
    const int cw = wid & 3; const bool is_ld = wid >= 4;
    const int rowl = rowl0 + cw * 4 + g;
    const int lt = cw * 64 + lane;
    constexpr int NCH = TS / RC;
    constexpr int CB = (RC / 2) * 1536;
    u32x4 st[6]; u32x4 ss0, ss1;
#define LD_ISSUE(c) do { const unsigned char* np = gp + (size_t)(c) * CB; const unsigned char* ns = gs + (size_t)(c) * (RC * 16); \
        _Pragma("unroll") for (int i = 0; i < 6; ++i) st[i] = *(const u32x4*)(np + (size_t)(lt + 256 * i) * 16); \
        if (lt < 32) ss0 = *(const u32x4*)(ns + lt * 16); } while (0)
#define LD_COMMIT(buf) do { LAS unsigned char* Bn = lds + 4096 + (buf) * RBUF; \
        _Pragma("unroll") for (int i = 0; i < 6; ++i) { const int q = lt + 256 * i, slot = (q % 96) >> 3; \
            const u32x4 w = st[i]; f32x4 a, b; \
            { const unsigned w0 = w[0], w1 = w[1], w2 = w[2], w3 = w[3]; const h16x2 h0 = __builtin_bit_cast(h16x2, w0), h1 = __builtin_bit_cast(h16x2, w1), h2 = __builtin_bit_cast(h16x2, w2), h3 = __builtin_bit_cast(h16x2, w3); \
              a[0] = (float)h0[0]; a[1] = (float)h0[1]; a[2] = (float)h1[0]; a[3] = (float)h1[1]; b[0] = (float)h2[0]; b[1] = (float)h2[1]; b[2] = (float)h3[0]; b[3] = (float)h3[1]; } \
            if (KIND == 0 && slot == 4) { a = 1.0f - a; b = 1.0f - b; } \
            *(LAS f32x4*)(Bn + q * 32) = a; *(LAS f32x4*)(Bn + q * 32 + 16) = b; } \
        if (lt < 32) *(LAS u32x4*)(Bn + (RC / 2) * RPB + lt * 16) = ss0; } while (0)
#define Y_OUT(c) do { const LAS float* yb = (const LAS float*)(lds + ((c) & 1) * 2048); const int stp = lt >> 3, rp = (lt & 7) * 2; \
        const f32x2 yv = *(const LAS f32x2*)(yb + stp * 16 + rp); *(unsigned*)(outp + ((size_t)(c) * RC + stp) * DM + rp) = pk_bf(yv[0], yv[1]); } while (0)
    if (is_ld) { LD_ISSUE(0); LD_COMMIT(0); LD_ISSUE(1); }
    __syncthreads();
    f32x2 Sv[4];
#pragma unroll
    for (int i = 0; i < 4; ++i) { Sv[i][0] = 0.f; Sv[i][1] = 0.f; }
    for (int c = 0; c < NCH; ++c) {
        if (is_ld) {
            if (c + 1 < NCH) { LD_COMMIT((c + 1) & 1); if (c + 2 < NCH) LD_ISSUE(c + 2); }
            if (c > 0) Y_OUT(c - 1);
        } else {
            const LAS unsigned char* B = lds + 4096 + (c & 1) * RBUF;
            const LAS unsigned char* Sc = B + (RC / 2) * RPB;
            LAS float* yw = (LAS float*)(lds + (c & 1) * 2048) + (cw * 4 + g);
            if (KIND == 0) {
                f32x4 n_kk, n_wr, n_x2, n_z2, n_W, n_B1, n_K1, n_b2, n_kp2, n_sA, n_sB; float n_v1, n_v2;
#define RW_LD(p) do { const LAS unsigned char* Pp = B + (p) * RPB + j * 16; \
                    n_kk = *(const LAS f32x4*)(Pp); n_wr = *(const LAS f32x4*)(Pp + 256); n_x2 = *(const LAS f32x4*)(Pp + 512); n_z2 = *(const LAS f32x4*)(Pp + 768); \
                    n_W = *(const LAS f32x4*)(Pp + 1024); n_B1 = *(const LAS f32x4*)(Pp + 1280); n_K1 = *(const LAS f32x4*)(Pp + 1536); n_b2 = *(const LAS f32x4*)(Pp + 1792); n_kp2 = *(const LAS f32x4*)(Pp + 2048); \
                    n_v1 = *(const LAS float*)(B + (p) * RPB + 2304 + rowl * 4); n_v2 = *(const LAS float*)(B + (p) * RPB + 2560 + rowl * 4); \
                    n_sA = *(const LAS f32x4*)(Sc + (p) * 32); n_sB = *(const LAS f32x4*)(Sc + (p) * 32 + 16); } while (0)
                RW_LD(0);
#pragma unroll 16
                for (int p = 0; p < RC / 2; ++p) {
                    const f32x4 kk = n_kk, wr = n_wr, x2 = n_x2, z2 = n_z2, W = n_W, B1 = n_B1, K1 = n_K1, b2 = n_b2, kp2 = n_kp2, sA = n_sA, sB = n_sB; const float v1 = n_v1, v2 = n_v2;
                    { const int pn = (p + 1 < RC / 2) ? p + 1 : p; RW_LD(pn); }
                    float d0 = dot4(Sv[0], Sv[1], kk), d1 = dot4(Sv[0], Sv[1], wr), d2 = dot4(Sv[0], Sv[1], x2), d3 = dot4(Sv[0], Sv[1], z2);
                    d0 = red16(d0); d1 = red16(d1); d2 = red16(d2); d3 = red16(d3);
                    const float sa1 = d0;
                    const float y1 = d1 - sa1 * sA[0] + v1 * sA[1];
                    const float sa2 = d2 - sa1 * sA[2] + v1 * sA[3];
                    const float y2 = (d3 - sa1 * sB[2] + v1 * sB[3]) - sa2 * sB[0] + v2 * sB[1];
                    yw[(2 * p) * 16] = y1; yw[(2 * p + 1) * 16] = y2;
                    const float n1 = -sa1, n2 = -sa2;
                    Sv[0] = lo2(b2) * n2 + (lo2(kp2) * v2 + (lo2(B1) * n1 + (lo2(K1) * v1 + Sv[0] * lo2(W))));
                    Sv[1] = hi2(b2) * n2 + (hi2(kp2) * v2 + (hi2(B1) * n1 + (hi2(K1) * v1 + Sv[1] * hi2(W))));
                }
            } else {
                f32x4 n_k1a, n_k1b, n_q1a, n_q1b, n_k2a, n_k2b, n_q2a, n_q2b, n_sA, n_sB; float n_v1, n_v2;
#define GD_LD(p) do { const LAS unsigned char* Pp = B + (p) * RPB + j * 16;     \
                    n_k1a = *(const LAS f32x4*)(Pp); n_k1b = *(const LAS f32x4*)(Pp + 256); n_q1a = *(const LAS f32x4*)(Pp + 512); n_q1b = *(const LAS f32x4*)(Pp + 768); \
                    n_k2a = *(const LAS f32x4*)(Pp + 1536); n_k2b = *(const LAS f32x4*)(Pp + 1792); n_q2a = *(const LAS f32x4*)(Pp + 2048); n_q2b = *(const LAS f32x4*)(Pp + 2304); \
                    n_v1 = *(const LAS float*)(B + (p) * RPB + 1024 + rowl * 4); n_v2 = *(const LAS float*)(B + (p) * RPB + 2560 + rowl * 4); \
                    n_sA = *(const LAS f32x4*)(Sc + (p) * 32); n_sB = *(const LAS f32x4*)(Sc + (p) * 32 + 16); } while (0)
                GD_LD(0);
#pragma unroll 16
                for (int p = 0; p < RC / 2; ++p) {
                    const f32x4 k1a = n_k1a, k1b = n_k1b, q1a = n_q1a, q1b = n_q1b, k2a = n_k2a, k2b = n_k2b, q2a = n_q2a, q2b = n_q2b, sA = n_sA, sB = n_sB; const float v1 = n_v1, v2 = n_v2;
                    { const int pn = (p + 1 < RC / 2) ? p + 1 : p; GD_LD(pn); }
                    float a1 = dot8(Sv, k1a, k1b), c1 = dot8(Sv, q1a, q1b), a2 = dot8(Sv, k2a, k2b), c2 = dot8(Sv, q2a, q2b);
                    a1 = red16(a1); c1 = red16(c1); a2 = red16(a2); c2 = red16(c2);
                    const float al1 = sA[0], al2 = sB[0];
                    const float vn1 = sA[1] * (v1 - al1 * a1);
                    const float o1 = al1 * c1 + sA[2] * vn1;
                    const float vn2 = sB[1] * (v2 - al2 * (al1 * a2 + sA[3] * vn1));
                    const float o2 = al2 * (al1 * c2 + sB[3] * vn1) + sB[2] * vn2;
                    yw[(2 * p) * 16] = o1; yw[(2 * p + 1) * 16] = o2;
                    const float cS = al1 * al2, w1 = al2 * vn1;
                    Sv[0] = lo2(k2a) * vn2 + (lo2(k1a) * w1 + Sv[0] * cS);
                    Sv[1] = hi2(k2a) * vn2 + (hi2(k1a) * w1 + Sv[1] * cS);
                    Sv[2] = lo2(k2b) * vn2 + (lo2(k1b) * w1 + Sv[2] * cS);
                    Sv[3] = hi2(k2b) * vn2 + (hi2(k1b) * w1 + Sv[3] * cS);
                }
            }
        }
        __syncthreads();
    }
    if (is_ld) Y_OUT(NCH - 1);
#undef LD_ISSUE
#undef LD_COMMIT
#undef Y_OUT
}
__device__ __forceinline__ void lru_carry(int grp  , const u16* __restrict__ LRA, const u16* __restrict__ LRUb, float* __restrict__ HIN) {
    const int lane = otid() & 63;
    const int b = grp >> 3, ch = (grp & 7) * 64 + lane;
    float h = 0.f;
    for (int c = 0; c < TS / 64; c += 8) {
        float a[8], u[8];
#pragma unroll
        for (int k = 0; k < 8; ++k) { const size_t m = (size_t)b * TS + (c + k) * 64 + 63; a[k] = bf2f(LRA[m * 512 + ch]); u[k] = bf2f(LRUb[m * 512 + ch]); }
#pragma unroll
        for (int k = 0; k < 8; ++k) { HIN[((size_t)b * 256 + c + k) * 512 + ch] = h; h = a[k] * h + u[k]; }
    }
}
__device__ __forceinline__ void post_lr(u16* __restrict__ MIX, const u16* __restrict__ Z2, const u16* __restrict__ LRA, const u16* __restrict__ LRUb, const float* __restrict__ HIN, int bsub = 0, int gsub = 0) {
    const int tid = otid(); const int bidx = gsub ? bsub : obid(), gdim = gsub ? gsub : ogrid();
    for (int it = bidx * 512 + tid; it < MT * 128; it += gdim * 512) {
        const int m = it >> 7, c4 = (it & 127) * 4, b = m >> 14, chunk = (m & (TS - 1)) >> 6;
        const u32x2 pw = *(const u32x2*)(LRA + (size_t)m * 512 + c4), hw = *(const u32x2*)(LRUb + (size_t)m * 512 + c4); const f32x4 hin = *(const f32x4*)(HIN + ((size_t)b * 256 + chunk) * 512 + c4);
        f32x4 pc, hl; pc[0] = bflo(pw.x); pc[1] = bfhi(pw.x); pc[2] = bflo(pw.y); pc[3] = bfhi(pw.y); hl[0] = bflo(hw.x); hl[1] = bfhi(hw.x); hl[2] = bflo(hw.y); hl[3] = bfhi(hw.y);
        const u32x2 yw = *(const u32x2*)(Z2 + (size_t)m * Z2_LD + Z2_YL + c4);
        const f32x4 h = hl + pc * hin;
        u32x2 o; o.x = pk_bf(h[0] * gelu_tanh(bflo(yw.x)), h[1] * gelu_tanh(bfhi(yw.x))); o.y = pk_bf(h[2] * gelu_tanh(bflo(yw.y)), h[3] * gelu_tanh(bfhi(yw.y)));
        *(u32x2*)(MIX + (size_t)m * DM + 1536 + c4) = o;
    }
}

__device__ __forceinline__ void post_rw(u16* __restrict__ MIX, const h16* __restrict__ RWP, const float* __restrict__ BON, const u16* __restrict__ ZG,
                                        const float* __restrict__ g2, const float* __restrict__ lng, const float* __restrict__ lnb) {
    const int tid_ = otid(); const int lane = tid_ & 63, wid = tid_ >> 6; const int bidx = obid(), gdim = ogrid();
    for (int task = bidx * 8 + wid; task < 12 * (MT / 64); task += gdim * 8) {
        const int hh = task % 12, chunk = task / 12, m0 = chunk * 64, b = m0 >> 14, t0 = m0 & (TS - 1);
        const int col = hh * 64 + lane;
        float gc[128];
#pragma unroll
        for (int i = 0; i < 128; ++i) gc[i] = g2[i * 768 + col];
        const float lg = lng[col], lb = lnb[col];
        for (int s4 = 0; s4 < 64; s4 += 4) {
          u16 ly[4]; h16 lv[4]; float lbon[4]; unsigned lsw[4];
#pragma unroll
          for (int k = 0; k < 4; ++k) { const int m = m0 + s4 + k; const size_t rec = (size_t)(b * 12 + hh) * TS + (t0 + s4 + k);
              ly[k] = MIX[(size_t)m * DM + col]; lv[k] = RWP[(rec >> 1) * 768 + (9 + (int)(rec & 1)) * 64 + lane]; lbon[k] = BON[rec]; lsw[k] = *(const unsigned*)(ZG + (size_t)m * 128 + 2 * lane); }
#pragma unroll
          for (int k = 0; k < 4; ++k) {
            const int m = m0 + s4 + k;
            const float y = bf2f(ly[k]);
            const float mean = wave_sum(y) * (1.0f / 64.0f);
            const float d = y - mean;
            const float var = wave_sum(d * d) * (1.0f / 64.0f);
            const float yn = d * rsqrtf(var + 64e-5f) * lg + lb;
            const float v = (float)lv[k];
            const float bonus = lbon[k];
            const unsigned sw = lsw[k];
            const float s0 = bflo(sw), s1 = bfhi(sw);
            float ga = 0.f, gb = 0.f;
#pragma unroll
            for (int i = 0; i < 64; ++i) { ga += rlane(s0, i) * gc[2 * i]; gb += rlane(s1, i) * gc[2 * i + 1]; }
            MIX[(size_t)m * DM + col] = f2bf((yn + bonus * v) * (ga + gb));
          }
        }
    }
}
__device__ __forceinline__ void post_rw2(u16* __restrict__ MIX, const h16* __restrict__ RWP, const float* __restrict__ BON, const u16* __restrict__ ZG,
                                         const u16* __restrict__ G2T, const float* __restrict__ lng, const float* __restrict__ lnb) {
    const int tid_ = otid(); const int lane = tid_ & 63, wid = tid_ >> 6, fr = lane & 15, fq = lane >> 4; const int bidx = obid(), gdim = ogrid();
    for (int task = bidx * 8 + wid; task < 12 * (MT / 16); task += gdim * 8) {
        const int hh = task % 12, chunk = task / 12, mB = chunk * 16, b = mB >> 14, tB = mB & (TS - 1);
        const int j0 = hh * 64 + 4 * fr;
        u32x2 yw[4]; h16x4 vv[4]; float bon[4];
#pragma unroll
        for (int r = 0; r < 4; ++r) { const int m = mB + 4 * fq + r; const size_t rec = (size_t)(b * 12 + hh) * TS + (tB + 4 * fq + r);
            yw[r] = *(const u32x2*)(MIX + (size_t)m * DM + j0); vv[r] = *(const h16x4*)(RWP + (rec >> 1) * 768 + (9 + (int)(rec & 1)) * 64 + 4 * fr); bon[r] = BON[rec]; }
        const f32x4 lg = *(const f32x4*)(lng + j0), lb = *(const f32x4*)(lnb + j0);
        f32x4 acc[4];
#pragma unroll
        for (int n = 0; n < 4; ++n) acc[n] = (f32x4){0.f, 0.f, 0.f, 0.f};
#pragma unroll
        for (int ks = 0; ks < 4; ++ks) {
            const bf16x8_t a_ = *(const bf16x8_t*)(ZG + (size_t)(mB + fr) * 128 + ks * 32 + fq * 8);
#pragma unroll
            for (int n = 0; n < 4; ++n) { const bf16x8_t b_ = *(const bf16x8_t*)(G2T + (size_t)(j0 + n) * 128 + ks * 32 + fq * 8);
                acc[n] = __builtin_amdgcn_mfma_f32_16x16x32_bf16(a_, b_, acc[n], 0, 0, 0); }
        }
#pragma unroll
        for (int r = 0; r < 4; ++r) {
            const int m = mB + 4 * fq + r;
            f32x4 y; y[0] = bflo(yw[r].x); y[1] = bfhi(yw[r].x); y[2] = bflo(yw[r].y); y[3] = bfhi(yw[r].y);
            const float mean = red16((y[0] + y[1]) + (y[2] + y[3])) * (1.0f / 64.0f);
            const f32x4 d = y - mean;
            const float var = red16((d[0] * d[0] + d[1] * d[1]) + (d[2] * d[2] + d[3] * d[3])) * (1.0f / 64.0f);
            const float rs = rsqrtf(var + 64e-5f);
            f32x4 o;
#pragma unroll
            for (int n = 0; n < 4; ++n) o[n] = (d[n] * rs * lg[n] + lb[n] + bon[r] * (float)vv[r][n]) * acc[n][r];
            u32x2 w; w.x = pk_bf(o[0], o[1]); w.y = pk_bf(o[2], o[3]);
            *(u32x2*)(MIX + (size_t)m * DM + j0) = w;
        }
    }
}
__device__ __forceinline__ void post_rw_head(u16* __restrict__ MIX, const h16* __restrict__ RWP, const float* __restrict__ BON, const u16* __restrict__ ZG,
                                             const u16* __restrict__ G2T, const float* __restrict__ lng, const float* __restrict__ lnb, int b, int hh, int chunk0, int nchunk) {
    const int tid_ = otid(); const int lane = tid_ & 63, wid = tid_ >> 6, fr = lane & 15, fq = lane >> 4;
    const int j0 = hh * 64 + 4 * fr;
    bf16x8_t bg[4][4];
#pragma unroll
    for (int ks = 0; ks < 4; ++ks)
#pragma unroll
        for (int n = 0; n < 4; ++n) bg[ks][n] = *(const bf16x8_t*)(G2T + (size_t)(j0 + n) * 128 + ks * 32 + fq * 8);
    const f32x4 lg = *(const f32x4*)(lng + j0), lb = *(const f32x4*)(lnb + j0);
    for (int ci = wid; ci < nchunk; ci += 8) {
        const int tB = (chunk0 + ci) * 16, mB = b * TS + tB;
        u32x2 yw[4]; h16x4 vv[4]; float bon[4];
#pragma unroll
        for (int r = 0; r < 4; ++r) { const int m = mB + 4 * fq + r; const size_t rec = (size_t)(b * 12 + hh) * TS + (tB + 4 * fq + r);
            yw[r] = *(const u32x2*)(MIX + (size_t)m * DM + j0); vv[r] = *(const h16x4*)(RWP + (rec >> 1) * 768 + (9 + (int)(rec & 1)) * 64 + 4 * fr); bon[r] = BON[rec]; }
        f32x4 acc[4];
#pragma unroll
        for (int n = 0; n < 4; ++n) acc[n] = (f32x4){0.f, 0.f, 0.f, 0.f};
#pragma unroll
        for (int ks = 0; ks < 4; ++ks) {
            const bf16x8_t a_ = *(const bf16x8_t*)(ZG + (size_t)(mB + fr) * 128 + ks * 32 + fq * 8);
#pragma unroll
            for (int n = 0; n < 4; ++n) acc[n] = __builtin_amdgcn_mfma_f32_16x16x32_bf16(a_, bg[ks][n], acc[n], 0, 0, 0);
        }
#pragma unroll
        for (int r = 0; r < 4; ++r) {
            const int m = mB + 4 * fq + r;
            f32x4 y; y[0] = bflo(yw[r].x); y[1] = bfhi(yw[r].x); y[2] = bflo(yw[r].y); y[3] = bfhi(yw[r].y);
            const float mean = red16((y[0] + y[1]) + (y[2] + y[3])) * (1.0f / 64.0f);
            const f32x4 d = y - mean;
            const float var = red16((d[0] * d[0] + d[1] * d[1]) + (d[2] * d[2] + d[3] * d[3])) * (1.0f / 64.0f);
            const float rs = rsqrtf(var + 64e-5f);
            f32x4 o;
#pragma unroll
            for (int n = 0; n < 4; ++n) o[n] = (d[n] * rs * lg[n] + lb[n] + bon[r] * (float)vv[r][n]) * acc[n][r];
            u32x2 w; w.x = pk_bf(o[0], o[1]); w.y = pk_bf(o[2], o[3]);
            *(u32x2*)(MIX + (size_t)m * DM + j0) = w;
        }
    }
}
__device__ __forceinline__ void post_gd(u16* __restrict__ MIX, const u16* __restrict__ Z2, const float* __restrict__ ng) {
    const int tid_ = otid(); const int lane = tid_ & 63, wid = tid_ >> 6; const int bidx = obid(), gdim = ogrid();
    for (int task = bidx * 8 + wid; task < 6 * (MT / 32); task += gdim * 8) {
        const int hh = task % 6, chunk = task / 6, m0 = chunk * 32;
        const float n0 = ng[2 * lane], n1 = ng[2 * lane + 1];
        for (int s8 = 0; s8 < 32; s8 += 8) {
          unsigned lo[8], lg[8];
#pragma unroll
          for (int k = 0; k < 8; ++k) { const int m = m0 + s8 + k; lo[k] = *(const unsigned*)(MIX + (size_t)m * DM + 768 + hh * 128 + 2 * lane); lg[k] = *(const unsigned*)(Z2 + (size_t)m * Z2_LD + Z2_GATE + hh * 128 + 2 * lane); }
#pragma unroll
          for (int k = 0; k < 8; ++k) {
            const int m = m0 + s8 + k;
            unsigned* op = (unsigned*)(MIX + (size_t)m * DM + 768 + hh * 128 + 2 * lane);
            const unsigned ow = lo[k];
            const float o0 = bflo(ow), o1 = bfhi(ow);
            const float ss = wave_sum(o0 * o0 + o1 * o1);
            const float rs = rsqrtf(ss * (1.0f / 128.0f) + 1e-6f);
            const unsigned gw = lg[k];
            const float g0 = bflo(gw), g1 = bfhi(gw);
            *op = pk_bf(o0 * rs * n0 * (g0 * sigm(g0)), o1 * rs * n1 * (g1 * sigm(g1)));
          }
        }
    }
}

#define XB_TMO      128
#define XB_XCNT(j)  (256  + 64 * (j))
#define XB_XSUB(j)  (1280 + 64 * (j))
#define XB_XGEN(j)  (2304 + 64 * (j))
#define XB_TOP      3328
#define XB_TOPGEN   3392
#define XCD_BAR_WORDS 3456
#define XB_SPIN_CAP (1u << 18)

__device__ __forceinline__ unsigned xb_ld(unsigned* p)              { return __hip_atomic_load(p, __ATOMIC_RELAXED, __HIP_MEMORY_SCOPE_AGENT); }
__device__ __forceinline__ unsigned xb_add(unsigned* p, unsigned v) { return __hip_atomic_fetch_add(p, v, __ATOMIC_RELAXED, __HIP_MEMORY_SCOPE_AGENT); }
__device__ __forceinline__ unsigned xb_xcc_id() { return (unsigned)__builtin_amdgcn_s_getreg((3 << 11) | 20) & 0xFu; }
#define XB_SPIN(cond, bar) do { unsigned _sp = 0; while (cond) { __builtin_amdgcn_s_sleep(1); \
    if ((++_sp & 255u) == 0u) { if (xb_ld(&(bar)[XB_TMO])) break; if (_sp > XB_SPIN_CAP) { atomicAdd(&(bar)[XB_TMO], 1u); break; } } } } while (0)

struct XcdBarrier {
    unsigned* bar; unsigned x;
    volatile LAS unsigned* st;
};

__device__ __forceinline__ XcdBarrier xcd_barrier_post(unsigned* bar, volatile LAS unsigned* st) {
    XcdBarrier b; b.bar = bar; b.x = xb_xcc_id(); b.st = st;
    if (threadIdx.x == 0) (void)xb_add(&bar[XB_XCNT(b.x)], 1u);
    return b;
}
__device__ __forceinline__ void xcd_barrier_complete(unsigned* bar, unsigned x, unsigned& nloc, unsigned& nx) {
    const unsigned G = gridDim.x * gridDim.y * gridDim.z;
    unsigned sum, cnt, mine, sp = 0u;
    for (;;) {
        sum = 0u; cnt = 0u; mine = 0u;
#pragma unroll
        for (unsigned j = 0; j < 16; ++j) { const unsigned c = xb_ld(&bar[XB_XCNT(j)]); sum += c; cnt += (c > 0u) ? 1u : 0u; mine = (j == x) ? c : mine; }
        if (sum == G) break;
        __builtin_amdgcn_s_sleep(1);
        if ((++sp & 255u) == 0u) { if (xb_ld(&bar[XB_TMO])) break; if (sp > XB_SPIN_CAP) { atomicAdd(&bar[XB_TMO], 1u); break; } }
    }
    nloc = mine > 0u ? mine : 1u; nx = cnt > 0u ? cnt : 1u;
}

__device__ __forceinline__ void xcd_barrier(const XcdBarrier& b) {
    asm volatile("s_waitcnt vmcnt(0)" ::: "memory");
    __syncthreads();
    if (threadIdx.x == 0) {
        unsigned* bar = b.bar;
        __builtin_amdgcn_s_waitcnt(0);
        unsigned nloc = b.st[0], nx = b.st[1];
        if (nloc == 0u) { xcd_barrier_complete(bar, b.x, nloc, nx); b.st[0] = nloc; b.st[1] = nx; }
        const unsigned old = xb_add(&bar[XB_XSUB(b.x)], 1u);
        const unsigned gen = old / nloc;
        if (old + 1u == (gen + 1u) * nloc) {
            __builtin_amdgcn_fence(__ATOMIC_RELEASE, "agent");
            asm volatile("s_waitcnt vmcnt(0)" ::: "memory");
            const unsigned og = xb_add(&bar[XB_TOP], 1u);
            const unsigned tg = og / nx;
            if (og + 1u == (tg + 1u) * nx) xb_add(&bar[XB_TOPGEN], 1u);
            else XB_SPIN(xb_ld(&bar[XB_TOPGEN]) == tg, bar);
            __builtin_amdgcn_fence(__ATOMIC_ACQUIRE, "agent");
            xb_add(&bar[XB_XGEN(b.x)], 1u);
            asm volatile("s_waitcnt vmcnt(0)" ::: "memory");
        } else {
            XB_SPIN(xb_ld(&bar[XB_XGEN(b.x)]) == gen, bar);
            __builtin_amdgcn_fence(__ATOMIC_ACQUIRE, "agent");
            asm volatile("s_waitcnt vmcnt(0)" ::: "memory");
        }
    }
    __syncthreads();
}
__device__ __forceinline__ const float* getp(const LAS unsigned* TAB, int k) {
    const unsigned lo = __builtin_amdgcn_readfirstlane(TAB[2 * k]), hi = __builtin_amdgcn_readfirstlane(TAB[2 * k + 1]);
    return (const float*)(((unsigned long long)hi << 32) | lo);
}
__global__ void __launch_bounds__(512, 2) fwd_mega(Params p) {
    extern __shared__ __attribute__((aligned(16))) unsigned char lds_raw[];
    LAS unsigned char* lds = (LAS unsigned char*)lds_raw;
    cg::grid_group grid = cg::this_grid();
#if REP & 256
#define GSYNC() do { xcd_barrier(xbar); xcd_barrier(xbar); } while (0)
#else
#define GSYNC() xcd_barrier(xbar)
#endif
    unsigned char* ws = p.ws;
    u16* HBUF = (u16*)(ws + WS_HBUF); u16* WGU = (u16*)(ws + WS_WGU); u16* WD = (u16*)(ws + WS_WD); u16* WIN = (u16*)(ws + WS_WIN); u16* WOUT = (u16*)(ws + WS_WOUT);
    u16* ACT = (u16*)(ws + WS_ACT); u16* Z = (u16*)(ws + WS_Z); h16* RWPp = (h16*)(ws + WS_RWP); float* RWSp = (float*)(ws + WS_RWS); u16* ZG = (u16*)(ws + WS_ZG);
    h16* GDPp = (h16*)(ws + WS_GDP); float* GDSp = (float*)(ws + WS_GDS); u16* LRA = (u16*)(ws + WS_LRA); u16* LRUb = (u16*)(ws + WS_LRU); u16* WGU2 = (u16*)(ws + WS_WGU2); u16* WD2 = (u16*)(ws + WS_WD2);
    const bool pre2 = gridDim.x > 208;     float* HIN = (float*)(ws + WS_HIN); float* BONp = (float*)(ws + WS_BON);
    float* X = p.out;
    const int G = gridDim.x, bid = blockIdx.x;
    LAS unsigned* TAB = (LAS unsigned*)(lds + 131072 + 1024);
    if (threadIdx.x == 0) {
#pragma unroll
        for (int i = 0; i < 35; ++i) { const unsigned long long a = (unsigned long long)p.in[i]; TAB[2 * i] = (unsigned)a; TAB[2 * i + 1] = (unsigned)(a >> 32); }
    }
    volatile LAS unsigned* xst = (volatile LAS unsigned*)(lds + 131072 + 512);
    if (threadIdx.x < 2) xst[threadIdx.x] = 0u;
    __syncthreads();
    const XcdBarrier xbar = xcd_barrier_post((unsigned*)(ws + WS_BAR), xst);
    grid.sync();
#define INP(k) getp(TAB, (k))

    for (int l = 0; l < 2; ++l) {
        for (int half = 0; half < 2; ++half) {
            const float* ng = INP(half ? 30 : 1) + (size_t)l * DM;
            const float* wg = INP(half ? 31 : 2) + (size_t)l * DM * DFF;
            const float* wu = INP(half ? 32 : 3) + (size_t)l * DM * DFF;
            const float* wd = INP(half ? 33 : 4) + (size_t)l * DM * DFF;
#if PH & 1
            u16* const WGUc = (half && pre2) ? WGU2 : WGU; u16* const WDc = (half && pre2) ? WD2 : WD;
            if (!(half && pre2)) {
            conv_w<1>(wg, WGUc, DM, DFF, (LAS float*)lds);
            conv_w<2>(wu, WGUc, DM, DFF, (LAS float*)lds);
            conv_w<0>(wd, WDc, DFF, DM, (LAS float*)lds);
            }
#endif
#if PH & 2
            if (l == 0 && half == 0) norm_rows<false>(INP(0), ng, HBUF, nullptr); else norm_rows<false>(X, ng, HBUF, nullptr);
#endif
#if REP & 32
            conv_w<1>(wg, WGU, DM, DFF, (LAS float*)lds);
            conv_w<2>(wu, WGU, DM, DFF, (LAS float*)lds);
            conv_w<0>(wd, WD, DFF, DM, (LAS float*)lds);
#endif
#if REP & 64
            if (l == 0 && half == 0) norm_rows<false>(INP(0), ng, HBUF, X); else norm_rows<false>(X, ng, HBUF, nullptr);
#endif
            GSYNC();
#if PH & 4
            { pg8::Gemm g{HBUF, WGUc, MT, 2 * DFF, DM}; pg8::StaticOrder S; S.init(MT, 2 * DFF, G, bid); pg8::EpiGU E{ACT, DFF};
              pg8::gemm_phase<pg8::EpiGU, pg8::StaticOrder>(lds, g, S, E);
#if REP & 1
              GSYNC(); pg8::gemm_phase<pg8::EpiGU, pg8::StaticOrder>(lds, g, S, E);
#endif
            }
#endif
            GSYNC();
#if PH & 8
            { pg8::Gemm g{ACT, WDc, MT, DM, DFF}; pg8::StaticOrder S; S.init(MT, DM, G, bid); pg8::EpiResid E{(l == 0 && half == 0) ? INP(0) : (const float*)X, X, DM, (REP & 2) ? 0.25f : 0.5f};
              pg8::gemm_phase<pg8::EpiResid, pg8::StaticOrder, true>(lds, g, S, E);
#if REP & 2
              GSYNC(); pg8::gemm_phase<pg8::EpiResid, pg8::StaticOrder, true>(lds, g, S, E);
#endif
            }
#endif
            GSYNC();
            if (half == 1) continue;
#if PH & 16
            conv_w<3>(INP(6) + (size_t)l * DM * 6668, WIN, DM, 6668, (LAS float*)lds);
            conv_w<0>(INP(29) + (size_t)l * DM * DM, WOUT, DM, DM, (LAS float*)lds);
            tr_small(INP(9) + l * 64 * 768, (u16*)(ws + WS_W2T), 64); tr_small(INP(11) + l * 64 * 768, (u16*)(ws + WS_A2T), 64); tr_small(INP(12) + l * 128 * 768, (u16*)(ws + WS_G2T), 128);
            tr_blocks(INP(24) + l * 8 * 64 * 64, (u16*)(ws + WS_WAT)); tr_blocks(INP(26) + l * 8 * 64 * 64, (u16*)(ws + WS_WXT));
            norm_rows<false>(X, INP(5) + (size_t)l * DM, HBUF, nullptr);
#endif
            GSYNC();
#if PH & 32
            { pg8::Gemm g{HBUF, WIN, MT, 2560, DM}; pg8::StaticOrder S; S.init(MT, 2560, G, bid); pg8::EpiZ E{Z, Z1_LD};
              pg8::gemm_phase<pg8::EpiZ, pg8::StaticOrder>(lds, g, S, E); }
#endif
            GSYNC();
#if PH & 64
            { RwP P{INP(7) + l * 2560, INP(8) + l * 768, INP(9) + l * 64 * 768, INP(10) + l * 768, INP(11) + l * 64 * 768, INP(13) + l * 768, INP(14) + l * 768, INP(15) + l * 768};
              prep_rw2(Z, P, (const u16*)(ws + WS_W2T), (const u16*)(ws + WS_A2T), RWPp, RWSp, BONp, ZG, lds);
#if REP & 8
              prep_rw2(Z, P, (const u16*)(ws + WS_W2T), (const u16*)(ws + WS_A2T), RWPp, RWSp, BONp, ZG, lds);
#endif
            }
#endif
            GSYNC();
#if PH & 128
            { pg8::Gemm g{HBUF, WIN + (size_t)2560 * DM, MT, 4352, DM}; pg8::StaticOrder S; S.init(MT, 4352, G, bid); pg8::EpiZ E{Z, Z2_LD};
              pg8::gemm_phase<pg8::EpiZ, pg8::StaticOrder>(lds, g, S, E); }
#endif
            GSYNC();
#if PH & 256
            prep_gd(Z, INP(18) + l * 4 * 2304, INP(19) + l * 6, INP(20) + l * 6, GDPp, GDSp);
#endif
#if PH & 512
            { LrP P{INP(22) + l * 4 * 512, INP(23) + l * 512, INP(24) + l * 8 * 64 * 64, INP(25) + l * 512, INP(26) + l * 8 * 64 * 64, INP(27) + l * 512, INP(28) + l * 512};
              if (!pre2) prep_lr2(Z, P, (const u16*)(ws + WS_WAT), (const u16*)(ws + WS_WXT), LRA, LRUb, lds);
            }
#endif
            GSYNC();
#if PH & 1024
            for (int rep_ = 0; rep_ < ((REP & 4) ? 2 : 1); ++rep_)
            for (int task = bid; task < 208; task += G) {
                if (task < 96) { const int bh = task >> 2, q4 = task & 3, b = bh / 12, hh = bh % 12;
                    rec_block<0>((const unsigned char*)RWPp + (size_t)bh * TS * 768, (const unsigned char*)RWSp + (size_t)bh * TS * 16,
                                 HBUF + (size_t)b * TS * DM + hh * 64 + q4 * 16, q4 * 16, lds);
                    __threadfence();
                    __syncthreads();
                    if (threadIdx.x == 0) {
                        unsigned* cnt = (unsigned*)(ws + WS_BAR + 14336) + bh;
                        __hip_atomic_fetch_add(cnt, 1u, __ATOMIC_RELAXED, __HIP_MEMORY_SCOPE_AGENT);
                        const unsigned want = 4u * (unsigned)(l + 1); unsigned spins = 0;
                        while (__hip_atomic_load(cnt, __ATOMIC_RELAXED, __HIP_MEMORY_SCOPE_AGENT) < want) { __builtin_amdgcn_s_sleep(8); if (++spins > (1u << 22)) break; }
                        __builtin_amdgcn_fence(__ATOMIC_ACQUIRE, "agent");
                        asm volatile("s_waitcnt vmcnt(0)" ::: "memory");
                    }
                    __syncthreads();
                    post_rw_head(HBUF, RWPp, BONp, ZG, (const u16*)(ws + WS_G2T), INP(16) + l * 768, INP(17) + l * 768, b, hh, q4 * (TS / 64), TS / 64); }
                else if (task < 192) { const int gb = task - 96, bh = gb >> 3, o8 = gb & 7, b = bh / 6, hh = bh % 6;
                    rec_block<1>((const unsigned char*)GDPp + (size_t)bh * TS * 768, (const unsigned char*)GDSp + (size_t)bh * TS * 16,
                                 HBUF + (size_t)b * TS * DM + 768 + hh * 128 + o8 * 16, o8 * 16, lds); }
                else if (threadIdx.x < 64) {
                    if (pre2) { unsigned* c3 = (unsigned*)(ws + WS_BAR + 14336) + 48; const unsigned want3 = (unsigned)(G - 208) * (unsigned)(l + 1); unsigned spins = 0;
                        while (__hip_atomic_load(c3, __ATOMIC_RELAXED, __HIP_MEMORY_SCOPE_AGENT) < want3) { __builtin_amdgcn_s_sleep(8); if (++spins > (1u << 22)) break; }
                        __builtin_amdgcn_fence(__ATOMIC_ACQUIRE, "agent"); asm volatile("s_waitcnt vmcnt(0)" ::: "memory"); }
                    lru_carry(task - 192, LRA, LRUb, HIN);
                    __threadfence();
                    if (threadIdx.x == 0) __hip_atomic_fetch_add((unsigned*)(ws + WS_BAR + 14336) + 32, 1u, __ATOMIC_RELAXED, __HIP_MEMORY_SCOPE_AGENT); }
            }
            if (pre2 && bid >= 208) {
                { LrP P{INP(22) + l * 4 * 512, INP(23) + l * 512, INP(24) + l * 8 * 64 * 64, INP(25) + l * 512, INP(26) + l * 8 * 64 * 64, INP(27) + l * 512, INP(28) + l * 512};
                  prep_lr2(Z, P, (const u16*)(ws + WS_WAT), (const u16*)(ws + WS_WXT), LRA, LRUb, lds, bid - 208, G - 208); }
                __threadfence();
                __syncthreads();
                if (threadIdx.x == 0) __hip_atomic_fetch_add((unsigned*)(ws + WS_BAR + 14336) + 48, 1u, __ATOMIC_RELAXED, __HIP_MEMORY_SCOPE_AGENT);
                conv_w<1>(INP(31) + (size_t)l * DM * DFF, WGU2, DM, DFF, (LAS float*)lds, bid - 208, G - 208);
                conv_w<2>(INP(32) + (size_t)l * DM * DFF, WGU2, DM, DFF, (LAS float*)lds, bid - 208, G - 208);
                conv_w<0>(INP(33) + (size_t)l * DM * DFF, WD2, DFF, DM, (LAS float*)lds, bid - 208, G - 208);
                if (threadIdx.x == 0) {
                    unsigned* cnt = (unsigned*)(ws + WS_BAR + 14336) + 32; const unsigned want = 16u * (unsigned)(l + 1); unsigned spins = 0;
                    while (__hip_atomic_load(cnt, __ATOMIC_RELAXED, __HIP_MEMORY_SCOPE_AGENT) < want) { __builtin_amdgcn_s_sleep(8); if (++spins > (1u << 22)) break; }
                    __builtin_amdgcn_fence(__ATOMIC_ACQUIRE, "agent");
                    asm volatile("s_waitcnt vmcnt(0)" ::: "memory");
                }
                __syncthreads();
                post_lr(HBUF, Z, LRA, LRUb, HIN, bid - 208, G - 208);
            }
#endif
            GSYNC();
#if PH & 2048
#endif
#if PH & 4096
            post_gd(HBUF, Z, INP(21) + l * 128);
            if (!pre2) post_lr(HBUF, Z, LRA, LRUb, HIN);
#endif
            GSYNC();
#if PH & 8192
            { pg8::Gemm g{HBUF, WOUT, MT, DM, DM}; pg8::StaticOrder S; S.init(MT, DM, G, bid); pg8::EpiResid E{X, X, DM, 1.0f};
              pg8::gemm_phase<pg8::EpiResid, pg8::StaticOrder>(lds, g, S, E); }
#endif
            GSYNC();
        }
    }
    norm_rows<true>(X, INP(34), nullptr, X);
}

extern "C" void kernel_launch(void* const* d_in, const int* in_sizes, int n_in, void* d_out, int out_size, void* d_ws, size_t ws_size, hipStream_t stream) {
    static int grid_blocks = 0;
    if (!grid_blocks) {
        int dev = 0, cus = 0, per_cu = 0;
        (void)hipGetDevice(&dev);
        (void)hipDeviceGetAttribute(&cus, hipDeviceAttributeMultiprocessorCount, dev);
        (void)hipFuncSetAttribute((const void*)fwd_mega, hipFuncAttributeMaxDynamicSharedMemorySize, LDS_BYTES);
        (void)hipOccupancyMaxActiveBlocksPerMultiprocessor(&per_cu, (const void*)fwd_mega, 512, LDS_BYTES);
        grid_blocks = cus > 0 ? cus : 256;
        if (ws_size < WS_END) fprintf(stderr, "kernel_launch: workspace too small: %zu < %zu\n", ws_size, (size_t)WS_END);
        fprintf(stderr, "kernel_launch: cus %d occupancy %d ws %zu n_in %d\n", cus, per_cu, ws_size, n_in);
    }
    Params p{};
    for (int i = 0; i < 35; ++i) p.in[i] = (const float*)d_in[i];
    p.out = (float*)d_out; p.ws = (unsigned char*)d_ws;
    (void)hipMemsetAsync((unsigned char*)d_ws + WS_BAR, 0, 16384, stream);
    void* args[] = {&p};
    hipError_t e = hipLaunchCooperativeKernel((const void*)fwd_mega, dim3(grid_blocks), dim3(512), args, LDS_BYTES, stream);
    if (e != hipSuccess) fprintf(stderr, "cooperative launch failed: %s (grid %d)\n", hipGetErrorString(e), grid_blocks);
}
```

```cpp
#include <hip/hip_runtime.h>
#include <hip/hip_cooperative_groups.h>
#include <cstdio>
namespace cg = cooperative_groups;
#include <hip/hip_runtime.h>
namespace pg8 {
#define PG8_LAS __attribute__((address_space(3)))
typedef unsigned short bf16_t;
typedef short bf16x8 __attribute__((ext_vector_type(8)));
typedef float f32x4 __attribute__((ext_vector_type(4)));
typedef unsigned u32x4 __attribute__((ext_vector_type(4)));
constexpr int BM = 256, BK = 64, HALF = 128, HTB = HALF * BK * 2  , STAGE_BYTES = 8 * HTB, NXCD = 8, WGM = 8;

__host__ __device__ __forceinline__ int lds_byte(int r, int c) { const int st = (r >> 4) * 2 + (c >> 5), rr = r & 15, cc = c & 31, ob = rr * 64 + cc * 2; return st * 1024 + (ob ^ (((ob >> 9) & 1) << 5)); }
__host__ __device__ __forceinline__ void stage_rc(int b, int& R, int& C) { const int st = b / 1024, sb = b % 1024, swz = sb ^ (((sb >> 9) & 1) << 5); R = (st >> 1) * 16 + swz / 64; C = (st & 1) * 32 + (swz % 64) / 2; }
__host__ __device__ __forceinline__ int perm32(int rho) { const int n = rho >> 4, i = rho & 15; return 8 * (i >> 2) + 4 * n + (i & 3); }

struct Unit { int pm, pn; };
struct Gemm { const bf16_t* A; const bf16_t* Bt; int M, N, K; };

struct StaticOrder {
    int nM, nN, nwg, G, c;
    __host__ __device__ void init(int M, int N, int G_, int c_) { nM = M / BM; nN = N / BM; nwg = nM * nN; G = G_; c = c_; }
    __host__ __device__ bool next(int i, Unit& u) const {
        const long L = (long)i * G + c; if (L >= nwg) return false;
        int wgid = (int)L; { const int q = nwg / NXCD, r = nwg % NXCD, xcd = wgid % NXCD, off = wgid / NXCD; wgid = (xcd < r ? xcd * (q + 1) : r * (q + 1) + (xcd - r) * q) + off; }
        const int nig = WGM * nN, gid = wgid / nig, fm = gid * WGM, gsz = (nM - fm) < WGM ? (nM - fm) : WGM;
        u.pm = fm + ((wgid % nig) % gsz); u.pn = (wgid % nig) / gsz; return true;
    }
    __device__ __forceinline__ void a_ready(const Unit&) const {}
    __device__ __forceinline__ void done(const Unit&) const {}
};
__device__ __forceinline__ unsigned cvt_pk_bf16(float lo, float hi) { unsigned r; asm volatile("v_cvt_pk_bf16_f32 %0, %1, %2" : "=v"(r) : "v"(lo), "v"(hi)); return r; }
typedef float f32x2 __attribute__((ext_vector_type(2)));
typedef unsigned u32x2 __attribute__((ext_vector_type(2)));
__device__ __forceinline__ float fast_silu(float g) { return g * __builtin_amdgcn_rcpf(1.0f + __expf(-g)); }
struct EpiGU {
    static constexpr bool PERM = true, AFTER_DRAIN = false;
    bf16_t* O; int ldc;
    __device__ __forceinline__ void operator()(const f32x4 (&acc)[2][2][4][2], const Unit& u, int wr, int wc, int fr, int fq) const {
        const int rl0 = wr * 64 + fr, col0 = u.pn * HALF + wc * 32 + 8 * fq;
        bf16_t* const blk = O + ((size_t)u.pm * (ldc >> 6) + (col0 >> 6)) * (BM * 64) + (col0 & 63);
#pragma unroll
        for (int ai = 0; ai < 2; ++ai)
#pragma unroll
            for (int m = 0; m < 4; ++m) { bf16_t* rowp = blk + (size_t)(rl0 + ai * HALF + m * 16) * 64;
                const f32x4 g0 = acc[ai][0][m][0], g1 = acc[ai][0][m][1], u0 = acc[ai][1][m][0], u1 = acc[ai][1][m][1];
                f32x4 h0, h1;
#pragma unroll
                for (int j = 0; j < 4; ++j) { h0[j] = fast_silu(g0[j]) * u0[j]; h1[j] = fast_silu(g1[j]) * u1[j]; }
                u32x4 w; w.x = cvt_pk_bf16(h0[0], h0[1]); w.y = cvt_pk_bf16(h0[2], h0[3]); w.z = cvt_pk_bf16(h1[0], h1[1]); w.w = cvt_pk_bf16(h1[2], h1[3]);
                *(u32x4*)rowp = w; }
    }
};
struct EpiZ {
    static constexpr bool PERM = true, AFTER_DRAIN = false;
    bf16_t* O; int ldc;
    __device__ __forceinline__ void operator()(const f32x4 (&acc)[2][2][4][2], const Unit& u, int wr, int wc, int fr, int fq) const {
        const int row0 = u.pm * BM + wr * 64 + fr, col0 = u.pn * BM + wc * 32 + 8 * fq;
#pragma unroll
        for (int ai = 0; ai < 2; ++ai)
#pragma unroll
            for (int m = 0; m < 4; ++m) { bf16_t* rowp = O + (size_t)(row0 + ai * HALF + m * 16) * ldc + col0;
#pragma unroll
                for (int bj = 0; bj < 2; ++bj) { const f32x4 v0 = acc[ai][bj][m][0], v1 = acc[ai][bj][m][1];
                    u32x4 w; w.x = cvt_pk_bf16(v0[0], v0[1]); w.y = cvt_pk_bf16(v0[2], v0[3]); w.z = cvt_pk_bf16(v1[0], v1[1]); w.w = cvt_pk_bf16(v1[2], v1[3]);
                    *(u32x4*)(rowp + bj * HALF) = w; } }
    }
};
struct EpiResid {
    static constexpr bool PERM = true, AFTER_DRAIN = false;
    const float* Xs; float* X; int ldc; float scale;
    __device__ __forceinline__ void operator()(const f32x4 (&acc)[2][2][4][2], const Unit& u, int wr, int wc, int fr, int fq) const {
        const int row0 = u.pm * BM + wr * 64 + fr, col0 = u.pn * BM + wc * 32 + 8 * fq;
#pragma unroll
        for (int ai = 0; ai < 2; ++ai)
#pragma unroll
            for (int m = 0; m < 4; ++m) { const size_t off = (size_t)(row0 + ai * HALF + m * 16) * ldc + col0;
#pragma unroll
                for (int bj = 0; bj < 2; ++bj) { const size_t o2 = off + bj * HALF;
                    const f32x4 x0 = *(const f32x4*)(Xs + o2) + acc[ai][bj][m][0] * scale, x1 = *(const f32x4*)(Xs + o2 + 4) + acc[ai][bj][m][1] * scale;
                    *(f32x4*)(X + o2) = x0; *(f32x4*)(X + o2 + 4) = x1; } }
    }
};
template <class Epi, class Sched, bool ABLK = false>
__device__ __forceinline__ void gemm_phase(PG8_LAS unsigned char* lds, const Gemm g, const Sched& S, const Epi& E) {
    int tid_o = threadIdx.x; asm volatile("" : "+v"(tid_o));
    const int tid = tid_o, wid = __builtin_amdgcn_readfirstlane(tid >> 6), lane = tid & 63, wr = wid >> 2, wc = wid & 3, fr = lane & 15, fq = lane >> 4;
    const int K = g.K, nt = K / BK;
    unsigned voffA[2], voffB[2];
#pragma unroll
    for (int i = 0; i < 2; ++i) { int R, C; stage_rc(tid * 16 + i * 8192, R, C); const int Rb = Epi::PERM ? ((R & ~31) + perm32(R & 31)) : R;
        voffA[i] = ABLK ? (unsigned)(R * BK + C) * 2u : (unsigned)(R * K + C) * 2u; voffB[i] = (unsigned)(Rb * K + C) * 2u; }
    const size_t kstep = (size_t)(BK * 2);
    const size_t hstep = (size_t)HALF * K * 2;
    const size_t tstep = 2 * hstep;
    const size_t kstepA = ABLK ? (size_t)(BM * BK * 2) : kstep, hstepA = ABLK ? (size_t)(HALF * BK * 2) : hstep, tstepA = tstep;
    const unsigned ldsw = (unsigned)wid * 1024u;
    const int aoff = lds_byte(wr * 64 + fr, fq * 8), boff = lds_byte(wc * 32 + fr, fq * 8);
#define PG8_SA(b, h) (((b) * 2 + (h)) * HTB)
#define PG8_SB(b, h) ((4 + (b) * 2 + (h)) * HTB)
#define PG8_STAGE(bufoff, gbase, voff) do { _Pragma("unroll") for (int _i = 0; _i < 2; ++_i) \
        __builtin_amdgcn_global_load_lds((const unsigned*)((const char*)(gbase) + (voff)[_i]), (PG8_LAS unsigned*)(lds + (bufoff) + ldsw + _i * 8192), 16, 0, 0); } while (0)
#define PG8_LDA(dst, b, h) do { _Pragma("unroll") for (int m = 0; m < 4; ++m) _Pragma("unroll") for (int k = 0; k < 2; ++k) dst[m][k] = *(const PG8_LAS bf16x8*)(lds + PG8_SA(b, h) + aoff + m * 2048 + k * 1024); } while (0)
#define PG8_LDB(dst, b, h) do { _Pragma("unroll") for (int n = 0; n < 2; ++n) _Pragma("unroll") for (int k = 0; k < 2; ++k) dst[n][k] = *(const PG8_LAS bf16x8*)(lds + PG8_SB(b, h) + boff + n * 2048 + k * 1024); } while (0)
#define PG8_MMA(ai, bj, At, Bt) do { __builtin_amdgcn_s_setprio(1); _Pragma("unroll") for (int m = 0; m < 4; ++m) _Pragma("unroll") for (int n = 0; n < 2; ++n) _Pragma("unroll") for (int k = 0; k < 2; ++k) \
        acc[ai][bj][m][n] = __builtin_amdgcn_mfma_f32_16x16x32_bf16(Bt[n][k], At[m][k], acc[ai][bj][m][n], 0, 0, 0); __builtin_amdgcn_s_setprio(0); } while (0)
#define PG8_WAIT_V(n) asm volatile("s_waitcnt vmcnt(" #n ")" ::: "memory")
#define PG8_WAIT_L(n) asm volatile("s_waitcnt lgkmcnt(" #n ")" ::: "memory")
#define PG8_BAR __builtin_amdgcn_s_barrier()
#define PG8_SCHED __builtin_amdgcn_sched_barrier(0)
    Unit cur, nxt; int ui = 0;
    if (!S.next(0, cur)) return;
    f32x4 acc[2][2][4][2];
#pragma unroll
    for (int a = 0; a < 2; ++a)
#pragma unroll
        for (int b = 0; b < 2; ++b)
#pragma unroll
            for (int m = 0; m < 4; ++m)
#pragma unroll
                for (int n = 0; n < 2; ++n) acc[a][b][m][n] = (f32x4){0.f, 0.f, 0.f, 0.f};
    bf16x8 At[4][2], B0[2][2], B1[2][2];
    const char* cA = (const char*)g.A + (size_t)cur.pm * tstepA; const char* cB = (const char*)g.Bt + (size_t)cur.pn * tstep;
    S.a_ready(cur);
    PG8_STAGE(PG8_SB(0, 0), cB, voffB); PG8_STAGE(PG8_SA(0, 0), cA, voffA); PG8_STAGE(PG8_SB(0, 1), cB + hstep, voffB); PG8_STAGE(PG8_SA(0, 1), cA + hstepA, voffA);
    if (wr == 1) PG8_BAR;
    PG8_WAIT_V(4); PG8_BAR;
    PG8_STAGE(PG8_SB(1, 0), cB + kstep, voffB); PG8_STAGE(PG8_SA(1, 0), cA + kstepA, voffA); PG8_STAGE(PG8_SB(1, 1), cB + hstep + kstep, voffB);
    PG8_WAIT_V(6); PG8_BAR;
    for (;;) {
        const bool has_next = S.next(ui + 1, nxt);
        const char* nA = has_next ? (const char*)g.A + (size_t)nxt.pm * tstepA : cA; const char* nB = has_next ? (const char*)g.Bt + (size_t)nxt.pn * tstep : cB;
        for (int t = 0; t < nt; t += 2) {
            const bool last = (t == nt - 2);
            const char* a1 = cA + (size_t)(t + 1) * kstepA;
            const char* a2 = last ? nA : cA + (size_t)(t + 2) * kstepA; const char* b2 = last ? nB : cB + (size_t)(t + 2) * kstep;
            const char* a3 = a2 + kstepA; const char* b3 = b2 + kstep;
            if (last && has_next) S.a_ready(nxt);
            PG8_LDB(B0, 0, 0); PG8_SCHED; PG8_LDA(At, 0, 0); PG8_STAGE(PG8_SA(1, 1), a1 + hstepA, voffA);
            PG8_WAIT_L(8); PG8_BAR; PG8_WAIT_L(0); PG8_MMA(0, 0, At, B0); PG8_BAR; PG8_SCHED;
            PG8_LDB(B1, 0, 1); PG8_STAGE(PG8_SB(0, 0), b2, voffB);
            PG8_BAR; PG8_WAIT_L(0); PG8_MMA(0, 1, At, B1); PG8_BAR;
            PG8_LDA(At, 0, 1); PG8_STAGE(PG8_SA(0, 0), a2, voffA);
            PG8_BAR; PG8_WAIT_L(0); PG8_MMA(1, 0, At, B0); PG8_BAR; PG8_SCHED;
            PG8_STAGE(PG8_SB(0, 1), b2 + hstep, voffB);
            PG8_WAIT_V(6); PG8_BAR; PG8_MMA(1, 1, At, B1); PG8_BAR;
            PG8_LDB(B0, 1, 0); PG8_SCHED; PG8_LDA(At, 1, 0); PG8_STAGE(PG8_SA(0, 1), a2 + hstepA, voffA);
            PG8_WAIT_L(8); PG8_BAR; PG8_WAIT_L(0); PG8_MMA(0, 0, At, B0); PG8_BAR; PG8_SCHED;
            PG8_LDB(B1, 1, 1); PG8_STAGE(PG8_SB(1, 0), b3, voffB);
            PG8_BAR; PG8_WAIT_L(0); PG8_MMA(0, 1, At, B1); PG8_BAR;
            PG8_LDA(At, 1, 1); PG8_STAGE(PG8_SA(1, 0), a3, voffA);
            PG8_BAR; PG8_WAIT_L(0); PG8_MMA(1, 0, At, B0); PG8_BAR; PG8_SCHED;
            PG8_STAGE(PG8_SB(1, 1), b3 + hstep, voffB);
            PG8_WAIT_V(6); PG8_BAR; PG8_MMA(1, 1, At, B1); PG8_BAR;
        }
        if constexpr (!Epi::AFTER_DRAIN) { E(acc, cur, wr, wc, fr, fq); S.done(cur); }
        if (!has_next) break;
#pragma unroll
        for (int a = 0; a < 2; ++a)
#pragma unroll
            for (int b = 0; b < 2; ++b)
#pragma unroll
                for (int m = 0; m < 4; ++m)
#pragma unroll
                    for (int n = 0; n < 2; ++n) acc[a][b][m][n] = (f32x4){0.f, 0.f, 0.f, 0.f};
        cur = nxt; cA = nA; cB = nB; ++ui;
    }
    PG8_WAIT_V(0);
    if (wr == 0) PG8_BAR;
    PG8_BAR;
    if constexpr (Epi::AFTER_DRAIN) { E.fused(acc, cur, wr, wc, fr, fq, lds, wid, lane); S.done(cur); }
#undef PG8_SA
#undef PG8_SB
#undef PG8_STAGE
#undef PG8_LDA
#undef PG8_LDB
#undef PG8_MMA
#undef PG8_WAIT_V
#undef PG8_WAIT_L
#undef PG8_BAR
#undef PG8_SCHED
}
}
#ifndef PH
#define PH 0xFFFF
#endif
#ifndef REP
#define REP 0
#endif
typedef unsigned short u16;
typedef float f32x4 __attribute__((ext_vector_type(4)));
typedef float f32x2 __attribute__((ext_vector_type(2)));
typedef unsigned u32x4 __attribute__((ext_vector_type(4)));
typedef unsigned u32x2 __attribute__((ext_vector_type(2)));
typedef _Float16 h16;
typedef _Float16 h16x4 __attribute__((ext_vector_type(4)));
typedef _Float16 h16x8 __attribute__((ext_vector_type(8)));
typedef _Float16 h16x2 __attribute__((ext_vector_type(2)));
#define LAS __attribute__((address_space(3)))

constexpr int MT = 32768, TS = 16384, DM = 2048, DFF = 5632;
constexpr int LDS_BYTES = 144 * 1024;
constexpr size_t WS_HBUF = 0;
constexpr size_t WS_WBUF = 134217728;
constexpr size_t WS_WGU = WS_WBUF, WS_WD = WS_WBUF + 46137344;
constexpr size_t WS_WIN = WS_WBUF, WS_WOUT = WS_WBUF + 28311552;
constexpr size_t WS_ACT = WS_WBUF + 69206016;
constexpr size_t WS_Z = WS_WBUF + 36700160;
constexpr size_t WS_RWP = WS_Z + 285212672;
constexpr size_t WS_RWS = WS_RWP + 301989888;
constexpr size_t WS_ZG = WS_RWS + 6291456;
constexpr size_t WS_GDP = WS_ZG + 8388608;
constexpr size_t WS_GDS = WS_GDP + 150994944;
constexpr size_t WS_LRA = WS_GDS + 3145728;
constexpr size_t WS_LRU = WS_LRA + 33554432;
constexpr size_t WS_WGU2 = WS_LRU + 33554432;
constexpr size_t WS_WD2 = WS_WGU2 + 46137344;
constexpr size_t WS_HIN = WS_WD2 + 23068672;
constexpr size_t WS_BON = WS_HIN + 1048576;
constexpr size_t WS_BAR = WS_BON + 1572864;
constexpr size_t WS_W2T = WS_BAR + 16384;
constexpr size_t WS_A2T = WS_W2T + 98304;
constexpr size_t WS_G2T = WS_A2T + 98304;
constexpr size_t WS_WAT = WS_G2T + 196608;
constexpr size_t WS_WXT = WS_WAT + 65536;
constexpr size_t WS_END = WS_WXT + 65536;
static_assert(WS_END <= 1073741824ull, "workspace");
constexpr int Z1_LD = 2560, Z2_LD = 4352;
constexpr int Z2_GATE = 2304, Z2_XL = 3072, Z2_YL = 3584, Z2_ZB = 4096, Z2_ZA = 4102;

struct Params { const float* in[35]; float* out; unsigned char* ws; };

__device__ __forceinline__ int otid() { int t = threadIdx.x; asm volatile("" : "+v"(t)); return t; }
__device__ __forceinline__ int obid() { int t = blockIdx.x; asm volatile("" : "+s"(t)); return t; }
__device__ __forceinline__ int ogrid() { int t = gridDim.x; asm volatile("" : "+s"(t)); return t; }
__device__ __forceinline__ float bf2f(u16 h) { return __uint_as_float((unsigned)h << 16); }
__device__ __forceinline__ float bflo(unsigned w) { return __uint_as_float(w << 16); }
__device__ __forceinline__ float bfhi(unsigned w) { return __uint_as_float(w & 0xffff0000u); }
__device__ __forceinline__ u16 f2bf(float f) { unsigned u = __float_as_uint(f); u += 0x7FFFu + ((u >> 16) & 1u); return (u16)(u >> 16); }
__device__ __forceinline__ unsigned pk_bf(float lo, float hi) { return pg8::cvt_pk_bf16(lo, hi); }
template <int C> __device__ __forceinline__ float dppf(float v) { return __int_as_float(__builtin_amdgcn_update_dpp(0, __float_as_int(v), C, 0xF, 0xF, true)); }
template <int H> __device__ __forceinline__ float fmix(float a, unsigned hp, float c) { float d;
    if (H == 0) asm("v_fma_mix_f32 %0, %1, %2, %3 op_sel_hi:[0,1,0]" : "=v"(d) : "v"(a), "v"(hp), "v"(c));
    else        asm("v_fma_mix_f32 %0, %1, %2, %3 op_sel:[0,1,0] op_sel_hi:[0,1,0]" : "=v"(d) : "v"(a), "v"(hp), "v"(c));
    return d; }
template <int H> __device__ __forceinline__ float fmixn(float a, unsigned hp, float c) { float d;
    if (H == 0) asm("v_fma_mix_f32 %0, -%1, %2, %3 op_sel_hi:[0,1,0]" : "=v"(d) : "v"(a), "v"(hp), "v"(c));
    else        asm("v_fma_mix_f32 %0, -%1, %2, %3 op_sel:[0,1,0] op_sel_hi:[0,1,0]" : "=v"(d) : "v"(a), "v"(hp), "v"(c));
    return d; }
__device__ __forceinline__ float red16(float v) { v += dppf<0xB1>(v); v += dppf<0x4E>(v); v += dppf<0x141>(v); v += dppf<0x140>(v); return v; }
__device__ __forceinline__ float rlane(float v, int l) { return __int_as_float(__builtin_amdgcn_readlane(__float_as_int(v), l)); }
__device__ __forceinline__ float wave_sum(float v) { v = red16(v);
    v += __int_as_float(__builtin_amdgcn_update_dpp(0, __float_as_int(v), 0x142, 0xA, 0xF, false));
    v += __int_as_float(__builtin_amdgcn_update_dpp(0, __float_as_int(v), 0x143, 0xC, 0xF, false));
    return rlane(v, 63); }
__device__ __forceinline__ float sigm(float x) { return __builtin_amdgcn_rcpf(1.0f + __expf(-x)); }
__device__ __forceinline__ float softplus_(float x) { return fmaxf(x, 0.0f) + __logf(1.0f + __expf(-fabsf(x))); }
__device__ __forceinline__ float tanh_(float x) { const float e = __expf(-2.0f * fabsf(x)); const float t = (1.0f - e) * __builtin_amdgcn_rcpf(1.0f + e); return x < 0.f ? -t : t; }
__device__ __forceinline__ float gelu_tanh(float x) { return 0.5f * x * (1.0f + tanh_(0.7978845608028654f * (x + 0.044715f * x * x * x))); }

template <int MAP> __device__ __forceinline__ int rowmap(int n) {
    if (MAP == 0) return n;
    if (MAP == 1) return (n >> 7) * 256 + (n & 127);
    if (MAP == 2) return (n >> 7) * 256 + 128 + (n & 127);
    if (n < 2560 + 3072) return n;
    const int q = n - 2560;
    if (q < 3084) return 2560 + Z2_ZB + (q - 3072);
    return 2560 + Z2_XL + (q - 3084);
}
template <int MAP> __device__ __forceinline__ void conv_w(const float* __restrict__ src, u16* __restrict__ dst, int K, int N, LAS float* tile, int bsub = 0, int gsub = 0) {
    const int tid = otid(), NT = (N + 63) >> 6, KT = K >> 6; const int bidx = gsub ? bsub : obid(), gdim = gsub ? gsub : ogrid();
    for (int t = bidx; t < NT * KT; t += gdim) {
        const int nt = t % NT, kt = t / NT;
        const int c = tid & 63, r0 = tid >> 6, n = nt * 64 + c;
#pragma unroll
        for (int i = 0; i < 8; ++i) { const int r = r0 + 8 * i; tile[r * 65 + c] = (n < N) ? src[(size_t)(kt * 64 + r) * N + n] : 0.f; }
        __syncthreads();
        const int nl = tid >> 3, kq = tid & 7, n2 = nt * 64 + nl;
        if (n2 < N) {
            float v[8];
#pragma unroll
            for (int j = 0; j < 8; ++j) v[j] = tile[(kq * 8 + j) * 65 + nl];
            u32x4 w; w.x = pk_bf(v[0], v[1]); w.y = pk_bf(v[2], v[3]); w.z = pk_bf(v[4], v[5]); w.w = pk_bf(v[6], v[7]);
            *(u32x4*)(dst + (size_t)rowmap<MAP>(n2) * K + kt * 64 + kq * 8) = w;
        }
        __syncthreads();
    }
}

template <bool FINAL> __device__ __forceinline__ void norm_rows(const float* src, const float* __restrict__ gamma, u16* dst, float* copy) {
    const int tid_ = otid(); const int lane = tid_ & 63, wid = tid_ >> 6; const int bidx = obid(), gdim = ogrid();
    f32x4 g[8];
#pragma unroll
    for (int i = 0; i < 8; ++i) g[i] = *(const f32x4*)(gamma + i * 256 + lane * 4);
    for (int row = bidx * 8 + wid; row < MT; row += gdim * 8) {
        const float* p = src + (size_t)row * DM; f32x4 v[8]; float ss = 0.f;
#pragma unroll
        for (int i = 0; i < 8; ++i) { v[i] = *(const f32x4*)(p + i * 256 + lane * 4); ss += v[i][0] * v[i][0] + v[i][1] * v[i][1] + v[i][2] * v[i][2] + v[i][3] * v[i][3]; }
        ss = wave_sum(ss);
        const float rs = rsqrtf(ss * (1.0f / 2048.0f) + 1e-6f);
#pragma unroll
        for (int i = 0; i < 8; ++i) {
            const f32x4 o = v[i] * rs * g[i];
            if (FINAL) { *(f32x4*)(copy + (size_t)row * DM + i * 256 + lane * 4) = o; }
            else { u32x2 w; w.x = pk_bf(o[0], o[1]); w.y = pk_bf(o[2], o[3]); *(u32x2*)(dst + (size_t)row * DM + i * 256 + lane * 4) = w;
                   if (copy) *(f32x4*)(copy + (size_t)row * DM + i * 256 + lane * 4) = v[i]; }
        }
    }
}

struct RwP { const float *mu, *w0, *w2, *a0, *a2, *kk, *ka, *rk; };
__device__ __forceinline__ void prep_rw(const u16* __restrict__ Z1, const RwP P, h16* __restrict__ RWP, float* __restrict__ RWS, float* __restrict__ BON, u16* __restrict__ ZG, LAS float* L) {
    const int tid = otid(), lane = tid & 63; const int bidx = obid(), gdim = ogrid();
    constexpr int TT = 32, TH = 16;
    for (int tile = bidx; tile < MT / TT; tile += gdim) {
        const int m0 = tile * TT;
#pragma unroll
        for (int i = 0; i < 16; ++i) {
            const int idx = tid + 512 * i, tok = idx >> 8, cc = idx & 255, m = m0 + tok, c = 2304 + cc;
            const float zc = bf2f(Z1[(size_t)m * Z1_LD + c]);
            const float zp = ((m & (TS - 1)) == 0) ? 0.f : bf2f(Z1[(size_t)(m - 1) * Z1_LD + c]);
            const float zf = zc + P.mu[c] * (zp - zc);
            if (cc < 64) L[cc * TT + tok] = tanh_(zf);
            else if (cc < 128) L[cc * TT + tok] = zf;
            else ZG[(size_t)m * 128 + (cc - 128)] = f2bf(sigm(zf));
        }
        __syncthreads();
        const int jj = tid & 255, th = tid >> 8;
        for (int cgi = 0; cgi < 3; ++cgi) {
            const int j = jj + 256 * cgi;
            const int mA = m0 + th * TH;
            u16 lr[TH], lk[TH], lv[TH]; u16 l0r = 0, l0k = 0, l0v = 0;
            if ((mA & (TS - 1)) != 0) { const u16* zp = Z1 + (size_t)(mA - 1) * Z1_LD; l0r = zp[j]; l0k = zp[768 + j]; l0v = zp[1536 + j]; }
#pragma unroll
            for (int tk = 0; tk < TH; ++tk) { const u16* zc = Z1 + (size_t)(mA + tk) * Z1_LD; lr[tk] = zc[j]; lk[tk] = zc[768 + j]; lv[tk] = zc[1536 + j]; }
            float aw[TH], aa[TH];
            { const float w0v = P.w0[j], a0v = P.a0[j];
#pragma unroll
              for (int k = 0; k < TH; ++k) { aw[k] = w0v; aa[k] = a0v; } }
#pragma unroll 4
            for (int i = 0; i < 64; ++i) {
                const float w2v = P.w2[i * 768 + j], a2v = P.a2[i * 768 + j];
#pragma unroll
                for (int q = 0; q < 4; ++q) {
                    const f32x4 t = *(const LAS f32x4*)(L + i * TT + th * TH + 4 * q), y = *(const LAS f32x4*)(L + (64 + i) * TT + th * TH + 4 * q);
#pragma unroll
                    for (int k = 0; k < 4; ++k) { aw[4 * q + k] += t[k] * w2v; aa[4 * q + k] += y[k] * a2v; }
                }
            }
            const float mur = P.mu[j], muk = P.mu[768 + j], muv = P.mu[1536 + j];
            const float kkc = P.kk[j], kac = P.ka[j], rkc = P.rk[j];
            const int hh = j >> 6;
            float pr = bf2f(l0r), pk = bf2f(l0k), pv = bf2f(l0v);
            float w1 = 0.f, dl1 = 0.f, bb1 = 0.f, kp1 = 0.f, br1 = 0.f, kr1 = 0.f;
#pragma unroll
            for (int tk = 0; tk < TH; ++tk) {
                const int m = mA + tk, b = m >> 14, t = m & (TS - 1);
                const float cr = bf2f(lr[tk]), ck = bf2f(lk[tk]), cv = bf2f(lv[tk]);
                const float r = cr + mur * (pr - cr), k = ck + muk * (pk - ck), v = cv + muv * (pv - cv);
                pr = cr; pk = ck; pv = cv;
                const float e = 0.6065306597f * sigm(aw[tk]);
                const float dl = 1.0f - __expf(-e);
                const float w = 1.0f - dl;
                const float a = sigm(aa[tk]);
                const float kq = k * kkc;
                const float ss = wave_sum(kq * kq);
                const float kkn = kq * rsqrtf(ss + 1e-12f);
                const float kp = k * (1.0f + (a - 1.0f) * kac);
                const float bb = kkn * a;
                const float wr = w * r;
                const float br = wave_sum(bb * r), kr = wave_sum(kp * r), bonus = wave_sum(r * kp * rkc);
                const size_t rec = (size_t)(b * 12 + hh) * TS + t;
                h16* o = RWP + (rec >> 1) * 768 + lane;
                if (lane == 0) BON[rec] = bonus;
                if ((tk & 1) == 0) {
                    o[0] = (h16)kkn; o[64] = (h16)wr; o[9 * 64] = (h16)v;
                    w1 = w; dl1 = dl; bb1 = bb; kp1 = kp; br1 = br; kr1 = kr;
                } else {
                    o[2 * 64] = (h16)(w1 * kkn); o[3 * 64] = (h16)(w1 * wr); o[4 * 64] = (h16)(dl1 + dl - dl1 * dl);
                    o[5 * 64] = (h16)(bb1 * w); o[6 * 64] = (h16)(kp1 * w); o[7 * 64] = (h16)bb; o[8 * 64] = (h16)kp; o[10 * 64] = (h16)v;
                    const float bk12 = wave_sum(bb1 * kkn), kk12 = wave_sum(kp1 * kkn), bz = wave_sum(bb1 * wr), kz = wave_sum(kp1 * wr);
                    if (lane == 0) { f32x4 sA, sB; sA[0] = br1; sA[1] = kr1; sA[2] = bk12; sA[3] = kk12; sB[0] = br; sB[1] = kr; sB[2] = bz; sB[3] = kz;
                        *(f32x4*)(RWS + (rec >> 1) * 8) = sA; *(f32x4*)(RWS + (rec >> 1) * 8 + 4) = sB; }
                }
            }
        }
        __syncthreads();
    }
}

__device__ __forceinline__ void tr_small(const float* __restrict__ src, u16* __restrict__ dst, int K) {
    const int tid = otid(); const int bidx = obid(), gdim = ogrid();
    for (int idx = bidx * 512 + tid; idx < 768 * K; idx += gdim * 512) { const int col = idx / K, k = idx - col * K; dst[idx] = f2bf(src[k * 768 + col]); }
}
typedef short bf16x8_t __attribute__((ext_vector_type(8)));
__device__ __forceinline__ void prep_rw2(const u16* __restrict__ Z1, const RwP P, const u16* __restrict__ W2T, const u16* __restrict__ A2T,
                                         h16* __restrict__ RWP, float* __restrict__ RWS, float* __restrict__ BON, u16* __restrict__ ZG, LAS unsigned char* lds) {
    const int tid = otid(), lane = tid & 63, wid = tid >> 6, fr = lane & 15, fq = lane >> 4; const int bidx = obid(), gdim = ogrid();
    constexpr int TT = 32, LST = 272;
    for (int tile = bidx; tile < MT / TT; tile += gdim) {
        const int m0 = tile * TT;
#pragma unroll
        for (int i = 0; i < 16; ++i) {
            const int idx = tid + 512 * i, tok = idx >> 8, cc = idx & 255, m = m0 + tok, c = 2304 + cc;
            const float zc = bf2f(Z1[(size_t)m * Z1_LD + c]);
            const float zp = ((m & (TS - 1)) == 0) ? 0.f : bf2f(Z1[(size_t)(m - 1) * Z1_LD + c]);
            const float zf = zc + P.mu[c] * (zp - zc);
            if (cc < 128) *(LAS u16*)(lds + tok * LST + cc * 2) = f2bf(cc < 64 ? tanh_(zf) : zf);
            else ZG[(size_t)m * 128 + (cc - 128)] = f2bf(sigm(zf));
        }
        __syncthreads();
        for (int wt = wid; wt < 24; wt += 8) {
            const int hh = wt % 12, half = wt / 12;
            const int mB = m0 + half * 16, b = mB >> 14, tB = mB & (TS - 1);
            const int j0 = hh * 64 + 4 * fr;
            f32x4 accW[4], accA[4];
#pragma unroll
            for (int n = 0; n < 4; ++n) { accW[n] = (f32x4){0.f, 0.f, 0.f, 0.f}; accA[n] = (f32x4){0.f, 0.f, 0.f, 0.f}; }
#pragma unroll
            for (int ks = 0; ks < 2; ++ks) {
                const bf16x8_t aw_ = *(const LAS bf16x8_t*)(lds + (half * 16 + fr) * LST + (ks * 32 + fq * 8) * 2);
                const bf16x8_t aa_ = *(const LAS bf16x8_t*)(lds + (half * 16 + fr) * LST + (64 + ks * 32 + fq * 8) * 2);
#pragma unroll
                for (int n = 0; n < 4; ++n) {
                    const bf16x8_t bw = *(const bf16x8_t*)(W2T + (size_t)(j0 + n) * 64 + ks * 32 + fq * 8);
                    const bf16x8_t ba = *(const bf16x8_t*)(A2T + (size_t)(j0 + n) * 64 + ks * 32 + fq * 8);
                    accW[n] = __builtin_amdgcn_mfma_f32_16x16x32_bf16(aw_, bw, accW[n], 0, 0, 0);
                    accA[n] = __builtin_amdgcn_mfma_f32_16x16x32_bf16(aa_, ba, accA[n], 0, 0, 0);
                }
            }
            const f32x4 w0v = *(const f32x4*)(P.w0 + j0), a0v = *(const f32x4*)(P.a0 + j0), mur = *(const f32x4*)(P.mu + j0), muk = *(const f32x4*)(P.mu + 768 + j0), muv = *(const f32x4*)(P.mu + 1536 + j0);
            const f32x4 kkc = *(const f32x4*)(P.kk + j0), kac = *(const f32x4*)(P.ka + j0), rkc = *(const f32x4*)(P.rk + j0);
            u32x2 zr[5], zk[5], zv[5];
#pragma unroll
            for (int q = 0; q < 5; ++q) {
                const int m = mB + 4 * fq + q - 1;
                if (q == 0 && ((m + 1) & (TS - 1)) == 0) { zr[0] = (u32x2){0u, 0u}; zk[0] = zr[0]; zv[0] = zr[0]; }
                else { const u16* zc = Z1 + (size_t)m * Z1_LD + j0; zr[q] = *(const u32x2*)zc; zk[q] = *(const u32x2*)(zc + 768); zv[q] = *(const u32x2*)(zc + 1536); }
            }
            f32x4 w1, dl1, bb1, kp1; float br1 = 0.f, kr1 = 0.f;
#pragma unroll
            for (int r = 0; r < 4; ++r) {
                const int t = tB + 4 * fq + r;
                const size_t rec = (size_t)(b * 12 + hh) * TS + t;
                f32x4 pr, pk, pv, cr, ck, cv;
                pr[0] = bflo(zr[r].x); pr[1] = bfhi(zr[r].x); pr[2] = bflo(zr[r].y); pr[3] = bfhi(zr[r].y);
                pk[0] = bflo(zk[r].x); pk[1] = bfhi(zk[r].x); pk[2] = bflo(zk[r].y); pk[3] = bfhi(zk[r].y);
                pv[0] = bflo(zv[r].x); pv[1] = bfhi(zv[r].x); pv[2] = bflo(zv[r].y); pv[3] = bfhi(zv[r].y);
                cr[0] = bflo(zr[r + 1].x); cr[1] = bfhi(zr[r + 1].x); cr[2] = bflo(zr[r + 1].y); cr[3] = bfhi(zr[r + 1].y);
                ck[0] = bflo(zk[r + 1].x); ck[1] = bfhi(zk[r + 1].x); ck[2] = bflo(zk[r + 1].y); ck[3] = bfhi(zk[r + 1].y);
                cv[0] = bflo(zv[r + 1].x); cv[1] = bfhi(zv[r + 1].x); cv[2] = bflo(zv[r + 1].y); cv[3] = bfhi(zv[r + 1].y);
                const f32x4 rr = cr + mur * (pr - cr), k = ck + muk * (pk - ck), v = cv + muv * (pv - cv);
                f32x4 w, dl, a, kq, kp;
                float ss = 0.f;
#pragma unroll
                for (int n = 0; n < 4; ++n) {
                    const float e = 0.6065306597f * sigm(accW[n][r] + w0v[n]);
                    w[n] = __expf(-e); dl[n] = 1.0f - w[n];
                    a[n] = sigm(accA[n][r] + a0v[n]);
                    kq[n] = k[n] * kkc[n]; ss += kq[n] * kq[n];
                    kp[n] = k[n] * (1.0f + (a[n] - 1.0f) * kac[n]);
                }
                ss = red16(ss);
                const float rn = rsqrtf(ss + 1e-12f);
                const f32x4 kkn = kq * rn, bb = kkn * a, wr = w * rr;
                float br = 0.f, kr = 0.f, bonus = 0.f;
#pragma unroll
                for (int n = 0; n < 4; ++n) { br += bb[n] * rr[n]; kr += kp[n] * rr[n]; bonus += rr[n] * kp[n] * rkc[n]; }
                br = red16(br); kr = red16(kr); bonus = red16(bonus);
                h16* o = RWP + (rec >> 1) * 768 + 4 * fr;
                if (fr == 0) BON[rec] = bonus;
#define ST4(slot, vec) do { h16x4 hv_; hv_[0] = (h16)(vec)[0]; hv_[1] = (h16)(vec)[1]; hv_[2] = (h16)(vec)[2]; hv_[3] = (h16)(vec)[3]; *(h16x4*)(o + (slot) * 64) = hv_; } while (0)
                if ((r & 1) == 0) {
                    ST4(0, kkn); ST4(1, wr); ST4(9, v);
                    w1 = w; dl1 = dl; bb1 = bb; kp1 = kp; br1 = br; kr1 = kr;
                } else {
                    const f32x4 x2 = w1 * kkn, z2 = w1 * wr, d12 = dl1 + dl - dl1 * dl, B1 = bb1 * w, K1 = kp1 * w;
                    ST4(2, x2); ST4(3, z2); ST4(4, d12); ST4(5, B1); ST4(6, K1); ST4(7, bb); ST4(8, kp); ST4(10, v);
                    float bk12 = 0.f, kk12 = 0.f, bz = 0.f, kz = 0.f;
#pragma unroll
                    for (int n = 0; n < 4; ++n) { bk12 += bb1[n] * kkn[n]; kk12 += kp1[n] * kkn[n]; bz += bb1[n] * wr[n]; kz += kp1[n] * wr[n]; }
                    bk12 = red16(bk12); kk12 = red16(kk12); bz = red16(bz); kz = red16(kz);
                    if (fr == 0) { f32x4 sA, sB; sA[0] = br1; sA[1] = kr1; sA[2] = bk12; sA[3] = kk12; sB[0] = br; sB[1] = kr; sB[2] = bz; sB[3] = kz;
                        *(f32x4*)(RWS + (rec >> 1) * 8) = sA; *(f32x4*)(RWS + (rec >> 1) * 8 + 4) = sB; }
                }
#undef ST4
            }
        }
        __syncthreads();
    }
}

__device__ __forceinline__ void prep_gd(const u16* __restrict__ Z2, const float* __restrict__ cw, const float* __restrict__ alog, const float* __restrict__ dtb,
                                        h16* __restrict__ GDP, float* __restrict__ GDS) {
    const int tid_ = otid(); const int lane = tid_ & 63, wid = tid_ >> 6; const int bidx = obid(), gdim = ogrid();
    for (int task = bidx * 8 + wid; task < 6 * (MT / 32); task += gdim * 8) {
        const int hh = task % 6, chunk = task / 6, m0 = chunk * 32, b = m0 >> 14, t0 = m0 & (TS - 1);
        const int cq = hh * 128 + 2 * lane;
        float w[3][4][2];
#pragma unroll
        for (int a = 0; a < 3; ++a)
#pragma unroll
            for (int i = 0; i < 4; ++i) { const f32x2 q = *(const f32x2*)(cw + i * 2304 + a * 768 + cq); w[a][i][0] = q[0]; w[a][i][1] = q[1]; }
        float x[3][3][2];
#pragma unroll
        for (int a = 0; a < 3; ++a)
#pragma unroll
            for (int d = 0; d < 3; ++d) {
                unsigned wv = 0u;
                if (t0 != 0) wv = *(const unsigned*)(Z2 + (size_t)(m0 - 3 + d) * Z2_LD + a * 768 + cq);
                x[a][d][0] = bflo(wv); x[a][d][1] = bfhi(wv);
            }
        const float An = -__expf(alog[hh]), dtbv = dtb[hh];
        float kprev0 = 0.f, kprev1 = 0.f, al1 = 0.f, be1 = 0.f, qk1 = 0.f;
        for (int s8 = 0; s8 < 32; s8 += 8) {
          unsigned ld[8][3]; u16 ldb[8], lda[8];
#pragma unroll
          for (int k = 0; k < 8; ++k) { const u16* zr = Z2 + (size_t)(m0 + s8 + k) * Z2_LD;
#pragma unroll
              for (int a = 0; a < 3; ++a) ld[k][a] = *(const unsigned*)(zr + a * 768 + cq);
              ldb[k] = zr[Z2_ZB + hh]; lda[k] = zr[Z2_ZA + hh]; }
#pragma unroll
          for (int k = 0; k < 8; ++k) {
            const int s = s8 + k;
            float y[3][2];
#pragma unroll
            for (int a = 0; a < 3; ++a) {
                const unsigned wv = ld[k][a];
                const float c0 = bflo(wv), c1 = bfhi(wv);
                const float s0 = x[a][0][0] * w[a][0][0] + x[a][1][0] * w[a][1][0] + x[a][2][0] * w[a][2][0] + c0 * w[a][3][0];
                const float s1 = x[a][0][1] * w[a][0][1] + x[a][1][1] * w[a][1][1] + x[a][2][1] * w[a][2][1] + c1 * w[a][3][1];
                x[a][0][0] = x[a][1][0]; x[a][1][0] = x[a][2][0]; x[a][2][0] = c0;
                x[a][0][1] = x[a][1][1]; x[a][1][1] = x[a][2][1]; x[a][2][1] = c1;
                y[a][0] = s0 * sigm(s0); y[a][1] = s1 * sigm(s1);
            }
            const float sq = wave_sum(y[0][0] * y[0][0] + y[0][1] * y[0][1]);
            const float sk = wave_sum(y[1][0] * y[1][0] + y[1][1] * y[1][1]);
            const float rq = rsqrtf(sq + 1e-12f) * 0.08838834764831845f, rk = rsqrtf(sk + 1e-12f);
            const float q0 = y[0][0] * rq, q1 = y[0][1] * rq, k0 = y[1][0] * rk, k1 = y[1][1] * rk;
            const float qk = wave_sum(q0 * k0 + q1 * k1);
            const size_t rec = (size_t)(b * 6 + hh) * TS + (t0 + s);
            h16* o = GDP + rec * 384 + 2 * lane;
            h16x2 kv; kv[0] = (h16)k0; kv[1] = (h16)k1; *(h16x2*)(o) = kv;
            h16x2 qv; qv[0] = (h16)q0; qv[1] = (h16)q1; *(h16x2*)(o + 128) = qv;
            h16x2 vv; vv[0] = (h16)y[2][0]; vv[1] = (h16)y[2][1]; *(h16x2*)(o + 256) = vv;
            const float beta = sigm(bf2f(ldb[k]));
            const float alpha = __expf(An * softplus_(bf2f(lda[k]) + dtbv));
            if ((k & 1) == 0) { kprev0 = k0; kprev1 = k1; al1 = alpha; be1 = beta; qk1 = qk; }
            else {
                const float k12 = wave_sum(kprev0 * k0 + kprev1 * k1), kq12 = wave_sum(kprev0 * q0 + kprev1 * q1);
                if (lane == 0) { f32x4 sA, sB; sA[0] = al1; sA[1] = be1; sA[2] = qk1; sA[3] = k12; sB[0] = alpha; sB[1] = beta; sB[2] = qk; sB[3] = kq12;
                    *(f32x4*)(GDS + (rec - 1) * 4) = sA; *(f32x4*)(GDS + rec * 4) = sB; }
            }
          }
        }
    }
}

struct LrP { const float *cw, *cb, *wa, *ba, *wx, *bx, *lam; };
__device__ __forceinline__ void tr_blocks(const float* __restrict__ src, u16* __restrict__ dst) {
    const int tid = otid(); const int bidx = obid(), gdim = ogrid();
    for (int idx = bidx * 512 + tid; idx < 8 * 64 * 64; idx += gdim * 512) { const int n = idx >> 12, d = (idx >> 6) & 63, c = idx & 63; dst[idx] = f2bf(src[(n * 64 + c) * 64 + d]); }
}
__device__ __forceinline__ void prep_lr2(const u16* __restrict__ Z2, const LrP P, const u16* __restrict__ WAT, const u16* __restrict__ WXT, u16* __restrict__ LRA, u16* __restrict__ LRUb, LAS unsigned char* lds, int bsub = 0, int gsub = 0) {
    const int tid_ = otid(); const int lane = tid_ & 63, wid = tid_ >> 6, fr = lane & 15, fq = lane >> 4; const int bidx = gsub ? bsub : obid(), gdim = gsub ? gsub : ogrid();
    LAS unsigned char* Lx = lds + wid * 10240;
    LAS float* La = (LAS float*)(Lx + 2048);
    LAS float* Lb = La + 1024;
    for (int task = bidx * 8 + wid; task < 8 * (MT / 64); task += gdim * 8) {
        const int n = task & 7, chunk = task >> 3, m0 = chunk * 64, t0 = m0 & (TS - 1);
        const int ch = n * 64 + lane;
        bf16x8_t bwa[4][2], bwx[4][2];
#pragma unroll
        for (int nt = 0; nt < 4; ++nt)
#pragma unroll
            for (int ks = 0; ks < 2; ++ks) { const size_t o = (size_t)(n * 64 + nt * 16 + fr) * 64 + ks * 32 + fq * 8; bwa[nt][ks] = *(const bf16x8_t*)(WAT + o); bwx[nt][ks] = *(const bf16x8_t*)(WXT + o); }
        const float c0 = P.cw[ch], c1 = P.cw[512 + ch], c2 = P.cw[1024 + ch], c3 = P.cw[1536 + ch], cb = P.cb[ch];
        const float ba = P.ba[ch], bx = P.bx[ch];
        const float spl = -8.0f * softplus_(-P.lam[ch]);
        float x0 = 0.f, x1 = 0.f, x2 = 0.f, hl = 0.f, pc = 1.f;
        if (t0 != 0) { x0 = bf2f(Z2[(size_t)(m0 - 3) * Z2_LD + Z2_XL + ch]); x1 = bf2f(Z2[(size_t)(m0 - 2) * Z2_LD + Z2_XL + ch]); x2 = bf2f(Z2[(size_t)(m0 - 1) * Z2_LD + Z2_XL + ch]); }
        for (int s16 = 0; s16 < 64; s16 += 16) {
            u16 ldx[16];
#pragma unroll
            for (int k = 0; k < 16; ++k) ldx[k] = Z2[(size_t)(m0 + s16 + k) * Z2_LD + Z2_XL + ch];
            float xc[16];
#pragma unroll
            for (int k = 0; k < 16; ++k) {
                const float xin = bf2f(ldx[k]);
                xc[k] = x0 * c0 + x1 * c1 + x2 * c2 + xin * c3 + cb;
                x0 = x1; x1 = x2; x2 = xin;
                *(LAS u16*)(Lx + (k * 64 + lane) * 2) = f2bf(xc[k]);
            }
            f32x4 aA[4], aX[4];
#pragma unroll
            for (int nt = 0; nt < 4; ++nt) { aA[nt] = (f32x4){0.f, 0.f, 0.f, 0.f}; aX[nt] = (f32x4){0.f, 0.f, 0.f, 0.f}; }
#pragma unroll
            for (int ks = 0; ks < 2; ++ks) {
                const bf16x8_t af = *(const LAS bf16x8_t*)(Lx + (fr * 64 + ks * 32 + fq * 8) * 2);
#pragma unroll
                for (int nt = 0; nt < 4; ++nt) { aA[nt] = __builtin_amdgcn_mfma_f32_16x16x32_bf16(af, bwa[nt][ks], aA[nt], 0, 0, 0); aX[nt] = __builtin_amdgcn_mfma_f32_16x16x32_bf16(af, bwx[nt][ks], aX[nt], 0, 0, 0); }
            }
#pragma unroll
            for (int nt = 0; nt < 4; ++nt)
#pragma unroll
                for (int r = 0; r < 4; ++r) { La[(4 * fq + r) * 64 + nt * 16 + fr] = aA[nt][r]; Lb[(4 * fq + r) * 64 + nt * 16 + fr] = aX[nt][r]; }
#pragma unroll
            for (int k = 0; k < 16; ++k) {
                const int m = m0 + s16 + k;
                const float r = sigm(La[k * 64 + lane] + ba), ig = sigm(Lb[k * 64 + lane] + bx);
                const float la = spl * r;
                const float a = __expf(la);
                const float u = __builtin_amdgcn_sqrtf(1.0f - __expf(2.0f * la)) * (ig * xc[k]);
                hl = a * hl + u; pc *= a;
                LRA[(size_t)m * 512 + ch] = f2bf(pc); LRUb[(size_t)m * 512 + ch] = f2bf(hl);
            }
        }
    }
}

constexpr int RC = 32;
constexpr int RPB = 3072;
constexpr int RBUF = (RC / 2) * RPB + (RC / 2) * 32;
__device__ __forceinline__ f32x2 lo2(f32x4 v) { f32x2 r; r[0] = v[0]; r[1] = v[1]; return r; }
__device__ __forceinline__ f32x2 hi2(f32x4 v) { f32x2 r; r[0] = v[2]; r[1] = v[3]; return r; }
__device__ __forceinline__ float dot4(f32x2 sa, f32x2 sb, f32x4 v) { f32x2 t = sa * lo2(v); t = sb * hi2(v) + t; return t[0] + t[1]; }
__device__ __forceinline__ float dot8(const f32x2 (&S)[4], f32x4 va, f32x4 vb) { f32x2 t = S[0] * lo2(va); t = S[1] * hi2(va) + t; t = S[2] * lo2(vb) + t; t = S[3] * hi2(vb) + t; return t[0] + t[1]; }
template <int KIND> __device__ __forceinline__ void rec_block(const unsigned char* __restrict__ gp, const unsigned char* __restrict__ gs, u16* __restrict__ outp  ,
                                                             int rowl0  , LAS unsigned char* lds) {
    const int tid = otid(), lane = tid & 63, wid = tid >> 6, g = lane >> 4, j = lane & 15;
    const int cw = wid & 3; const bool is_ld = wid >= 4;
    const int rowl = rowl0 + cw * 4 + g;
    const int lt = cw * 64 + lane;
    constexpr int NCH = TS / RC;
    constexpr int CB = (RC / 2) * 1536;
    u32x2 st[12]; u32x4 ss0, ss1;
#define LD_ISSUE(c) do { const unsigned char* np = gp + (size_t)(c) * CB; const unsigned char* ns = gs + (size_t)(c) * (RC * 16); \
        _Pragma("unroll") for (int i = 0; i < 12; ++i) st[i] = *(const u32x2*)(np + (size_t)(lt + 256 * i) * 8); \
        if (lt < 32) ss0 = *(const u32x4*)(ns + lt * 16); } while (0)
#define LD_COMMIT(buf) do { LAS unsigned char* Bn = lds + 4096 + (buf) * RBUF; \
        _Pragma("unroll") for (int i = 0; i < 12; ++i) { const int q = lt + 256 * i, slot = (q % 192) >> 4; \
            const u32x2 w = st[i]; f32x4 a; \
            { const unsigned w0 = w[0], w1 = w[1]; const h16x2 h0 = __builtin_bit_cast(h16x2, w0), h1 = __builtin_bit_cast(h16x2, w1); \
              a[0] = (float)h0[0]; a[1] = (float)h0[1]; a[2] = (float)h1[0]; a[3] = (float)h1[1]; } \
            if (KIND == 0 && slot == 4) a = 1.0f - a; \
            *(LAS f32x4*)(Bn + q * 16) = a; } \
        if (lt < 32) *(LAS u32x4*)(Bn + (RC / 2) * RPB + lt * 16) = ss0; } while (0)
#define Y_OUT(c) do { const LAS float* yb = (const LAS float*)(lds + ((c) & 1) * 2048); const int stp = lt >> 3, rp = (lt & 7) * 2; \
        const f32x2 yv = *(const LAS f32x2*)(yb + stp * 16 + rp); *(unsigned*)(outp + ((size_t)(c) * RC + stp) * DM + rp) = pk_bf(yv[0], yv[1]); } while (0)
    if (is_ld) { LD_ISSUE(0); LD_COMMIT(0); LD_ISSUE(1); }
    __syncthreads();
    f32x2 Sv[4];
#pragma unroll
    for (int i = 0; i < 4; ++i) { Sv[i][0] = 0.f; Sv[i][1] = 0.f; }
    for (int c = 0; c < NCH; ++c) {
        if (is_ld) {
            if (c + 1 < NCH) { LD_COMMIT((c + 1) & 1); if (c + 2 < NCH) LD_ISSUE(c + 2); }
            if (c > 0) Y_OUT(c - 1);
        } else {
            const LAS unsigned char* B = lds + 4096 + (c & 1) * RBUF;
            const LAS unsigned char* Sc = B + (RC / 2) * RPB;
            LAS float* yw = (LAS float*)(lds + (c & 1) * 2048) + (cw * 4 + g);
            if (KIND == 0) {
                f32x4 n_kk, n_wr, n_x2, n_z2, n_W, n_B1, n_K1, n_b2, n_kp2, n_sA, n_sB; float n_v1, n_v2;
#define RW_LD(p) do { const LAS unsigned char* Pp = B + (p) * RPB + j * 16; \
                    n_kk = *(const LAS f32x4*)(Pp); n_wr = *(const LAS f32x4*)(Pp + 256); n_x2 = *(const LAS f32x4*)(Pp + 512); n_z2 = *(const LAS f32x4*)(Pp + 768); \
                    n_W = *(const LAS f32x4*)(Pp + 1024); n_B1 = *(const LAS f32x4*)(Pp + 1280); n_K1 = *(const LAS f32x4*)(Pp + 1536); n_b2 = *(const LAS f32x4*)(Pp + 1792); n_kp2 = *(const LAS f32x4*)(Pp + 2048); \
                    n_v1 = *(const LAS float*)(B + (p) * RPB + 2304 + rowl * 4); n_v2 = *(const LAS float*)(B + (p) * RPB + 2560 + rowl * 4); \
                    n_sA = *(const LAS f32x4*)(Sc + (p) * 32); n_sB = *(const LAS f32x4*)(Sc + (p) * 32 + 16); } while (0)
                RW_LD(0);
#pragma unroll 16
                for (int p = 0; p < RC / 2; ++p) {
                    const f32x4 kk = n_kk, wr = n_wr, x2 = n_x2, z2 = n_z2, W = n_W, B1 = n_B1, K1 = n_K1, b2 = n_b2, kp2 = n_kp2, sA = n_sA, sB = n_sB; const float v1 = n_v1, v2 = n_v2;
                    { const int pn = (p + 1 < RC / 2) ? p + 1 : p; RW_LD(pn); }
                    float d0 = dot4(Sv[0], Sv[1], kk), d1 = dot4(Sv[0], Sv[1], wr), d2 = dot4(Sv[0], Sv[1], x2), d3 = dot4(Sv[0], Sv[1], z2);
                    d0 = red16(d0); d1 = red16(d1); d2 = red16(d2); d3 = red16(d3);
                    const float sa1 = d0;
                    const float y1 = d1 - sa1 * sA[0] + v1 * sA[1];
                    const float sa2 = d2 - sa1 * sA[2] + v1 * sA[3];
                    const float y2 = (d3 - sa1 * sB[2] + v1 * sB[3]) - sa2 * sB[0] + v2 * sB[1];
                    yw[(2 * p) * 16] = y1; yw[(2 * p + 1) * 16] = y2;
                    const float n1 = -sa1, n2 = -sa2;
                    Sv[0] = lo2(b2) * n2 + (lo2(kp2) * v2 + (lo2(B1) * n1 + (lo2(K1) * v1 + Sv[0] * lo2(W))));
                    Sv[1] = hi2(b2) * n2 + (hi2(kp2) * v2 + (hi2(B1) * n1 + (hi2(K1) * v1 + Sv[1] * hi2(W))));
                }
            } else {
                f32x4 n_k1a, n_k1b, n_q1a, n_q1b, n_k2a, n_k2b, n_q2a, n_q2b, n_sA, n_sB; float n_v1, n_v2;
#define GD_LD(p) do { const LAS unsigned char* Pp = B + (p) * RPB + j * 16;     \
                    n_k1a = *(const LAS f32x4*)(Pp); n_k1b = *(const LAS f32x4*)(Pp + 256); n_q1a = *(const LAS f32x4*)(Pp + 512); n_q1b = *(const LAS f32x4*)(Pp + 768); \
                    n_k2a = *(const LAS f32x4*)(Pp + 1536); n_k2b = *(const LAS f32x4*)(Pp + 1792); n_q2a = *(const LAS f32x4*)(Pp + 2048); n_q2b = *(const LAS f32x4*)(Pp + 2304); \
                    n_v1 = *(const LAS float*)(B + (p) * RPB + 1024 + rowl * 4); n_v2 = *(const LAS float*)(B + (p) * RPB + 2560 + rowl * 4); \
                    n_sA = *(const LAS f32x4*)(Sc + (p) * 32); n_sB = *(const LAS f32x4*)(Sc + (p) * 32 + 16); } while (0)
                GD_LD(0);
#pragma unroll 16
                for (int p = 0; p < RC / 2; ++p) {
                    const f32x4 k1a = n_k1a, k1b = n_k1b, q1a = n_q1a, q1b = n_q1b, k2a = n_k2a, k2b = n_k2b, q2a = n_q2a, q2b = n_q2b, sA = n_sA, sB = n_sB; const float v1 = n_v1, v2 = n_v2;
                    { const int pn = (p + 1 < RC / 2) ? p + 1 : p; GD_LD(pn); }
                    float a1 = dot8(Sv, k1a, k1b), c1 = dot8(Sv, q1a, q1b), a2 = dot8(Sv, k2a, k2b), c2 = dot8(Sv, q2a, q2b);
                    a1 = red16(a1); c1 = red16(c1); a2 = red16(a2); c2 = red16(c2);
                    const float al1 = sA[0], al2 = sB[0];
                    const float vn1 = sA[1] * (v1 - al1 * a1);
                    const float o1 = al1 * c1 + sA[2] * vn1;
                    const float vn2 = sB[1] * (v2 - al2 * (al1 * a2 + sA[3] * vn1));
                    const float o2 = al2 * (al1 * c2 + sB[3] * vn1) + sB[2] * vn2;
                    yw[(2 * p) * 16] = o1; yw[(2 * p + 1) * 16] = o2;
                    const float cS = al1 * al2, w1 = al2 * vn1;
                    Sv[0] = lo2(k2a) * vn2 + (lo2(k1a) * w1 + Sv[0] * cS);
                    Sv[1] = hi2(k2a) * vn2 + (hi2(k1a) * w1 + Sv[1] * cS);
                    Sv[2] = lo2(k2b) * vn2 + (lo2(k1b) * w1 + Sv[2] * cS);
                    Sv[3] = hi2(k2b) * vn2 + (hi2(k1b) * w1 + Sv[3] * cS);
                }
            }
        }
        __syncthreads();
    }
    if (is_ld) Y_OUT(NCH - 1);
#undef LD_ISSUE
#undef LD_COMMIT
#undef Y_OUT
}
__device__ __forceinline__ void lru_carry(int grp  , const u16* __restrict__ LRA, const u16* __restrict__ LRUb, float* __restrict__ HIN) {
    const int lane = otid() & 63;
    const int b = grp >> 3, ch = (grp & 7) * 64 + lane;
    float h = 0.f;
    for (int c = 0; c < TS / 64; c += 8) {
        float a[8], u[8];
#pragma unroll
        for (int k = 0; k < 8; ++k) { const size_t m = (size_t)b * TS + (c + k) * 64 + 63; a[k] = bf2f(LRA[m * 512 + ch]); u[k] = bf2f(LRUb[m * 512 + ch]); }
#pragma unroll
        for (int k = 0; k < 8; ++k) { HIN[((size_t)b * 256 + c + k) * 512 + ch] = h; h = a[k] * h + u[k]; }
    }
}
__device__ __forceinline__ void post_lr(u16* __restrict__ MIX, const u16* __restrict__ Z2, const u16* __restrict__ LRA, const u16* __restrict__ LRUb, const float* __restrict__ HIN, int bsub = 0, int gsub = 0) {
    const int tid = otid(); const int bidx = gsub ? bsub : obid(), gdim = gsub ? gsub : ogrid();
    for (int it = bidx * 512 + tid; it < MT * 128; it += gdim * 512) {
        const int m = it >> 7, c4 = (it & 127) * 4, b = m >> 14, chunk = (m & (TS - 1)) >> 6;
        const u32x2 pw = *(const u32x2*)(LRA + (size_t)m * 512 + c4), hw = *(const u32x2*)(LRUb + (size_t)m * 512 + c4); const f32x4 hin = *(const f32x4*)(HIN + ((size_t)b * 256 + chunk) * 512 + c4);
        f32x4 pc, hl; pc[0] = bflo(pw.x); pc[1] = bfhi(pw.x); pc[2] = bflo(pw.y); pc[3] = bfhi(pw.y); hl[0] = bflo(hw.x); hl[1] = bfhi(hw.x); hl[2] = bflo(hw.y); hl[3] = bfhi(hw.y);
        const u32x2 yw = *(const u32x2*)(Z2 + (size_t)m * Z2_LD + Z2_YL + c4);
        const f32x4 h = hl + pc * hin;
        u32x2 o; o.x = pk_bf(h[0] * gelu_tanh(bflo(yw.x)), h[1] * gelu_tanh(bfhi(yw.x))); o.y = pk_bf(h[2] * gelu_tanh(bflo(yw.y)), h[3] * gelu_tanh(bfhi(yw.y)));
        *(u32x2*)(MIX + (size_t)m * DM + 1536 + c4) = o;
    }
}

__device__ __forceinline__ void post_rw(u16* __restrict__ MIX, const h16* __restrict__ RWP, const float* __restrict__ BON, const u16* __restrict__ ZG,
                                        const float* __restrict__ g2, const float* __restrict__ lng, const float* __restrict__ lnb) {
    const int tid_ = otid(); const int lane = tid_ & 63, wid = tid_ >> 6; const int bidx = obid(), gdim = ogrid();
    for (int task = bidx * 8 + wid; task < 12 * (MT / 64); task += gdim * 8) {
        const int hh = task % 12, chunk = task / 12, m0 = chunk * 64, b = m0 >> 14, t0 = m0 & (TS - 1);
        const int col = hh * 64 + lane;
        float gc[128];
#pragma unroll
        for (int i = 0; i < 128; ++i) gc[i] = g2[i * 768 + col];
        const float lg = lng[col], lb = lnb[col];
        for (int s4 = 0; s4 < 64; s4 += 4) {
          u16 ly[4]; h16 lv[4]; float lbon[4]; unsigned lsw[4];
#pragma unroll
          for (int k = 0; k < 4; ++k) { const int m = m0 + s4 + k; const size_t rec = (size_t)(b * 12 + hh) * TS + (t0 + s4 + k);
              ly[k] = MIX[(size_t)m * DM + col]; lv[k] = RWP[(rec >> 1) * 768 + (9 + (int)(rec & 1)) * 64 + lane]; lbon[k] = BON[rec]; lsw[k] = *(const unsigned*)(ZG + (size_t)m * 128 + 2 * lane); }
#pragma unroll
          for (int k = 0; k < 4; ++k) {
            const int m = m0 + s4 + k;
            const float y = bf2f(ly[k]);
            const float mean = wave_sum(y) * (1.0f / 64.0f);
            const float d = y - mean;
            const float var = wave_sum(d * d) * (1.0f / 64.0f);
            const float yn = d * rsqrtf(var + 64e-5f) * lg + lb;
            const float v = (float)lv[k];
            const float bonus = lbon[k];
            const unsigned sw = lsw[k];
            const float s0 = bflo(sw), s1 = bfhi(sw);
            float ga = 0.f, gb = 0.f;
#pragma unroll
            for (int i = 0; i < 64; ++i) { ga += rlane(s0, i) * gc[2 * i]; gb += rlane(s1, i) * gc[2 * i + 1]; }
            MIX[(size_t)m * DM + col] = f2bf((yn + bonus * v) * (ga + gb));
          }
        }
    }
}
__device__ __forceinline__ void post_rw2(u16* __restrict__ MIX, const h16* __restrict__ RWP, const float* __restrict__ BON, const u16* __restrict__ ZG,
                                         const u16* __restrict__ G2T, const float* __restrict__ lng, const float* __restrict__ lnb) {
    const int tid_ = otid(); const int lane = tid_ & 63, wid = tid_ >> 6, fr = lane & 15, fq = lane >> 4; const int bidx = obid(), gdim = ogrid();
    for (int task = bidx * 8 + wid; task < 12 * (MT / 16); task += gdim * 8) {
        const int hh = task % 12, chunk = task / 12, mB = chunk * 16, b = mB >> 14, tB = mB & (TS - 1);
        const int j0 = hh * 64 + 4 * fr;
        u32x2 yw[4]; h16x4 vv[4]; float bon[4];
#pragma unroll
        for (int r = 0; r < 4; ++r) { const int m = mB + 4 * fq + r; const size_t rec = (size_t)(b * 12 + hh) * TS + (tB + 4 * fq + r);
            yw[r] = *(const u32x2*)(MIX + (size_t)m * DM + j0); vv[r] = *(const h16x4*)(RWP + (rec >> 1) * 768 + (9 + (int)(rec & 1)) * 64 + 4 * fr); bon[r] = BON[rec]; }
        const f32x4 lg = *(const f32x4*)(lng + j0), lb = *(const f32x4*)(lnb + j0);
        f32x4 acc[4];
#pragma unroll
        for (int n = 0; n < 4; ++n) acc[n] = (f32x4){0.f, 0.f, 0.f, 0.f};
#pragma unroll
        for (int ks = 0; ks < 4; ++ks) {
            const bf16x8_t a_ = *(const bf16x8_t*)(ZG + (size_t)(mB + fr) * 128 + ks * 32 + fq * 8);
#pragma unroll
            for (int n = 0; n < 4; ++n) { const bf16x8_t b_ = *(const bf16x8_t*)(G2T + (size_t)(j0 + n) * 128 + ks * 32 + fq * 8);
                acc[n] = __builtin_amdgcn_mfma_f32_16x16x32_bf16(a_, b_, acc[n], 0, 0, 0); }
        }
#pragma unroll
        for (int r = 0; r < 4; ++r) {
            const int m = mB + 4 * fq + r;
            f32x4 y; y[0] = bflo(yw[r].x); y[1] = bfhi(yw[r].x); y[2] = bflo(yw[r].y); y[3] = bfhi(yw[r].y);
            const float mean = red16((y[0] + y[1]) + (y[2] + y[3])) * (1.0f / 64.0f);
            const f32x4 d = y - mean;
            const float var = red16((d[0] * d[0] + d[1] * d[1]) + (d[2] * d[2] + d[3] * d[3])) * (1.0f / 64.0f);
            const float rs = rsqrtf(var + 64e-5f);
            f32x4 o;
#pragma unroll
            for (int n = 0; n < 4; ++n) o[n] = (d[n] * rs * lg[n] + lb[n] + bon[r] * (float)vv[r][n]) * acc[n][r];
            u32x2 w; w.x = pk_bf(o[0], o[1]); w.y = pk_bf(o[2], o[3]);
            *(u32x2*)(MIX + (size_t)m * DM + j0) = w;
        }
    }
}
__device__ __forceinline__ void post_rw_head(u16* __restrict__ MIX, const h16* __restrict__ RWP, const float* __restrict__ BON, const u16* __restrict__ ZG,
                                             const u16* __restrict__ G2T, const float* __restrict__ lng, const float* __restrict__ lnb, int b, int hh, int chunk0, int nchunk) {
    const int tid_ = otid(); const int lane = tid_ & 63, wid = tid_ >> 6, fr = lane & 15, fq = lane >> 4;
    const int j0 = hh * 64 + 4 * fr;
    bf16x8_t bg[4][4];
#pragma unroll
    for (int ks = 0; ks < 4; ++ks)
#pragma unroll
        for (int n = 0; n < 4; ++n) bg[ks][n] = *(const bf16x8_t*)(G2T + (size_t)(j0 + n) * 128 + ks * 32 + fq * 8);
    const f32x4 lg = *(const f32x4*)(lng + j0), lb = *(const f32x4*)(lnb + j0);
    for (int ci = wid; ci < nchunk; ci += 8) {
        const int tB = (chunk0 + ci) * 16, mB = b * TS + tB;
        u32x2 yw[4]; h16x4 vv[4]; float bon[4];
#pragma unroll
        for (int r = 0; r < 4; ++r) { const int m = mB + 4 * fq + r; const size_t rec = (size_t)(b * 12 + hh) * TS + (tB + 4 * fq + r);
            yw[r] = *(const u32x2*)(MIX + (size_t)m * DM + j0); vv[r] = *(const h16x4*)(RWP + (rec >> 1) * 768 + (9 + (int)(rec & 1)) * 64 + 4 * fr); bon[r] = BON[rec]; }
        f32x4 acc[4];
#pragma unroll
        for (int n = 0; n < 4; ++n) acc[n] = (f32x4){0.f, 0.f, 0.f, 0.f};
#pragma unroll
        for (int ks = 0; ks < 4; ++ks) {
            const bf16x8_t a_ = *(const bf16x8_t*)(ZG + (size_t)(mB + fr) * 128 + ks * 32 + fq * 8);
#pragma unroll
            for (int n = 0; n < 4; ++n) acc[n] = __builtin_amdgcn_mfma_f32_16x16x32_bf16(a_, bg[ks][n], acc[n], 0, 0, 0);
        }
#pragma unroll
        for (int r = 0; r < 4; ++r) {
            const int m = mB + 4 * fq + r;
            f32x4 y; y[0] = bflo(yw[r].x); y[1] = bfhi(yw[r].x); y[2] = bflo(yw[r].y); y[3] = bfhi(yw[r].y);
            const float mean = red16((y[0] + y[1]) + (y[2] + y[3])) * (1.0f / 64.0f);
            const f32x4 d = y - mean;
            const float var = red16((d[0] * d[0] + d[1] * d[1]) + (d[2] * d[2] + d[3] * d[3])) * (1.0f / 64.0f);
            const float rs = rsqrtf(var + 64e-5f);
            f32x4 o;
#pragma unroll
            for (int n = 0; n < 4; ++n) o[n] = (d[n] * rs * lg[n] + lb[n] + bon[r] * (float)vv[r][n]) * acc[n][r];
            u32x2 w; w.x = pk_bf(o[0], o[1]); w.y = pk_bf(o[2], o[3]);
            *(u32x2*)(MIX + (size_t)m * DM + j0) = w;
        }
    }
}
__device__ __forceinline__ void post_gd(u16* __restrict__ MIX, const u16* __restrict__ Z2, const float* __restrict__ ng) {
    const int tid_ = otid(); const int lane = tid_ & 63, wid = tid_ >> 6; const int bidx = obid(), gdim = ogrid();
    for (int task = bidx * 8 + wid; task < 6 * (MT / 32); task += gdim * 8) {
        const int hh = task % 6, chunk = task / 6, m0 = chunk * 32;
        const float n0 = ng[2 * lane], n1 = ng[2 * lane + 1];
        for (int s8 = 0; s8 < 32; s8 += 8) {
          unsigned lo[8], lg[8];
#pragma unroll
          for (int k = 0; k < 8; ++k) { const int m = m0 + s8 + k; lo[k] = *(const unsigned*)(MIX + (size_t)m * DM + 768 + hh * 128 + 2 * lane); lg[k] = *(const unsigned*)(Z2 + (size_t)m * Z2_LD + Z2_GATE + hh * 128 + 2 * lane); }
#pragma unroll
          for (int k = 0; k < 8; ++k) {
            const int m = m0 + s8 + k;
            unsigned* op = (unsigned*)(MIX + (size_t)m * DM + 768 + hh * 128 + 2 * lane);
            const unsigned ow = lo[k];
            const float o0 = bflo(ow), o1 = bfhi(ow);
            const float ss = wave_sum(o0 * o0 + o1 * o1);
            const float rs = rsqrtf(ss * (1.0f / 128.0f) + 1e-6f);
            const unsigned gw = lg[k];
            const float g0 = bflo(gw), g1 = bfhi(gw);
            *op = pk_bf(o0 * rs * n0 * (g0 * sigm(g0)), o1 * rs * n1 * (g1 * sigm(g1)));
          }
        }
    }
}

#define XB_TMO      128
#define XB_XCNT(j)  (256  + 64 * (j))
#define XB_XSUB(j)  (1280 + 64 * (j))
#define XB_XGEN(j)  (2304 + 64 * (j))
#define XB_TOP      3328
#define XB_TOPGEN   3392
#define XCD_BAR_WORDS 3456
#define XB_SPIN_CAP (1u << 18)

__device__ __forceinline__ unsigned xb_ld(unsigned* p)              { return __hip_atomic_load(p, __ATOMIC_RELAXED, __HIP_MEMORY_SCOPE_AGENT); }
__device__ __forceinline__ unsigned xb_add(unsigned* p, unsigned v) { return __hip_atomic_fetch_add(p, v, __ATOMIC_RELAXED, __HIP_MEMORY_SCOPE_AGENT); }
__device__ __forceinline__ unsigned xb_xcc_id() { return (unsigned)__builtin_amdgcn_s_getreg((3 << 11) | 20) & 0xFu; }
#define XB_SPIN(cond, bar) do { unsigned _sp = 0; while (cond) { __builtin_amdgcn_s_sleep(1); \
    if ((++_sp & 255u) == 0u) { if (xb_ld(&(bar)[XB_TMO])) break; if (_sp > XB_SPIN_CAP) { atomicAdd(&(bar)[XB_TMO], 1u); break; } } } } while (0)

struct XcdBarrier {
    unsigned* bar; unsigned x;
    volatile LAS unsigned* st;
};

__device__ __forceinline__ XcdBarrier xcd_barrier_post(unsigned* bar, volatile LAS unsigned* st) {
    XcdBarrier b; b.bar = bar; b.x = xb_xcc_id(); b.st = st;
    if (threadIdx.x == 0) (void)xb_add(&bar[XB_XCNT(b.x)], 1u);
    return b;
}
__device__ __forceinline__ void xcd_barrier_complete(unsigned* bar, unsigned x, unsigned& nloc, unsigned& nx) {
    const unsigned G = gridDim.x * gridDim.y * gridDim.z;
    unsigned sum, cnt, mine, sp = 0u;
    for (;;) {
        sum = 0u; cnt = 0u; mine = 0u;
#pragma unroll
        for (unsigned j = 0; j < 16; ++j) { const unsigned c = xb_ld(&bar[XB_XCNT(j)]); sum += c; cnt += (c > 0u) ? 1u : 0u; mine = (j == x) ? c : mine; }
        if (sum == G) break;
        __builtin_amdgcn_s_sleep(1);
        if ((++sp & 255u) == 0u) { if (xb_ld(&bar[XB_TMO])) break; if (sp > XB_SPIN_CAP) { atomicAdd(&bar[XB_TMO], 1u); break; } }
    }
    nloc = mine > 0u ? mine : 1u; nx = cnt > 0u ? cnt : 1u;
}

__device__ __forceinline__ void xcd_barrier(const XcdBarrier& b) {
    asm volatile("s_waitcnt vmcnt(0)" ::: "memory");
    __syncthreads();
    if (threadIdx.x == 0) {
        unsigned* bar = b.bar;
        __builtin_amdgcn_s_waitcnt(0);
        unsigned nloc = b.st[0], nx = b.st[1];
        if (nloc == 0u) { xcd_barrier_complete(bar, b.x, nloc, nx); b.st[0] = nloc; b.st[1] = nx; }
        const unsigned old = xb_add(&bar[XB_XSUB(b.x)], 1u);
        const unsigned gen = old / nloc;
        if (old + 1u == (gen + 1u) * nloc) {
            __builtin_amdgcn_fence(__ATOMIC_RELEASE, "agent");
            asm volatile("s_waitcnt vmcnt(0)" ::: "memory");
            const unsigned og = xb_add(&bar[XB_TOP], 1u);
            const unsigned tg = og / nx;
            if (og + 1u == (tg + 1u) * nx) xb_add(&bar[XB_TOPGEN], 1u);
            else XB_SPIN(xb_ld(&bar[XB_TOPGEN]) == tg, bar);
            __builtin_amdgcn_fence(__ATOMIC_ACQUIRE, "agent");
            xb_add(&bar[XB_XGEN(b.x)], 1u);
            asm volatile("s_waitcnt vmcnt(0)" ::: "memory");
        } else {
            XB_SPIN(xb_ld(&bar[XB_XGEN(b.x)]) == gen, bar);
            __builtin_amdgcn_fence(__ATOMIC_ACQUIRE, "agent");
            asm volatile("s_waitcnt vmcnt(0)" ::: "memory");
        }
    }
    __syncthreads();
}
__device__ __forceinline__ const float* getp(const LAS unsigned* TAB, int k) {
    const unsigned lo = __builtin_amdgcn_readfirstlane(TAB[2 * k]), hi = __builtin_amdgcn_readfirstlane(TAB[2 * k + 1]);
    return (const float*)(((unsigned long long)hi << 32) | lo);
}
__global__ void __launch_bounds__(512, 2) fwd_mega(Params p) {
    extern __shared__ __attribute__((aligned(16))) unsigned char lds_raw[];
    LAS unsigned char* lds = (LAS unsigned char*)lds_raw;
    cg::grid_group grid = cg::this_grid();
#if REP & 256
#define GSYNC() do { xcd_barrier(xbar); xcd_barrier(xbar); } while (0)
#else
#define GSYNC() xcd_barrier(xbar)
#endif
    unsigned char* ws = p.ws;
    u16* HBUF = (u16*)(ws + WS_HBUF); u16* WGU = (u16*)(ws + WS_WGU); u16* WD = (u16*)(ws + WS_WD); u16* WIN = (u16*)(ws + WS_WIN); u16* WOUT = (u16*)(ws + WS_WOUT);
    u16* ACT = (u16*)(ws + WS_ACT); u16* Z = (u16*)(ws + WS_Z); h16* RWPp = (h16*)(ws + WS_RWP); float* RWSp = (float*)(ws + WS_RWS); u16* ZG = (u16*)(ws + WS_ZG);
    h16* GDPp = (h16*)(ws + WS_GDP); float* GDSp = (float*)(ws + WS_GDS); u16* LRA = (u16*)(ws + WS_LRA); u16* LRUb = (u16*)(ws + WS_LRU); u16* WGU2 = (u16*)(ws + WS_WGU2); u16* WD2 = (u16*)(ws + WS_WD2);
    const bool pre2 = gridDim.x > 208;     float* HIN = (float*)(ws + WS_HIN); float* BONp = (float*)(ws + WS_BON);
    float* X = p.out;
    const int G = gridDim.x, bid = blockIdx.x;
    LAS unsigned* TAB = (LAS unsigned*)(lds + 131072 + 1024);
    if (threadIdx.x == 0) {
#pragma unroll
        for (int i = 0; i < 35; ++i) { const unsigned long long a = (unsigned long long)p.in[i]; TAB[2 * i] = (unsigned)a; TAB[2 * i + 1] = (unsigned)(a >> 32); }
    }
    volatile LAS unsigned* xst = (volatile LAS unsigned*)(lds + 131072 + 512);
    if (threadIdx.x < 2) xst[threadIdx.x] = 0u;
    __syncthreads();
    const XcdBarrier xbar = xcd_barrier_post((unsigned*)(ws + WS_BAR), xst);
    grid.sync();
#define INP(k) getp(TAB, (k))

    for (int l = 0; l < 2; ++l) {
        for (int half = 0; half < 2; ++half) {
            const float* ng = INP(half ? 30 : 1) + (size_t)l * DM;
            const float* wg = INP(half ? 31 : 2) + (size_t)l * DM * DFF;
            const float* wu = INP(half ? 32 : 3) + (size_t)l * DM * DFF;
            const float* wd = INP(half ? 33 : 4) + (size_t)l * DM * DFF;
#if PH & 1
            u16* const WGUc = (half && pre2) ? WGU2 : WGU; u16* const WDc = (half && pre2) ? WD2 : WD;
            if (!(half && pre2)) {
            conv_w<1>(wg, WGUc, DM, DFF, (LAS float*)lds);
            conv_w<2>(wu, WGUc, DM, DFF, (LAS float*)lds);
            conv_w<0>(wd, WDc, DFF, DM, (LAS float*)lds);
            }
#endif
#if PH & 2
            if (l == 0 && half == 0) norm_rows<false>(INP(0), ng, HBUF, nullptr); else norm_rows<false>(X, ng, HBUF, nullptr);
#endif
#if REP & 32
            conv_w<1>(wg, WGU, DM, DFF, (LAS float*)lds);
            conv_w<2>(wu, WGU, DM, DFF, (LAS float*)lds);
            conv_w<0>(wd, WD, DFF, DM, (LAS float*)lds);
#endif
#if REP & 64
            if (l == 0 && half == 0) norm_rows<false>(INP(0), ng, HBUF, X); else norm_rows<false>(X, ng, HBUF, nullptr);
#endif
            GSYNC();
#if PH & 4
            { pg8::Gemm g{HBUF, WGUc, MT, 2 * DFF, DM}; pg8::StaticOrder S; S.init(MT, 2 * DFF, G, bid); pg8::EpiGU E{ACT, DFF};
              pg8::gemm_phase<pg8::EpiGU, pg8::StaticOrder>(lds, g, S, E);
#if REP & 1
              GSYNC(); pg8::gemm_phase<pg8::EpiGU, pg8::StaticOrder>(lds, g, S, E);
#endif
            }
#endif
            GSYNC();
#if PH & 8
            { pg8::Gemm g{ACT, WDc, MT, DM, DFF}; pg8::StaticOrder S; S.init(MT, DM, G, bid); pg8::EpiResid E{(l == 0 && half == 0) ? INP(0) : (const float*)X, X, DM, (REP & 2) ? 0.25f : 0.5f};
              pg8::gemm_phase<pg8::EpiResid, pg8::StaticOrder, true>(lds, g, S, E);
#if REP & 2
              GSYNC(); pg8::gemm_phase<pg8::EpiResid, pg8::StaticOrder, true>(lds, g, S, E);
#endif
            }
#endif
            GSYNC();
            if (half == 1) continue;
#if PH & 16
            conv_w<3>(INP(6) + (size_t)l * DM * 6668, WIN, DM, 6668, (LAS float*)lds);
            conv_w<0>(INP(29) + (size_t)l * DM * DM, WOUT, DM, DM, (LAS float*)lds);
            tr_small(INP(9) + l * 64 * 768, (u16*)(ws + WS_W2T), 64); tr_small(INP(11) + l * 64 * 768, (u16*)(ws + WS_A2T), 64); tr_small(INP(12) + l * 128 * 768, (u16*)(ws + WS_G2T), 128);
            tr_blocks(INP(24) + l * 8 * 64 * 64, (u16*)(ws + WS_WAT)); tr_blocks(INP(26) + l * 8 * 64 * 64, (u16*)(ws + WS_WXT));
            norm_rows<false>(X, INP(5) + (size_t)l * DM, HBUF, nullptr);
#endif
            GSYNC();
#if PH & 32
            { pg8::Gemm g{HBUF, WIN, MT, 2560, DM}; pg8::StaticOrder S; S.init(MT, 2560, G, bid); pg8::EpiZ E{Z, Z1_LD};
              pg8::gemm_phase<pg8::EpiZ, pg8::StaticOrder>(lds, g, S, E); }
#endif
            GSYNC();
#if PH & 64
            { RwP P{INP(7) + l * 2560, INP(8) + l * 768, INP(9) + l * 64 * 768, INP(10) + l * 768, INP(11) + l * 64 * 768, INP(13) + l * 768, INP(14) + l * 768, INP(15) + l * 768};
              prep_rw2(Z, P, (const u16*)(ws + WS_W2T), (const u16*)(ws + WS_A2T), RWPp, RWSp, BONp, ZG, lds);
#if REP & 8
              prep_rw2(Z, P, (const u16*)(ws + WS_W2T), (const u16*)(ws + WS_A2T), RWPp, RWSp, BONp, ZG, lds);
#endif
            }
#endif
            GSYNC();
#if PH & 128
            { pg8::Gemm g{HBUF, WIN + (size_t)2560 * DM, MT, 4352, DM}; pg8::StaticOrder S; S.init(MT, 4352, G, bid); pg8::EpiZ E{Z, Z2_LD};
              pg8::gemm_phase<pg8::EpiZ, pg8::StaticOrder>(lds, g, S, E); }
#endif
            GSYNC();
#if PH & 256
            prep_gd(Z, INP(18) + l * 4 * 2304, INP(19) + l * 6, INP(20) + l * 6, GDPp, GDSp);
#endif
#if PH & 512
            { LrP P{INP(22) + l * 4 * 512, INP(23) + l * 512, INP(24) + l * 8 * 64 * 64, INP(25) + l * 512, INP(26) + l * 8 * 64 * 64, INP(27) + l * 512, INP(28) + l * 512};
              if (!pre2) prep_lr2(Z, P, (const u16*)(ws + WS_WAT), (const u16*)(ws + WS_WXT), LRA, LRUb, lds);
            }
#endif
            GSYNC();
#if PH & 1024
            for (int rep_ = 0; rep_ < ((REP & 4) ? 2 : 1); ++rep_)
            for (int task = bid; task < 208; task += G) {
                if (task < 96) { const int bh = task >> 2, q4 = task & 3, b = bh / 12, hh = bh % 12;
                    rec_block<0>((const unsigned char*)RWPp + (size_t)bh * TS * 768, (const unsigned char*)RWSp + (size_t)bh * TS * 16,
                                 HBUF + (size_t)b * TS * DM + hh * 64 + q4 * 16, q4 * 16, lds);
                    __threadfence();
                    __syncthreads();
                    if (threadIdx.x == 0) {
                        unsigned* cnt = (unsigned*)(ws + WS_BAR + 14336) + bh;
                        __hip_atomic_fetch_add(cnt, 1u, __ATOMIC_RELAXED, __HIP_MEMORY_SCOPE_AGENT);
                        const unsigned want = 4u * (unsigned)(l + 1); unsigned spins = 0;
                        while (__hip_atomic_load(cnt, __ATOMIC_RELAXED, __HIP_MEMORY_SCOPE_AGENT) < want) { __builtin_amdgcn_s_sleep(8); if (++spins > (1u << 22)) break; }
                        __builtin_amdgcn_fence(__ATOMIC_ACQUIRE, "agent");
                        asm volatile("s_waitcnt vmcnt(0)" ::: "memory");
                    }
                    __syncthreads();
                    post_rw_head(HBUF, RWPp, BONp, ZG, (const u16*)(ws + WS_G2T), INP(16) + l * 768, INP(17) + l * 768, b, hh, q4 * (TS / 64), TS / 64); }
                else if (task < 192) { const int gb = task - 96, bh = gb >> 3, o8 = gb & 7, b = bh / 6, hh = bh % 6;
                    rec_block<1>((const unsigned char*)GDPp + (size_t)bh * TS * 768, (const unsigned char*)GDSp + (size_t)bh * TS * 16,
                                 HBUF + (size_t)b * TS * DM + 768 + hh * 128 + o8 * 16, o8 * 16, lds); }
                else if (threadIdx.x < 64) {
                    if (pre2) { unsigned* c3 = (unsigned*)(ws + WS_BAR + 14336) + 48; const unsigned want3 = (unsigned)(G - 208) * (unsigned)(l + 1); unsigned spins = 0;
                        while (__hip_atomic_load(c3, __ATOMIC_RELAXED, __HIP_MEMORY_SCOPE_AGENT) < want3) { __builtin_amdgcn_s_sleep(8); if (++spins > (1u << 22)) break; }
                        __builtin_amdgcn_fence(__ATOMIC_ACQUIRE, "agent"); asm volatile("s_waitcnt vmcnt(0)" ::: "memory"); }
                    lru_carry(task - 192, LRA, LRUb, HIN);
                    __threadfence();
                    if (threadIdx.x == 0) __hip_atomic_fetch_add((unsigned*)(ws + WS_BAR + 14336) + 32, 1u, __ATOMIC_RELAXED, __HIP_MEMORY_SCOPE_AGENT); }
            }
            if (pre2 && bid >= 208) {
                { LrP P{INP(22) + l * 4 * 512, INP(23) + l * 512, INP(24) + l * 8 * 64 * 64, INP(25) + l * 512, INP(26) + l * 8 * 64 * 64, INP(27) + l * 512, INP(28) + l * 512};
                  prep_lr2(Z, P, (const u16*)(ws + WS_WAT), (const u16*)(ws + WS_WXT), LRA, LRUb, lds, bid - 208, G - 208); }
                __threadfence();
                __syncthreads();
                if (threadIdx.x == 0) __hip_atomic_fetch_add((unsigned*)(ws + WS_BAR + 14336) + 48, 1u, __ATOMIC_RELAXED, __HIP_MEMORY_SCOPE_AGENT);
                conv_w<1>(INP(31) + (size_t)l * DM * DFF, WGU2, DM, DFF, (LAS float*)lds, bid - 208, G - 208);
                conv_w<2>(INP(32) + (size_t)l * DM * DFF, WGU2, DM, DFF, (LAS float*)lds, bid - 208, G - 208);
                conv_w<0>(INP(33) + (size_t)l * DM * DFF, WD2, DFF, DM, (LAS float*)lds, bid - 208, G - 208);
                if (threadIdx.x == 0) {
                    unsigned* cnt = (unsigned*)(ws + WS_BAR + 14336) + 32; const unsigned want = 16u * (unsigned)(l + 1); unsigned spins = 0;
                    while (__hip_atomic_load(cnt, __ATOMIC_RELAXED, __HIP_MEMORY_SCOPE_AGENT) < want) { __builtin_amdgcn_s_sleep(8); if (++spins > (1u << 22)) break; }
                    __builtin_amdgcn_fence(__ATOMIC_ACQUIRE, "agent");
                    asm volatile("s_waitcnt vmcnt(0)" ::: "memory");
                }
                __syncthreads();
                post_lr(HBUF, Z, LRA, LRUb, HIN, bid - 208, G - 208);
            }
#endif
            GSYNC();
#if PH & 2048
#endif
#if PH & 4096
            post_gd(HBUF, Z, INP(21) + l * 128);
            if (!pre2) post_lr(HBUF, Z, LRA, LRUb, HIN);
#endif
            GSYNC();
#if PH & 8192
            { pg8::Gemm g{HBUF, WOUT, MT, DM, DM}; pg8::StaticOrder S; S.init(MT, DM, G, bid); pg8::EpiResid E{X, X, DM, 1.0f};
              pg8::gemm_phase<pg8::EpiResid, pg8::StaticOrder>(lds, g, S, E); }
#endif
            GSYNC();
        }
    }
    norm_rows<true>(X, INP(34), nullptr, X);
}

extern "C" void kernel_launch(void* const* d_in, const int* in_sizes, int n_in, void* d_out, int out_size, void* d_ws, size_t ws_size, hipStream_t stream) {
    static int grid_blocks = 0;
    if (!grid_blocks) {
        int dev = 0, cus = 0, per_cu = 0;
        (void)hipGetDevice(&dev);
        (void)hipDeviceGetAttribute(&cus, hipDeviceAttributeMultiprocessorCount, dev);
        (void)hipFuncSetAttribute((const void*)fwd_mega, hipFuncAttributeMaxDynamicSharedMemorySize, LDS_BYTES);
        (void)hipOccupancyMaxActiveBlocksPerMultiprocessor(&per_cu, (const void*)fwd_mega, 512, LDS_BYTES);
        grid_blocks = cus > 0 ? cus : 256;
        if (ws_size < WS_END) fprintf(stderr, "kernel_launch: workspace too small: %zu < %zu\n", ws_size, (size_t)WS_END);
        fprintf(stderr, "kernel_launch: cus %d occupancy %d ws %zu n_in %d\n", cus, per_cu, ws_size, n_in);
    }
    Params p{};
    for (int i = 0; i < 35; ++i) p.in[i] = (const float*)d_in[i];
    p.out = (float*)d_out; p.ws = (unsigned char*)d_ws;
    (void)hipMemsetAsync((unsigned char*)d_ws + WS_BAR, 0, 16384, stream);
    void* args[] = {&p};
    hipError_t e = hipLaunchCooperativeKernel((const void*)fwd_mega, dim3(grid_blocks), dim3(512), args, LDS_BYTES, stream);
    if (e != hipSuccess) fprintf(stderr, "cooperative launch failed: %s (grid %d)\n", hipGetErrorString(e), grid_blocks);
}
```
